# Optimizing an MI355X kernel written in HIP

```python
import math
import jax
import jax.numpy as jnp
from jax import lax
import numpy as np

D_MODEL = 2048
BATCH = 1
SEQ = 8192
DEPTH = 2
DEC_BATCH = 128
DEC_SEQ = 4
PAST_LEN = 8192
PAGE_SIZE = 128

MIX_HALF = D_MODEL // 2
CONV_A_WIDTH = MIX_HALF
CONV_A_K = 3
HEAD_DIM = 64
ATT_HEADS = MIX_HALF // HEAD_DIM
ATT_KV_HEADS = ATT_HEADS // 4
ATT_GROUP = ATT_HEADS // ATT_KV_HEADS
WINDOW = 128
NUM_BUCKETS = 32
MAX_DISTANCE = 128
CMLP_WIDTH = MIX_HALF
CMLP_GROUPS = 8
CHUNK = 128
SSD_HEAD_DIM = 64
SSD_HEADS = MIX_HALF // SSD_HEAD_DIM
SSD_WIDTH = SSD_HEADS * SSD_HEAD_DIM
SSD_STATE = 128
SSD_GROUPS = 2
SSD_CONV_K = 4
SSD_CHUNK = 128
SSD_CONV_DIM = SSD_WIDTH + 2 * SSD_GROUPS * SSD_STATE
EVEN_IN_WIDTHS = (CONV_A_WIDTH,) * 4 + (ATT_HEADS * HEAD_DIM, ATT_KV_HEADS * HEAD_DIM, ATT_KV_HEADS * HEAD_DIM, ATT_HEADS * HEAD_DIM)
ODD_IN_WIDTHS = (CMLP_WIDTH,) * 3 + (SSD_WIDTH, SSD_CONV_DIM, SSD_HEADS)
NORM_EPS = 1e-6
MASK_VALUE = -1e30

kernel_name = 'hybrid_conv_swa_chunkmlp_ssd_step'


def split_cols(t, widths):
    idx = np.cumsum(widths)[:-1].tolist()
    return jnp.split(t, idx, axis=-1)


def rms_norm(x, g):
    xf = x.astype(jnp.float32)
    y = xf * lax.rsqrt(jnp.mean(xf * xf, axis=-1, keepdims=True) + NORM_EPS)
    return (y * g.astype(jnp.float32)).astype(x.dtype)


def layer_norm(x, g, b):
    xf = x.astype(jnp.float32)
    xc = xf - jnp.mean(xf, axis=-1, keepdims=True)
    y = xc * lax.rsqrt(jnp.mean(xc * xc, axis=-1, keepdims=True) + NORM_EPS)
    return (y * g.astype(jnp.float32) + b.astype(jnp.float32)).astype(x.dtype)


def causal_dwconv(s, buf, w):
    k_width = w.shape[0]
    t_len = s.shape[1]
    full = jnp.concatenate([buf.astype(s.dtype), s], axis=1)
    out = full[:, 0:t_len] * w[0]
    for j in range(1, k_width):
        out = out + full[:, j:j + t_len] * w[j]
    return out, full[:, full.shape[1] - (k_width - 1):]


def rel_bucket(dist):
    max_exact = NUM_BUCKETS // 2
    d = jnp.maximum(dist, 0)
    ratio = jnp.maximum(d, max_exact).astype(jnp.float32) / max_exact
    large = max_exact + (jnp.log(ratio) / math.log(MAX_DISTANCE / max_exact) * (NUM_BUCKETS - max_exact)).astype(jnp.int32)
    return jnp.where(d < max_exact, d, jnp.minimum(large, NUM_BUCKETS - 1))


def sink_attention(q, k, v, dist, valid, rel_bias, sinks):
    hkv, grp, hd = q.shape[-3:]
    s = jnp.einsum('...qhgd,...shd->...hgqs', q, k).astype(jnp.float32) * (hd ** -0.5)
    bias = rel_bias.astype(jnp.float32)[rel_bucket(dist)]
    bias = jnp.moveaxis(bias, -1, 0).reshape(hkv, grp, *dist.shape)
    s = jnp.where(valid, s + bias, MASK_VALUE)
    sink = sinks.astype(jnp.float32).reshape(hkv, grp, 1, 1)
    m = jnp.maximum(jnp.max(s, axis=-1, keepdims=True), sink)
    p = jnp.exp(s - m)
    probs = p / (jnp.sum(p, axis=-1, keepdims=True) + jnp.exp(sink - m))
    return jnp.einsum('...hgqs,...shd->...qhgd', probs.astype(v.dtype), v)


def banded_window_attention(q, k, v, rel_bias, sinks):
    b, t_len, hkv, grp, hd = q.shape
    bs = WINDOW
    nb = t_len // bs
    qb = q.reshape(b, nb, bs, hkv, grp, hd)
    kb = k.reshape(b, nb, bs, hkv, hd)
    vb = v.reshape(b, nb, bs, hkv, hd)
    kk = jnp.concatenate([jnp.concatenate([jnp.zeros_like(kb[:, :1]), kb[:, :-1]], axis=1), kb], axis=2)
    vv = jnp.concatenate([jnp.concatenate([jnp.zeros_like(vb[:, :1]), vb[:, :-1]], axis=1), vb], axis=2)
    dist = (jnp.arange(bs)[:, None] + bs) - jnp.arange(2 * bs)[None, :]
    key_ok = (jnp.arange(nb)[:, None] * bs + jnp.arange(2 * bs)[None, :] - bs) >= 0
    valid = ((dist >= 0) & (dist < WINDOW))[None, None, None, None] & key_ok[None, :, None, None, None, :]
    o = sink_attention(qb, kk, vv, dist, valid, rel_bias, sinks)
    return o.reshape(b, t_len, hkv * grp * hd)


def window_attention_step(q, k, v, k_past, v_past, rel_bias, sinks):
    b, t_len = q.shape[:2]
    k_all = jnp.concatenate([k_past.astype(k.dtype), k], axis=1)
    v_all = jnp.concatenate([v_past.astype(v.dtype), v], axis=1)
    n_keys = k_all.shape[1]
    dist = (jnp.arange(t_len)[:, None] + k_past.shape[1]) - jnp.arange(n_keys)[None, :]
    valid = (dist >= 0) & (dist < WINDOW)
    o = sink_attention(q, k_all, v_all, dist, valid, rel_bias, sinks)
    return o.reshape(b, t_len, -1), k_all[:, n_keys - WINDOW:], v_all[:, n_keys - WINDOW:]


def chunk_mlp(v, ln_g, ln_b, w_s, b_s):
    b, t_len, width = v.shape
    vn = layer_norm(v, ln_g, ln_b)
    size = t_len if t_len <= CHUNK else CHUNK
    n_chunks = -(-t_len // size)
    pad = n_chunks * size - t_len
    vc = jnp.pad(vn, ((0, 0), (0, pad), (0, 0))).reshape(b, n_chunks, size, CMLP_GROUPS, width // CMLP_GROUPS)
    w_causal = jnp.tril(w_s[:, :size, :size])
    mixed = jnp.einsum('gts,bcsgw->bctgw', w_causal, vc) + jnp.transpose(b_s[:, :size])[None, None, :, :, None]
    return mixed.reshape(b, n_chunks * size, width)[:, :t_len], vn


def ssd_scan(x, dt, a, bm, cm, h0):
    b, t_len, n_heads, p_dim = x.shape
    n_grp, n_st = bm.shape[2], bm.shape[3]
    rep = n_heads // n_grp
    size = t_len if t_len <= SSD_CHUNK else SSD_CHUNK
    nc = -(-t_len // size)
    pad = nc * size - t_len
    padt = lambda t: jnp.pad(t, [(0, 0), (0, pad)] + [(0, 0)] * (t.ndim - 2))
    xc = padt(x).reshape(b, nc, size, n_grp, rep, p_dim)
    dtc = padt(dt).reshape(b, nc, size, n_grp, rep)
    bc = padt(bm).reshape(b, nc, size, n_grp, n_st)
    cc = padt(cm).reshape(b, nc, size, n_grp, n_st)
    acs = jnp.cumsum(dtc * a.reshape(n_grp, rep), axis=2)
    causal = jnp.tril(jnp.ones((size, size), dtype=bool))
    seg = acs[:, :, :, None] - acs[:, :, None, :]
    decay = jnp.exp(jnp.where(causal[:, :, None, None], seg, -jnp.inf))
    cb = jnp.einsum('bctgn,bcsgn->bctsg', cc, bc)
    w = cb[..., None] * decay * dtc[:, :, None]
    y_diag = jnp.einsum('bctsgr,bcsgrp->bctgrp', w, xc)
    xw = xc * (jnp.exp(acs[:, :, -1:] - acs) * dtc)[..., None]
    chunk_states = jnp.einsum('bcsgn,bcsgrp->bcgrpn', bc, xw)
    chunk_decay = jnp.exp(acs[:, :, -1])

    def step(h, inp):
        dec, st = inp
        return h * dec[..., None, None] + st, h

    h_last, h_prev = lax.scan(step, h0.reshape(b, n_grp, rep, p_dim, n_st),
                              (jnp.moveaxis(chunk_decay, 1, 0), jnp.moveaxis(chunk_states, 1, 0)))
    h_prev = jnp.moveaxis(h_prev, 0, 1)
    y_off = jnp.einsum('bctgn,bcgrpn->bctgrp', cc, h_prev) * jnp.exp(acs)[..., None]
    y = (y_diag + y_off).reshape(b, nc * size, n_heads, p_dim)[:, :t_len]
    return y, h_last.reshape(b, n_heads, p_dim, n_st)


def even_layer(x, conv_buf, k_past, v_past, g_pre, w_in, conv_w, rel_bias, sinks, w_out, g_post):
    b, t_len, _ = x.shape
    h = rms_norm(x, g_pre)
    a_b, a_c, a_h, a_gate, q, k, v, att_gate = split_cols(h @ w_in, EVEN_IN_WIDTHS)
    conv_out, new_conv = causal_dwconv(a_c * a_h, conv_buf, conv_w)
    y_a = a_b * conv_out * jax.nn.silu(a_gate)
    q = q.reshape(b, t_len, ATT_KV_HEADS, ATT_GROUP, HEAD_DIM)
    k = k.reshape(b, t_len, ATT_KV_HEADS, HEAD_DIM)
    v = v.reshape(b, t_len, ATT_KV_HEADS, HEAD_DIM)
    if k_past is None:
        o = banded_window_attention(q, k, v, rel_bias, sinks)
        new_k, new_v = k[:, t_len - WINDOW:], v[:, t_len - WINDOW:]
    else:
        o, new_k, new_v = window_attention_step(q, k, v, k_past, v_past, rel_bias, sinks)
    y_b = o * jax.nn.silu(att_gate)
    y = jnp.concatenate([y_a, y_b], axis=-1) @ w_out
    return x + rms_norm(y, g_post), new_conv, new_k, new_v


def odd_layer(x, conv_buf, ssm_state, g_pre, w_in, ln_g, ln_b, w_s, b_s, conv_w, conv_b, dt_bias, a_log, d_skip, gate_norm_g, w_out, g_post):
    b, t_len, _ = x.shape
    f32 = jnp.float32
    h = rms_norm(x, g_pre)
    u, v, c_gate, z, xbc, dt_raw = split_cols(h @ w_in, ODD_IN_WIDTHS)
    mixed, v_rows = chunk_mlp(v, ln_g, ln_b, w_s, b_s)
    y_c = u * mixed * jax.nn.silu(c_gate)
    conv_out, new_conv = causal_dwconv(xbc, conv_buf, conv_w)
    xbc = jax.nn.silu(conv_out + conv_b)
    xs, bm, cm = split_cols(xbc, (SSD_WIDTH, SSD_GROUPS * SSD_STATE, SSD_GROUPS * SSD_STATE))
    xs = xs.reshape(b, t_len, SSD_HEADS, SSD_HEAD_DIM).astype(f32)
    bm = bm.reshape(b, t_len, SSD_GROUPS, SSD_STATE).astype(f32)
    cm = cm.reshape(b, t_len, SSD_GROUPS, SSD_STATE).astype(f32)
    dt = jax.nn.softplus(dt_raw.astype(f32) + dt_bias.astype(f32))
    a = -jnp.exp(a_log.astype(f32))
    y_ssd, new_state = ssd_scan(xs, dt, a, bm, cm, ssm_state.astype(f32))
    y_ssd = y_ssd + d_skip.astype(f32)[:, None] * xs
    grp_w = SSD_WIDTH // SSD_GROUPS
    gated = y_ssd.reshape(b, t_len, SSD_GROUPS, grp_w) * jax.nn.silu(z.astype(f32)).reshape(b, t_len, SSD_GROUPS, grp_w)
    gated = gated * lax.rsqrt(jnp.mean(gated * gated, axis=-1, keepdims=True) + NORM_EPS)
    y_d = (gated.reshape(b, t_len, SSD_WIDTH) * gate_norm_g.astype(f32)).astype(x.dtype)
    y = jnp.concatenate([y_c, y_d], axis=-1) @ w_out
    return x + rms_norm(y, g_post), v_rows, new_conv, new_state


def setup_inputs(seed: int = 0) -> dict:
    key = jax.random.key(seed)
    ks = iter(jax.random.split(key, 40))
    f32 = jnp.float32
    d = D_MODEL

    def nrm(shape, scale):
        return jax.random.normal(next(ks), shape, f32) * scale

    def gain(n):
        return 1.0 + nrm((n,), 0.05)

    u_dt = jax.random.uniform(next(ks), (SSD_HEADS,), f32)
    dt0 = jnp.exp(u_dt * (math.log(0.1) - math.log(1e-3)) + math.log(1e-3))
    a_init = jax.random.uniform(next(ks), (SSD_HEADS,), f32, 1.0, 16.0)
    return {
        'x_prompt': nrm((BATCH, SEQ, d), 1.0),
        'x_sample': nrm((DEC_BATCH, DEC_SEQ, d), 1.0),
        'state_conv_a': nrm((DEC_BATCH, CONV_A_K - 1, CONV_A_WIDTH), 1.0),
        'cache_win_k': nrm((DEC_BATCH, WINDOW, ATT_KV_HEADS, HEAD_DIM), 1.0),
        'cache_win_v': nrm((DEC_BATCH, WINDOW, ATT_KV_HEADS, HEAD_DIM), 1.0),
        'state_conv_d': nrm((DEC_BATCH, SSD_CONV_K - 1, SSD_CONV_DIM), 1.0),
        'state_ssm': nrm((DEC_BATCH, SSD_HEADS, SSD_HEAD_DIM, SSD_STATE), 0.5),
        'rel_bias': nrm((NUM_BUCKETS, ATT_HEADS), 0.5),
        'l0_g_pre': gain(d),
        'l0_w_in': nrm((d, sum(EVEN_IN_WIDTHS)), d ** -0.5),
        'l0_conv_w': nrm((CONV_A_K, CONV_A_WIDTH), CONV_A_K ** -0.5),
        'l0_sinks': nrm((ATT_HEADS,), 0.5),
        'l0_w_out': nrm((2 * MIX_HALF, d), (2 * MIX_HALF) ** -0.5),
        'l0_g_post': gain(d),
        'l1_g_pre': gain(d),
        'l1_w_in': nrm((d, sum(ODD_IN_WIDTHS)), d ** -0.5),
        'l1_ln_g': gain(CMLP_WIDTH),
        'l1_ln_b': nrm((CMLP_WIDTH,), 0.02),
        'l1_w_s': nrm((CMLP_GROUPS, CHUNK, CHUNK), CHUNK ** -0.5),
        'l1_b_s': 1.0 + nrm((CMLP_GROUPS, CHUNK), 0.1),
        'l1_conv_w': nrm((SSD_CONV_K, SSD_CONV_DIM), SSD_CONV_K ** -0.5),
        'l1_conv_b': nrm((SSD_CONV_DIM,), 0.02),
        'l1_dt_bias': dt0 + jnp.log(-jnp.expm1(-dt0)),
        'l1_a_log': jnp.log(a_init),
        'l1_d_skip': 1.0 + nrm((SSD_HEADS,), 0.1),
        'l1_gate_norm_g': gain(SSD_WIDTH),
        'l1_w_out': nrm((2 * MIX_HALF, d), (2 * MIX_HALF) ** -0.5),
        'l1_g_post': gain(d),
    }


def reference(x_prompt, x_sample, state_conv_a, cache_win_k, cache_win_v, state_conv_d, state_ssm, rel_bias,
              l0_g_pre, l0_w_in, l0_conv_w, l0_sinks, l0_w_out, l0_g_post,
              l1_g_pre, l1_w_in, l1_ln_g, l1_ln_b, l1_w_s, l1_b_s, l1_conv_w, l1_conv_b, l1_dt_bias, l1_a_log,
              l1_d_skip, l1_gate_norm_g, l1_w_out, l1_g_post):
    y_prompt, y_sample = x_prompt, x_sample
    b_p = x_prompt.shape[0]
    for layer in range(DEPTH):
        if layer % 2 == 0:
            even_w = (l0_g_pre, l0_w_in, l0_conv_w, rel_bias, l0_sinks, l0_w_out, l0_g_post)
            zero_conv_a = jnp.zeros((b_p, CONV_A_K - 1, CONV_A_WIDTH), x_prompt.dtype)
            y_prompt, p_conv_a, p_win_k, p_win_v = even_layer(y_prompt, zero_conv_a, None, None, *even_w)
            y_sample, s_conv_a, s_win_k, s_win_v = even_layer(y_sample, state_conv_a, cache_win_k, cache_win_v, *even_w)
        else:
            odd_w = (l1_g_pre, l1_w_in, l1_ln_g, l1_ln_b, l1_w_s, l1_b_s, l1_conv_w, l1_conv_b, l1_dt_bias,
                     l1_a_log, l1_d_skip, l1_gate_norm_g, l1_w_out, l1_g_post)
            zero_conv_d = jnp.zeros((b_p, SSD_CONV_K - 1, SSD_CONV_DIM), x_prompt.dtype)
            zero_ssm = jnp.zeros((b_p, SSD_HEADS, SSD_HEAD_DIM, SSD_STATE), jnp.float32)
            y_prompt, _, p_conv_d, p_ssm = odd_layer(y_prompt, zero_conv_d, zero_ssm, *odd_w)
            y_sample, s_chunk_v, s_conv_d, s_ssm = odd_layer(y_sample, state_conv_d, state_ssm, *odd_w)
    return (y_prompt, y_sample, p_conv_a, s_conv_a, p_win_k, p_win_v, s_win_k, s_win_v, s_chunk_v,
            p_conv_d, s_conv_d, p_ssm, s_ssm)
```

```cpp
#include <hip/hip_runtime.h>
#include <hip/hip_cooperative_groups.h>
#include <cstdio>
#include <cstdint>
namespace cg = cooperative_groups;

namespace pg8 {
#define PG8_LAS __attribute__((address_space(3)))
typedef unsigned short bf16_t;
typedef short bf16x8 __attribute__((ext_vector_type(8)));
typedef float f32x4 __attribute__((ext_vector_type(4)));
typedef unsigned u32x4 __attribute__((ext_vector_type(4)));
constexpr int BM = 256, BK = 64, HALF = 128, HTB = HALF * BK * 2  , STAGE_BYTES = 8 * HTB, NXCD = 8, WGM = 8;

__host__ __device__ __forceinline__ int lds_byte(int r, int c) { const int st = (r >> 4) * 2 + (c >> 5), rr = r & 15, cc = c & 31, ob = rr * 64 + cc * 2; return st * 1024 + (ob ^ (((ob >> 9) & 1) << 5)); }
__host__ __device__ __forceinline__ void stage_rc(int b, int& R, int& C) { const int st = b / 1024, sb = b % 1024, swz = sb ^ (((sb >> 9) & 1) << 5); R = (st >> 1) * 16 + swz / 64; C = (st & 1) * 32 + (swz % 64) / 2; }
__host__ __device__ __forceinline__ int perm32(int rho) { const int n = rho >> 4, i = rho & 15; return 8 * (i >> 2) + 4 * n + (i & 3); }

struct Unit { int pm, pn; };
struct Gemm { const bf16_t* A; const bf16_t* Bt; int M, N, K; };

struct StaticOrder {
    int nM, nN, nwg, G, c;
    __host__ __device__ void init(int M, int N, int G_, int c_) { nM = M / BM; nN = N / BM; nwg = nM * nN; G = G_; c = c_; }
    __host__ __device__ bool next(int i, Unit& u) const {
        const long L = (long)i * G + c; if (L >= nwg) return false;
        int wgid = (int)L; { const int q = nwg / NXCD, r = nwg % NXCD, xcd = wgid % NXCD, off = wgid / NXCD; wgid = (xcd < r ? xcd * (q + 1) : r * (q + 1) + (xcd - r) * q) + off; }
        const int nig = WGM * nN, gid = wgid / nig, fm = gid * WGM, gsz = (nM - fm) < WGM ? (nM - fm) : WGM;
        u.pm = fm + ((wgid % nig) % gsz); u.pn = (wgid % nig) / gsz; return true;
    }
    __device__ __forceinline__ void a_ready(const Unit&) const {}
    __device__ __forceinline__ void done(const Unit&) const {}
};

__device__ __forceinline__ unsigned cvt_pk_bf16(float lo, float hi) { unsigned r; asm volatile("v_cvt_pk_bf16_f32 %0, %1, %2" : "=v"(r) : "v"(lo), "v"(hi)); return r; }
struct EpiStore {
    static constexpr bool PERM = true, AFTER_DRAIN = false;
    bf16_t* O; int ldc; float* dt_out; int dt_tile;
    __device__ __forceinline__ void operator()(const f32x4 (&acc)[2][2][4][2], const Unit& u, int wr, int wc, int fr, int fq) const {
        const int row0 = u.pm * BM + wr * 64 + fr; const int col0 = u.pn * BM + wc * 32 + 8 * fq;
#pragma unroll
        for (int ai = 0; ai < 2; ++ai)
#pragma unroll
            for (int m = 0; m < 4; ++m) { bf16_t* rowp = O + (size_t)(row0 + ai * HALF + m * 16) * ldc + col0;
#pragma unroll
                for (int bj = 0; bj < 2; ++bj) { const f32x4 v0 = acc[ai][bj][m][0], v1 = acc[ai][bj][m][1];
                    u32x4 w; w.x = cvt_pk_bf16(v0[0], v0[1]); w.y = cvt_pk_bf16(v0[2], v0[3]); w.z = cvt_pk_bf16(v1[0], v1[1]); w.w = cvt_pk_bf16(v1[2], v1[3]);
                    *(u32x4*)(rowp + bj * HALF) = w; } }
        if (dt_out != nullptr && u.pn == dt_tile && wc == 0 && fq < 2) {
#pragma unroll
            for (int ai = 0; ai < 2; ++ai)
#pragma unroll
                for (int m = 0; m < 4; ++m) { float* p = dt_out + (size_t)(row0 + ai * HALF + m * 16) * 16 + 8 * fq;
                    *(f32x4*)(p) = acc[ai][0][m][0]; *(f32x4*)(p + 4) = acc[ai][0][m][1]; }
        }
    }
};

template <class Epi, class Sched, bool ALIGN_EPI = false, bool SP2 = false>
__device__ __forceinline__ void gemm_phase(PG8_LAS unsigned char* lds, const Gemm g, const Sched& S, const Epi& E) {
    const int tid = threadIdx.x, wid = __builtin_amdgcn_readfirstlane(tid >> 6), lane = tid & 63, wr = wid >> 2, wc = wid & 3, fr = lane & 15, fq = lane >> 4;
    const int K = g.K, nt = K / BK;
    unsigned voffA[2], voffB[2];
#pragma unroll
    for (int i = 0; i < 2; ++i) { int R, C; stage_rc(tid * 16 + i * 8192, R, C); const int Rb = Epi::PERM ? ((R & ~31) + perm32(R & 31)) : R;
        voffA[i] = (unsigned)(R * K + C) * 2u; voffB[i] = (unsigned)(Rb * K + C) * 2u; }
    const size_t kstep = (size_t)(BK * 2);
    const size_t hstep = (size_t)HALF * K * 2;
    const size_t tstep = 2 * hstep;
    const unsigned ldsw = (unsigned)wid * 1024u;
    const int aoff = lds_byte(wr * 64 + fr, fq * 8), boff = lds_byte(wc * 32 + fr, fq * 8);
#define PG8_SA(b, h) (((b) * 2 + (h)) * HTB)
#define PG8_SB(b, h) ((4 + (b) * 2 + (h)) * HTB)
#define PG8_STAGE(bufoff, gbase, voff) do { _Pragma("unroll") for (int _i = 0; _i < 2; ++_i) \
        __builtin_amdgcn_global_load_lds((const unsigned*)((const char*)(gbase) + (voff)[_i]), (PG8_LAS unsigned*)(lds + (bufoff) + ldsw + _i * 8192), 16, 0, 0); } while (0)
#define PG8_LDA(dst, b, h) do { _Pragma("unroll") for (int m = 0; m < 4; ++m) _Pragma("unroll") for (int k = 0; k < 2; ++k) dst[m][k] = *(const PG8_LAS bf16x8*)(lds + PG8_SA(b, h) + aoff + m * 2048 + k * 1024); } while (0)
#define PG8_LDB(dst, b, h) do { _Pragma("unroll") for (int n = 0; n < 2; ++n) _Pragma("unroll") for (int k = 0; k < 2; ++k) dst[n][k] = *(const PG8_LAS bf16x8*)(lds + PG8_SB(b, h) + boff + n * 2048 + k * 1024); } while (0)
#define PG8_MMA(ai, bj, At, Bt) do { __builtin_amdgcn_s_setprio(1); _Pragma("unroll") for (int m = 0; m < 4; ++m) _Pragma("unroll") for (int n = 0; n < 2; ++n) _Pragma("unroll") for (int k = 0; k < 2; ++k) \
        acc[ai][bj][m][n] = __builtin_amdgcn_mfma_f32_16x16x32_bf16(Bt[n][k], At[m][k], acc[ai][bj][m][n], 0, 0, 0); __builtin_amdgcn_s_setprio(0); } while (0)
#define PG8_WAIT_V(n) asm volatile("s_waitcnt vmcnt(" #n ")" ::: "memory")
#define PG8_WAIT_L(n) asm volatile("s_waitcnt lgkmcnt(" #n ")" ::: "memory")
#define PG8_BAR __builtin_amdgcn_s_barrier()
#define PG8_SCHED __builtin_amdgcn_sched_barrier(0)
    Unit cur, nxt; int ui = 0;
    if (!S.next(0, cur)) return;
    f32x4 acc[2][2][4][2];
#pragma unroll
    for (int a = 0; a < 2; ++a)
#pragma unroll
        for (int b = 0; b < 2; ++b)
#pragma unroll
            for (int m = 0; m < 4; ++m)
#pragma unroll
                for (int n = 0; n < 2; ++n) acc[a][b][m][n] = (f32x4){0.f, 0.f, 0.f, 0.f};
    bf16x8 At[4][2], B0[2][2], B1[2][2];
    const char* cA = (const char*)g.A + (size_t)cur.pm * tstep; const char* cB = (const char*)g.Bt + (size_t)cur.pn * tstep;
    S.a_ready(cur);
    if constexpr (SP2) {
        PG8_STAGE(PG8_SB(0, 0), cB, voffB); PG8_STAGE(PG8_SB(0, 1), cB + hstep, voffB); PG8_STAGE(PG8_SA(0, 0), cA, voffA); PG8_STAGE(PG8_SA(0, 1), cA + hstep, voffA);
        if (wr == 1) PG8_BAR;
        PG8_WAIT_V(2); PG8_BAR;
        PG8_STAGE(PG8_SB(1, 0), cB + kstep, voffB); PG8_STAGE(PG8_SA(1, 0), cA + kstep, voffA); PG8_STAGE(PG8_SB(1, 1), cB + hstep + kstep, voffB);
        PG8_WAIT_V(6); PG8_BAR;
    } else {
        PG8_STAGE(PG8_SB(0, 0), cB, voffB); PG8_STAGE(PG8_SA(0, 0), cA, voffA); PG8_STAGE(PG8_SB(0, 1), cB + hstep, voffB); PG8_STAGE(PG8_SA(0, 1), cA + hstep, voffA);
        if (wr == 1) PG8_BAR;
        PG8_WAIT_V(4); PG8_BAR;
        PG8_STAGE(PG8_SB(1, 0), cB + kstep, voffB); PG8_STAGE(PG8_SA(1, 0), cA + kstep, voffA); PG8_STAGE(PG8_SB(1, 1), cB + hstep + kstep, voffB);
        PG8_WAIT_V(6); PG8_BAR;
    }
    for (;;) {
        const bool has_next = S.next(ui + 1, nxt);
        const char* nA = has_next ? (const char*)g.A + (size_t)nxt.pm * tstep : cA; const char* nB = has_next ? (const char*)g.Bt + (size_t)nxt.pn * tstep : cB;
        for (int t = 0; t < nt; t += 2) {
            const bool last = (t == nt - 2);
            const char* a1 = cA + (size_t)(t + 1) * kstep;
            const char* a2 = last ? nA : cA + (size_t)(t + 2) * kstep; const char* b2 = last ? nB : cB + (size_t)(t + 2) * kstep;
            const char* a3 = a2 + kstep; const char* b3 = b2 + kstep;
            if (last && has_next) S.a_ready(nxt);
            if constexpr (SP2) {
            PG8_LDB(B0, 0, 0); PG8_LDB(B1, 0, 1); PG8_SCHED; PG8_LDA(At, 0, 0); PG8_STAGE(PG8_SA(1, 1), a1 + hstep, voffA);
            PG8_WAIT_V(8); PG8_WAIT_L(0); PG8_BAR; PG8_MMA(0, 0, At, B0); PG8_MMA(0, 1, At, B1); PG8_BAR; PG8_SCHED;
            PG8_LDA(At, 0, 1); PG8_STAGE(PG8_SB(0, 0), b2, voffB); PG8_STAGE(PG8_SB(0, 1), b2 + hstep, voffB); PG8_STAGE(PG8_SA(0, 0), a2, voffA);
            PG8_WAIT_V(8); PG8_WAIT_L(0); PG8_BAR; PG8_MMA(1, 0, At, B0); PG8_MMA(1, 1, At, B1); PG8_BAR; PG8_SCHED;
            PG8_LDB(B0, 1, 0); PG8_LDB(B1, 1, 1); PG8_SCHED; PG8_LDA(At, 1, 0); PG8_STAGE(PG8_SA(0, 1), a2 + hstep, voffA);
            PG8_WAIT_V(8); PG8_WAIT_L(0); PG8_BAR; PG8_MMA(0, 0, At, B0); PG8_MMA(0, 1, At, B1); PG8_BAR; PG8_SCHED;
            PG8_LDA(At, 1, 1); PG8_STAGE(PG8_SB(1, 0), b3, voffB); PG8_STAGE(PG8_SB(1, 1), b3 + hstep, voffB); PG8_STAGE(PG8_SA(1, 0), a3, voffA);
            PG8_WAIT_V(8); PG8_WAIT_L(0); PG8_BAR; PG8_MMA(1, 0, At, B0); PG8_MMA(1, 1, At, B1); PG8_BAR; PG8_SCHED;
            } else {
            PG8_LDB(B0, 0, 0); PG8_SCHED; PG8_LDA(At, 0, 0); PG8_STAGE(PG8_SA(1, 1), a1 + hstep, voffA);
            PG8_WAIT_L(8); PG8_BAR; PG8_WAIT_L(0); PG8_MMA(0, 0, At, B0); PG8_BAR; PG8_SCHED;
            PG8_LDB(B1, 0, 1); PG8_STAGE(PG8_SB(0, 0), b2, voffB);
            PG8_BAR; PG8_WAIT_L(0); PG8_MMA(0, 1, At, B1); PG8_BAR;
            PG8_LDA(At, 0, 1); PG8_STAGE(PG8_SA(0, 0), a2, voffA);
            PG8_BAR; PG8_WAIT_L(0); PG8_MMA(1, 0, At, B0); PG8_BAR; PG8_SCHED;
            PG8_STAGE(PG8_SB(0, 1), b2 + hstep, voffB);
            PG8_WAIT_V(6); PG8_BAR; PG8_MMA(1, 1, At, B1); PG8_BAR;
            PG8_LDB(B0, 1, 0); PG8_SCHED; PG8_LDA(At, 1, 0); PG8_STAGE(PG8_SA(0, 1), a2 + hstep, voffA);
            PG8_WAIT_L(8); PG8_BAR; PG8_WAIT_L(0); PG8_MMA(0, 0, At, B0); PG8_BAR; PG8_SCHED;
            PG8_LDB(B1, 1, 1); PG8_STAGE(PG8_SB(1, 0), b3, voffB);
            PG8_BAR; PG8_WAIT_L(0); PG8_MMA(0, 1, At, B1); PG8_BAR;
            PG8_LDA(At, 1, 1); PG8_STAGE(PG8_SA(1, 0), a3, voffA);
            PG8_BAR; PG8_WAIT_L(0); PG8_MMA(1, 0, At, B0); PG8_BAR; PG8_SCHED;
            PG8_STAGE(PG8_SB(1, 1), b3 + hstep, voffB);
            PG8_WAIT_V(6); PG8_BAR; PG8_MMA(1, 1, At, B1); PG8_BAR;
            }
        }
        if constexpr (ALIGN_EPI) { if (wr == 0) PG8_BAR; }
        if constexpr (!Epi::AFTER_DRAIN) { E(acc, cur, wr, wc, fr, fq); S.done(cur); }
        if (!has_next) break;
#pragma unroll
        for (int a = 0; a < 2; ++a)
#pragma unroll
            for (int b = 0; b < 2; ++b)
#pragma unroll
                for (int m = 0; m < 4; ++m)
#pragma unroll
                    for (int n = 0; n < 2; ++n) acc[a][b][m][n] = (f32x4){0.f, 0.f, 0.f, 0.f};
        cur = nxt; cA = nA; cB = nB; ++ui;
        if constexpr (ALIGN_EPI) { if (wr == 1) PG8_BAR; }
    }
    PG8_WAIT_V(0);
    if constexpr (!ALIGN_EPI) { if (wr == 0) PG8_BAR; }
    PG8_BAR;
    if constexpr (Epi::AFTER_DRAIN) { E.fused(acc, cur, wr, wc, fr, fq, lds, wid, lane); S.done(cur); }
#undef PG8_SA
#undef PG8_SB
#undef PG8_STAGE
#undef PG8_LDA
#undef PG8_LDB
#undef PG8_MMA
#undef PG8_WAIT_V
#undef PG8_WAIT_L
#undef PG8_BAR
#undef PG8_SCHED
}
}

#define GAS __attribute__((address_space(1)))
#define LAS __attribute__((address_space(3)))
typedef unsigned short bf16;
typedef unsigned v4u __attribute__((ext_vector_type(4)));
typedef unsigned v2u __attribute__((ext_vector_type(2)));
typedef float f32x4 __attribute__((ext_vector_type(4)));
typedef float f32x16 __attribute__((ext_vector_type(16)));
typedef short bf16x8 __attribute__((ext_vector_type(8)));
typedef short s16x4 __attribute__((ext_vector_type(4)));

constexpr int NWAVES = 8, NTHR = 512;
constexpr int DM = 2048, SEQ = 8192, NB = 128, NT = 4, MROWS = 8704, MS0 = 8192;
constexpr int N0 = 6656, N1 = 5648, N1P = 5888;
constexpr int C0_AB = 0, C0_AC = 1024, C0_AH = 2048, C0_AG = 3072, C0_Q = 4096, C0_K = 5120, C0_V = 5376, C0_G = 5632;
constexpr int C1_U = 0, C1_V = 1024, C1_CG = 2048, C1_Z = 3072, C1_X = 4096, C1_B = 5120, C1_C = 5376, C1_DT = 5632;
constexpr float EPS = 1e-6f, LOG2E = 1.4426950408889634f, QSCALE = 0.125f * 1.4426950408889634f, NEGBIG = -1e30f;
constexpr size_t O_YP = 0, O_YS = O_YP + 8192ull * 2048, O_PCA = O_YS + 512ull * 2048, O_SCA = O_PCA + 2048, O_PWK = O_SCA + 128ull * 2048,
                 O_PWV = O_PWK + 128ull * 256, O_SWK = O_PWV + 128ull * 256, O_SWV = O_SWK + 128ull * 128 * 256, O_SCV = O_SWV + 128ull * 128 * 256,
                 O_PCD = O_SCV + 128ull * 4 * 1024, O_SCD = O_PCD + 3 * 1536, O_PSSM = O_SCD + 128ull * 3 * 1536, O_SSSM = O_PSSM + 131072, O_END = O_SSSM + 128ull * 131072;
static_assert(O_END == 44571136ull, "output size");
constexpr size_t MiB = 1u << 20;
constexpr size_t WS_CTL = 0, CTL_ZERO_BYTES = 1 * MiB;
constexpr size_t WS_WT0 = 1 * MiB;
constexpr size_t WS_WO0 = WS_WT0 + (size_t)N0 * DM * 2;
constexpr size_t WS_WT1 = WS_WO0 + (size_t)DM * DM * 2;
constexpr size_t WS_WO1 = WS_WT1 + (size_t)N1P * DM * 2;
constexpr size_t WS_TRIL = WS_WO1 + (size_t)DM * DM * 2;
constexpr size_t WS_H = WS_TRIL + 8 * 128 * 128 * 2;
constexpr size_t WS_Z = WS_H + (size_t)MROWS * DM * 2;
constexpr size_t WS_Y = WS_Z + (size_t)MROWS * N0 * 2;
constexpr size_t WS_XA = WS_Y + (size_t)MROWS * DM * 2;
constexpr size_t WS_DTR = WS_XA + (size_t)SEQ * 1536 * 2;
constexpr size_t WS_ACS = WS_DTR + (size_t)MROWS * 16 * 4;
constexpr size_t WS_DTV = WS_ACS + (size_t)SEQ * 16 * 4;
constexpr size_t WS_CD = WS_DTV + (size_t)SEQ * 16 * 4;
constexpr size_t WS_VST = WS_CD + 64 * 16 * 4;
constexpr size_t WS_END = WS_VST + (size_t)SEQ * 2 * 4;
static_assert(WS_END <= 290ull * MiB, "workspace map");
static_assert((size_t)64 * 16 * 64 * 128 * 4 <= (size_t)MROWS * DM * 2, "CS fits in H");
constexpr int CW_BAR = 4096;
constexpr int LDS_BYTES = 147456, LDS_CTL_OFF = 147200;

#define RLX_AGENT __ATOMIC_RELAXED, __HIP_MEMORY_SCOPE_AGENT
__device__ __forceinline__ unsigned f2bf(float f) { unsigned u = __builtin_bit_cast(unsigned, f); return (u + 0x7fffu + ((u >> 16) & 1u)) >> 16; }
__device__ __forceinline__ unsigned pk2(float lo, float hi) { return f2bf(lo) | (f2bf(hi) << 16); }
__device__ __forceinline__ float bflo(unsigned w) { return __uint_as_float(w << 16); }
__device__ __forceinline__ float bfhi(unsigned w) { return __uint_as_float(w & 0xffff0000u); }
__device__ __forceinline__ float bf1(bf16 b) { return __uint_as_float((unsigned)b << 16); }
#define UNPACK8(v, f) do { f[0] = bflo(v.x); f[1] = bfhi(v.x); f[2] = bflo(v.y); f[3] = bfhi(v.y); f[4] = bflo(v.z); f[5] = bfhi(v.z); f[6] = bflo(v.w); f[7] = bfhi(v.w); } while (0)
__device__ __forceinline__ v4u pack8(const float* f) { v4u o; o.x = pk2(f[0], f[1]); o.y = pk2(f[2], f[3]); o.z = pk2(f[4], f[5]); o.w = pk2(f[6], f[7]); return o; }
__device__ __forceinline__ float silu(float x) { return x / (1.f + __expf(-x)); }
__device__ __forceinline__ float wave_sum(float v) {
#pragma unroll
    for (int o = 1; o < 64; o <<= 1) v += __shfl_xor(v, o);
    return v;
}
__device__ __forceinline__ float wave_max(float v) {
#pragma unroll
    for (int o = 1; o < 64; o <<= 1) v = fmaxf(v, __shfl_xor(v, o));
    return v;
}
__device__ __forceinline__ int crow(int r, int hi) { return (r & 3) + 8 * (r >> 2) + 4 * hi; }
#define MFMA32(a, b, c) __builtin_amdgcn_mfma_f32_32x32x16_bf16((a), (b), (c), 0, 0, 0)
__device__ __forceinline__ bf16x8 pack_frag(const f32x16& x, int s) {
    v4u p; p.x = pk2(x[8 * s + 0], x[8 * s + 1]); p.y = pk2(x[8 * s + 2], x[8 * s + 3]); p.z = pk2(x[8 * s + 4], x[8 * s + 5]); p.w = pk2(x[8 * s + 6], x[8 * s + 7]);
    return __builtin_bit_cast(bf16x8, p);
}
__device__ __forceinline__ bf16x8 frag_from_f32(const float* p) {
    const f32x4 a = *(const f32x4*)p, b = *(const f32x4*)(p + 4);
    v4u o; o.x = pk2(a[0], a[1]); o.y = pk2(a[2], a[3]); o.z = pk2(b[0], b[1]); o.w = pk2(b[2], b[3]);
    return __builtin_bit_cast(bf16x8, o);
}

#define XB_TMO      128
#define XB_XCNT(j)  (256  + 64 * (j))
#define XB_XSUB(j)  (1280 + 64 * (j))
#define XB_XGEN(j)  (2304 + 64 * (j))
#define XB_TOP      3328
#define XB_TOPGEN   3392
#define XCD_BAR_WORDS 3456
#define XB_SPIN_CAP (1u << 18)
__device__ __forceinline__ unsigned xb_ld(unsigned* p)              { return __hip_atomic_load(p, __ATOMIC_RELAXED, __HIP_MEMORY_SCOPE_AGENT); }
__device__ __forceinline__ unsigned xb_add(unsigned* p, unsigned v) { return __hip_atomic_fetch_add(p, v, __ATOMIC_RELAXED, __HIP_MEMORY_SCOPE_AGENT); }
__device__ __forceinline__ unsigned xb_xcc_id() { return (unsigned)__builtin_amdgcn_s_getreg((3 << 11) | 20) & 0xFu; }
#define XB_SPIN(cond, bar) do { unsigned _sp = 0; while (cond) { __builtin_amdgcn_s_sleep(1); \
    if ((++_sp & 255u) == 0u) { if (xb_ld(&(bar)[XB_TMO])) break; if (_sp > XB_SPIN_CAP) { atomicAdd(&(bar)[XB_TMO], 1u); break; } } } } while (0)
struct XcdBarrier { unsigned* bar; unsigned x; volatile LAS unsigned* st; };
__device__ __forceinline__ XcdBarrier xcd_barrier_post(unsigned* bar, volatile LAS unsigned* st) {
    XcdBarrier b; b.bar = bar; b.x = xb_xcc_id(); b.st = st;
    if (threadIdx.x == 0) (void)xb_add(&bar[XB_XCNT(b.x)], 1u);
    return b;
}
__device__ __forceinline__ void xcd_barrier_complete(unsigned* bar, unsigned x, unsigned& nloc, unsigned& nx) {
    const unsigned G = gridDim.x * gridDim.y * gridDim.z;
    unsigned sum, cnt, mine, sp = 0u;
    for (;;) {
        sum = 0u; cnt = 0u; mine = 0u;
#pragma unroll
        for (unsigned j = 0; j < 16; ++j) { const unsigned c = xb_ld(&bar[XB_XCNT(j)]); sum += c; cnt += (c > 0u) ? 1u : 0u; mine = (j == x) ? c : mine; }
        if (sum == G) break;
        __builtin_amdgcn_s_sleep(1);
        if ((++sp & 255u) == 0u) { if (xb_ld(&bar[XB_TMO])) break; if (sp > XB_SPIN_CAP) { atomicAdd(&bar[XB_TMO], 1u); break; } }
    }
    nloc = mine > 0u ? mine : 1u; nx = cnt > 0u ? cnt : 1u;
}
__device__ __forceinline__ void xcd_barrier(const XcdBarrier& b) {
    asm volatile("s_waitcnt vmcnt(0)" ::: "memory");
    __syncthreads();
    if (threadIdx.x == 0) {
        unsigned* bar = b.bar;
        __builtin_amdgcn_s_waitcnt(0);
        unsigned nloc = b.st[0], nx = b.st[1];
        if (nloc == 0u) { xcd_barrier_complete(bar, b.x, nloc, nx); b.st[0] = nloc; b.st[1] = nx; }
        const unsigned old = xb_add(&bar[XB_XSUB(b.x)], 1u);
        const unsigned gen = old / nloc;
        if (old + 1u == (gen + 1u) * nloc) {
            __builtin_amdgcn_fence(__ATOMIC_RELEASE, "agent");
            asm volatile("s_waitcnt vmcnt(0)" ::: "memory");
            const unsigned og = xb_add(&bar[XB_TOP], 1u);
            const unsigned tg = og / nx;
            if (og + 1u == (tg + 1u) * nx) xb_add(&bar[XB_TOPGEN], 1u);
            else XB_SPIN(xb_ld(&bar[XB_TOPGEN]) == tg, bar);
            __builtin_amdgcn_fence(__ATOMIC_ACQUIRE, "agent");
            xb_add(&bar[XB_XGEN(b.x)], 1u);
            asm volatile("s_waitcnt vmcnt(0)" ::: "memory");
        } else {
            XB_SPIN(xb_ld(&bar[XB_XGEN(b.x)]) == gen, bar);
            __builtin_amdgcn_fence(__ATOMIC_ACQUIRE, "agent");
            asm volatile("s_waitcnt vmcnt(0)" ::: "memory");
        }
    }
    __syncthreads();
}

struct Args { const float* in[28]; float* out; unsigned char* ws; int ph_lo, ph_hi; };

struct Frame {
    LAS unsigned char* lds;
    int tid, lane, wave, G, bid;
    const float* in[28];
    float* out; unsigned char* ws;
};
#define WSP(T, off) ((T*)(F.ws + (off)))
#define LDSP(T, off) ((LAS T*)(F.lds + (off)))

__device__ __forceinline__ void p0_transpose_item(const float* W, int K, int N, bf16* WT, LAS float* scr, int item, int nblk, int lane, int sc_lo, int sc_hi, float sc) {
    const int kb = item / nblk, nb = item % nblk, k0 = 64 * kb, n0 = 32 * nb;
    const int ncol = n0 + (lane & 31);
    const float mul = (ncol >= sc_lo && ncol < sc_hi) ? sc : 1.f;
#pragma unroll 8
    for (int i = 0; i < 32; ++i) { const int kk = 2 * i + (lane >> 5); scr[kk * 33 + (lane & 31)] = (ncol < N) ? W[(size_t)(k0 + kk) * N + ncol] * mul : 0.f; }
    asm volatile("s_waitcnt lgkmcnt(0)" ::: "memory");
    const int c = lane & 7;
#pragma unroll
    for (int j = 0; j < 4; ++j) { const int n = (lane >> 3) + 8 * j; const LAS float* s = scr + (8 * c) * 33 + n;
        v4u o; o.x = pk2(s[0 * 33], s[1 * 33]); o.y = pk2(s[2 * 33], s[3 * 33]); o.z = pk2(s[4 * 33], s[5 * 33]); o.w = pk2(s[6 * 33], s[7 * 33]);
        *(v4u*)(WT + (size_t)(n0 + n) * K + k0 + 8 * c) = o; }
    asm volatile("s_waitcnt lgkmcnt(0)" ::: "memory");
}
__device__ __forceinline__ void rms_row_to_bf16(const float* xrow, const float* g, bf16* orow, int lane) {
    f32x4 v[8]; float s = 0.f;
#pragma unroll
    for (int j = 0; j < 4; ++j) { v[2 * j] = *(const f32x4*)(xrow + 512 * j + 8 * lane); v[2 * j + 1] = *(const f32x4*)(xrow + 512 * j + 8 * lane + 4);
        s += (v[2 * j][0] * v[2 * j][0] + v[2 * j][1] * v[2 * j][1]) + (v[2 * j][2] * v[2 * j][2] + v[2 * j][3] * v[2 * j][3]);
        s += (v[2 * j + 1][0] * v[2 * j + 1][0] + v[2 * j + 1][1] * v[2 * j + 1][1]) + (v[2 * j + 1][2] * v[2 * j + 1][2] + v[2 * j + 1][3] * v[2 * j + 1][3]); }
    const float rstd = rsqrtf(wave_sum(s) * (1.f / DM) + EPS);
#pragma unroll
    for (int j = 0; j < 4; ++j) { const f32x4 g0 = *(const f32x4*)(g + 512 * j + 8 * lane), g1 = *(const f32x4*)(g + 512 * j + 8 * lane + 4);
        const f32x4 a = v[2 * j] * rstd * g0, b = v[2 * j + 1] * rstd * g1;
        v4u o; o.x = pk2(a[0], a[1]); o.y = pk2(a[2], a[3]); o.z = pk2(b[0], b[1]); o.w = pk2(b[2], b[3]);
        *(v4u*)(orow + 512 * j + 8 * lane) = o; }
}
__device__ __forceinline__ const float* xrow_ptr(const Frame& F, int m) { return m < MS0 ? F.in[0] + (size_t)m * DM : F.in[1] + (size_t)(m - MS0) * DM; }

__device__ __forceinline__ void p0_prologue(Frame& F) {
    LAS float* scr = LDSP(float, F.wave * 16384);
    const int gw = F.bid * NWAVES + F.wave, NGW = F.G * NWAVES;
    constexpr int I0 = 32 * (N0 / 32), I1 = 32 * (DM / 32), I2 = 32 * (N1P / 32), I3 = 32 * (DM / 32);
    constexpr int NITEMS = I0 + I1 + I2 + I3;
    for (int it = gw; it < NITEMS; it += NGW) {
        int r = it;
        if (r < I0) { p0_transpose_item(F.in[9], DM, N0, WSP(bf16, WS_WT0), scr, r, N0 / 32, F.lane, C0_Q, C0_K, QSCALE); continue; } r -= I0;
        if (r < I1) { p0_transpose_item(F.in[12], DM, DM, WSP(bf16, WS_WO0), scr, r, DM / 32, F.lane, 0, 0, 1.f); continue; } r -= I1;
        if (r < I2) { p0_transpose_item(F.in[15], DM, N1, WSP(bf16, WS_WT1), scr, r, N1P / 32, F.lane, 0, 0, 1.f); continue; } r -= I2;
        p0_transpose_item(F.in[26], DM, DM, WSP(bf16, WS_WO1), scr, r, DM / 32, F.lane, 0, 0, 1.f);
    }
    for (int m = gw; m < MROWS; m += NGW) rms_row_to_bf16(xrow_ptr(F, m), F.in[8], WSP(bf16, WS_H) + (size_t)m * DM, F.lane);
    const size_t gtid = (size_t)F.bid * NTHR + F.tid, gsz = (size_t)F.G * NTHR;
    for (size_t i = gtid; i < 8 * 128 * 128; i += gsz) { const int t = (int)((i >> 7) & 127), s = (int)(i & 127); WSP(bf16, WS_TRIL)[i] = (bf16)f2bf(s <= t ? F.in[18][i] : 0.f); }
    { const f32x4* ck = (const f32x4*)F.in[3]; const f32x4* cv = (const f32x4*)F.in[4]; f32x4* ok = (f32x4*)(F.out + O_SWK); f32x4* ov = (f32x4*)(F.out + O_SWV);
      for (size_t i = gtid; i < 128ull * 124 * 64; i += gsz) { const size_t b = i / (124 * 64), r = i % (124 * 64);
          ok[b * 128 * 64 + r] = ck[b * 128 * 64 + 4 * 64 + r]; ov[b * 128 * 64 + r] = cv[b * 128 * 64 + 4 * 64 + r]; } }
}

__device__ __forceinline__ int rel_bucket(int d) {
    if (d < 16) return d;
    const int large = 16 + (int)(logf((float)d * (1.f / 16.f)) / logf(8.f) * 16.f);
    return large < 31 ? large : 31;
}
constexpr int L2_BIAS = 0;
constexpr int L2_K = 8192;
constexpr int L2_VT = L2_K + 256 * 144;
constexpr int L2_SW = 8192;
constexpr int L2_SW_STRIDE = 12544;
static_assert(L2_VT + 64 * 520 <= LDS_CTL_OFF && L2_SW + 8 * L2_SW_STRIDE <= LDS_CTL_OFF, "P2 LDS");

__device__ __forceinline__ void attn_prompt_unit(Frame& F, int n, int hk) {
    const bf16* Z = WSP(bf16, WS_Z); bf16* Y = WSP(bf16, WS_Y);
    const int tid = F.tid, lane = F.lane, w = F.wave, l31 = lane & 31, hl = lane >> 5;
#pragma unroll
    for (int i = 0; i < 4; ++i) {
        const int item = tid + 512 * i, key = item >> 3, ch = item & 7, pos = 128 * (n - 1) + key;
        v4u kv = (v4u){0u, 0u, 0u, 0u}, vv = (v4u){0u, 0u, 0u, 0u};
        if (pos >= 0) { kv = *(const v4u*)(Z + (size_t)pos * N0 + C0_K + hk * 64 + ch * 8); vv = *(const v4u*)(Z + (size_t)pos * N0 + C0_V + hk * 64 + ch * 8); }
        *(LAS v4u*)(F.lds + L2_K + key * 144 + ch * 16) = kv;
        LAS bf16* vt = LDSP(bf16, L2_VT) + (ch * 8) * 260 + key;
        vt[0 * 260] = (bf16)(vv.x & 0xffffu); vt[1 * 260] = (bf16)(vv.x >> 16); vt[2 * 260] = (bf16)(vv.y & 0xffffu); vt[3 * 260] = (bf16)(vv.y >> 16);
        vt[4 * 260] = (bf16)(vv.z & 0xffffu); vt[5 * 260] = (bf16)(vv.z >> 16); vt[6 * 260] = (bf16)(vv.w & 0xffffu); vt[7 * 260] = (bf16)(vv.w >> 16);
    }
    __syncthreads();
    const int g = w >> 1, head = hk * 4 + g;
    const float sink2 = F.in[11][head] * LOG2E;
    const LAS float* biasd = LDSP(float, L2_BIAS) + head * 128;
    for (int qq = 0; qq < 2; ++qq) {
        const int qt = 2 * (w & 1) + qq;
        const int pos_q = 128 * n + 32 * qt + l31;
        const bf16* qrow = Z + (size_t)pos_q * N0 + C0_Q + head * 64 + 8 * hl;
        bf16x8 qf[4];
#pragma unroll
        for (int ks = 0; ks < 4; ++ks) qf[ks] = *(const bf16x8*)(qrow + 16 * ks);
        f32x16 S[5];
#pragma unroll
        for (int k5 = 0; k5 < 5; ++k5) {
            f32x16 acc = {};
            const LAS unsigned char* kp = F.lds + L2_K + (32 * (qt + k5) + l31) * 144 + 16 * hl;
#pragma unroll
            for (int ks = 0; ks < 4; ++ks) { const bf16x8 a = *(const LAS bf16x8*)(kp + 32 * ks); acc = MFMA32(a, qf[ks], acc); }
            S[k5] = acc;
        }
        float mx = NEGBIG;
#pragma unroll
        for (int k5 = 0; k5 < 5; ++k5)
#pragma unroll
            for (int r = 0; r < 16; ++r) {
                const int cr = crow(r, hl), dist = 128 - 32 * k5 + l31 - cr, j = 32 * (qt + k5) + cr;
                const bool valid = (dist >= 0) && (dist < 128) && (n > 0 || j >= 128);
                const float b = biasd[dist & 127];
                const float s = valid ? S[k5][r] + b : NEGBIG;
                S[k5][r] = s; mx = fmaxf(mx, s);
            }
        mx = fmaxf(mx, __shfl_xor(mx, 32));
        mx = fmaxf(mx, sink2);
        float sum = 0.f;
#pragma unroll
        for (int k5 = 0; k5 < 5; ++k5)
#pragma unroll
            for (int r = 0; r < 16; ++r) { const float p = exp2f(S[k5][r] - mx); S[k5][r] = p; sum += p; }
        sum += __shfl_xor(sum, 32);
        const float inv = 1.f / (sum + exp2f(sink2 - mx));
        f32x16 o0 = {}, o1 = {};
#pragma unroll
        for (int k5 = 0; k5 < 5; ++k5)
#pragma unroll
            for (int sp = 0; sp < 2; ++sp) {
                const bf16x8 pf = pack_frag(S[k5], sp);
                const int kb = 32 * (qt + k5) + 16 * sp + 4 * hl;
                const LAS bf16* v0 = LDSP(bf16, L2_VT) + l31 * 260 + kb;
                const LAS bf16* v1 = v0 + 32 * 260;
                const s16x4 a0 = *(const LAS s16x4*)(v0), a1 = *(const LAS s16x4*)(v0 + 8);
                const s16x4 b0 = *(const LAS s16x4*)(v1), b1 = *(const LAS s16x4*)(v1 + 8);
                const bf16x8 A0 = (bf16x8){a0[0], a0[1], a0[2], a0[3], a1[0], a1[1], a1[2], a1[3]};
                const bf16x8 A1 = (bf16x8){b0[0], b0[1], b0[2], b0[3], b1[0], b1[1], b1[2], b1[3]};
                o0 = MFMA32(A0, pf, o0); o1 = MFMA32(A1, pf, o1);
            }
        const bf16* grow = Z + (size_t)pos_q * N0 + C0_G + head * 64;
        bf16* yrow = Y + (size_t)pos_q * DM + 1024 + head * 64;
#pragma unroll
        for (int dt = 0; dt < 2; ++dt)
#pragma unroll
            for (int q4 = 0; q4 < 4; ++q4) {
                const int d = 32 * dt + 8 * q4 + 4 * hl;
                const v2u gz = *(const v2u*)(grow + d);
                const float g0 = bflo(gz.x), g1 = bfhi(gz.x), g2 = bflo(gz.y), g3 = bfhi(gz.y);
                const float a = (dt ? o1[4 * q4 + 0] : o0[4 * q4 + 0]) * inv, b = (dt ? o1[4 * q4 + 1] : o0[4 * q4 + 1]) * inv,
                            c = (dt ? o1[4 * q4 + 2] : o0[4 * q4 + 2]) * inv, e = (dt ? o1[4 * q4 + 3] : o0[4 * q4 + 3]) * inv;
                v2u o; o.x = pk2(a * silu(g0), b * silu(g1)); o.y = pk2(c * silu(g2), e * silu(g3));
                *(v2u*)(yrow + d) = o;
            }
    }
    __syncthreads();
}

__device__ __forceinline__ void attn_sample_unit(Frame& F, int b, int hk) {
    const bf16* Z = WSP(bf16, WS_Z); bf16* Y = WSP(bf16, WS_Y);
    const int lane = F.lane, w = F.wave;
    LAS float* qs = LDSP(float, L2_SW + w * L2_SW_STRIDE);
    LAS float* ps = qs + 1024;
    const float* ck = F.in[3]; const float* cv = F.in[4];
    {
        const int qi = lane >> 2, d0 = (lane & 3) * 16, gq = qi >> 2, t = qi & 3;
        const bf16* qp = Z + (size_t)(MS0 + 4 * b + t) * N0 + C0_Q + (hk * 4 + gq) * 64 + d0;
        const v4u a = *(const v4u*)qp, c = *(const v4u*)(qp + 8);
        float f[8]; UNPACK8(a, f);
#pragma unroll
        for (int i = 0; i < 8; ++i) qs[qi * 64 + d0 + i] = f[i];
        UNPACK8(c, f);
#pragma unroll
        for (int i = 0; i < 8; ++i) qs[qi * 64 + d0 + 8 + i] = f[i];
    }
#pragma unroll 1
    for (int pss = 0; pss < 3; ++pss) {
        const int j = 64 * pss + lane;
        if (j < 132) {
            float acc[16];
#pragma unroll
            for (int qi = 0; qi < 16; ++qi) acc[qi] = 0.f;
#pragma unroll 1
            for (int dc = 0; dc < 4; ++dc) {
                float k[16];
                if (j < 128) { const float* kp = ck + ((size_t)(b * 128 + j) * 4 + hk) * 64 + 16 * dc;
#pragma unroll
                    for (int i = 0; i < 4; ++i) { const f32x4 t4 = *(const f32x4*)(kp + 4 * i); k[4 * i] = t4[0]; k[4 * i + 1] = t4[1]; k[4 * i + 2] = t4[2]; k[4 * i + 3] = t4[3]; } }
                else { const bf16* kp = Z + (size_t)(MS0 + 4 * b + (j - 128)) * N0 + C0_K + hk * 64 + 16 * dc;
                    const v4u a = *(const v4u*)kp, c = *(const v4u*)(kp + 8);
                    k[0] = bflo(a.x); k[1] = bfhi(a.x); k[2] = bflo(a.y); k[3] = bfhi(a.y); k[4] = bflo(a.z); k[5] = bfhi(a.z); k[6] = bflo(a.w); k[7] = bfhi(a.w);
                    k[8] = bflo(c.x); k[9] = bfhi(c.x); k[10] = bflo(c.y); k[11] = bfhi(c.y); k[12] = bflo(c.z); k[13] = bfhi(c.z); k[14] = bflo(c.w); k[15] = bfhi(c.w); }
#pragma unroll
                for (int qi = 0; qi < 16; ++qi) {
#pragma unroll
                    for (int i = 0; i < 4; ++i) { const f32x4 q4 = *(const LAS f32x4*)(qs + qi * 64 + 16 * dc + 4 * i);
                        acc[qi] += k[4 * i] * q4[0] + k[4 * i + 1] * q4[1] + k[4 * i + 2] * q4[2] + k[4 * i + 3] * q4[3]; }
                }
            }
#pragma unroll
            for (int qi = 0; qi < 16; ++qi) {
                const int t = qi & 3, gq = qi >> 2, dist = 128 + t - j;
                const bool valid = (dist >= 0) && (dist < 128);
                const float bb = LDSP(float, L2_BIAS)[(hk * 4 + gq) * 128 + (dist & 127)];
                ps[j * 16 + qi] = valid ? acc[qi] + bb : NEGBIG;
            }
        }
    }
#pragma unroll 1
    for (int qi = 0; qi < 16; ++qi) {
        const float sink2 = F.in[11][hk * 4 + (qi >> 2)] * LOG2E;
        const float s0 = ps[lane * 16 + qi], s1 = ps[(64 + lane) * 16 + qi], s2 = (lane < 4) ? ps[(128 + lane) * 16 + qi] : NEGBIG;
        float m = fmaxf(fmaxf(s0, s1), s2);
        m = fmaxf(wave_max(m), sink2);
        const float p0 = exp2f(s0 - m), p1 = exp2f(s1 - m), p2 = exp2f(s2 - m);
        const float inv = 1.f / (wave_sum(p0 + p1 + p2) + exp2f(sink2 - m));
        ps[lane * 16 + qi] = p0 * inv; ps[(64 + lane) * 16 + qi] = p1 * inv;
        if (lane < 4) ps[(128 + lane) * 16 + qi] = p2 * inv;
    }
    float o[16];
#pragma unroll
    for (int qi = 0; qi < 16; ++qi) o[qi] = 0.f;
#pragma unroll 2
    for (int j = 0; j < 132; ++j) {
        const float v = (j < 128) ? cv[((size_t)(b * 128 + j) * 4 + hk) * 64 + lane] : bf1(Z[(size_t)(MS0 + 4 * b + (j - 128)) * N0 + C0_V + hk * 64 + lane]);
#pragma unroll
        for (int i = 0; i < 4; ++i) { const f32x4 p4 = *(const LAS f32x4*)(ps + j * 16 + 4 * i);
            o[4 * i] += p4[0] * v; o[4 * i + 1] += p4[1] * v; o[4 * i + 2] += p4[2] * v; o[4 * i + 3] += p4[3] * v; }
    }
#pragma unroll
    for (int qi = 0; qi < 16; ++qi) {
        const int t = qi & 3, head = hk * 4 + (qi >> 2); const size_t m = MS0 + 4 * b + t;
        const float gate = bf1(Z[m * N0 + C0_G + head * 64 + lane]);
        Y[m * DM + 1024 + head * 64 + lane] = (bf16)f2bf(o[qi] * silu(gate));
    }
}

__device__ __forceinline__ void p2_mixers0(Frame& F) {
    const bf16* Z = WSP(bf16, WS_Z); bf16* Y = WSP(bf16, WS_Y);
    for (int i = F.tid; i < 16 * 128; i += NTHR) { const int head = i >> 7, d = i & 127; LDSP(float, L2_BIAS)[i] = F.in[7][rel_bucket(d) * 16 + head] * LOG2E; }
    __syncthreads();
#ifndef NO_PROMPT
    for (int u = F.bid; u < 256; u += F.G) attn_prompt_unit(F, u >> 2, u & 3);
#endif
    __syncthreads();
#ifndef NO_SAMPLE
    for (int u = F.wave * F.G + F.bid; u < 512; u += NWAVES * F.G) attn_sample_unit(F, u >> 2, u & 3);
#endif
    const size_t gtid = (size_t)F.bid * NTHR + F.tid, gsz = (size_t)F.G * NTHR;
    const float* cw = F.in[10]; const float* sca = F.in[2];
    for (size_t it = gtid; it < (size_t)MROWS * 128; it += gsz) {
        const int m = (int)(it >> 7), c0 = (int)(it & 127) * 8;
        const bf16* zr = Z + (size_t)m * N0;
        float ac[8], ah[8], s0[8], s1[8], s2[8];
        { const v4u a = *(const v4u*)(zr + C0_AC + c0), h = *(const v4u*)(zr + C0_AH + c0); UNPACK8(a, ac); UNPACK8(h, ah); }
#pragma unroll
        for (int i = 0; i < 8; ++i) s2[i] = ac[i] * ah[i];
        int t, b = 0; bool samp = m >= MS0;
        if (!samp) t = m; else { b = (m - MS0) >> 2; t = (m - MS0) & 3; }
        if (t >= 1) { const v4u a = *(const v4u*)(zr - N0 + C0_AC + c0), h = *(const v4u*)(zr - N0 + C0_AH + c0); UNPACK8(a, ac); UNPACK8(h, ah);
#pragma unroll
            for (int i = 0; i < 8; ++i) s1[i] = ac[i] * ah[i]; }
        else if (samp) {
#pragma unroll
            for (int i = 0; i < 8; ++i) s1[i] = sca[(size_t)(b * 2 + 1) * 1024 + c0 + i]; }
        else {
#pragma unroll
            for (int i = 0; i < 8; ++i) s1[i] = 0.f; }
        if (t >= 2) { const v4u a = *(const v4u*)(zr - 2 * N0 + C0_AC + c0), h = *(const v4u*)(zr - 2 * N0 + C0_AH + c0); UNPACK8(a, ac); UNPACK8(h, ah);
#pragma unroll
            for (int i = 0; i < 8; ++i) s0[i] = ac[i] * ah[i]; }
        else if (samp) {
#pragma unroll
            for (int i = 0; i < 8; ++i) s0[i] = sca[(size_t)(b * 2 + t) * 1024 + c0 + i]; }
        else {
#pragma unroll
            for (int i = 0; i < 8; ++i) s0[i] = 0.f; }
        float ab[8], ag[8], y[8];
        { const v4u a = *(const v4u*)(zr + C0_AB + c0), h = *(const v4u*)(zr + C0_AG + c0); UNPACK8(a, ab); UNPACK8(h, ag); }
#pragma unroll
        for (int i = 0; i < 8; ++i) { const float cv_ = cw[c0 + i] * s0[i] + cw[1024 + c0 + i] * s1[i] + cw[2048 + c0 + i] * s2[i]; y[i] = ab[i] * cv_ * silu(ag[i]); }
        *(v4u*)(Y + (size_t)m * DM + c0) = pack8(y);
        if (!samp && m >= SEQ - 2) {
#pragma unroll
            for (int i = 0; i < 8; ++i) F.out[O_PCA + (size_t)(m - (SEQ - 2)) * 1024 + c0 + i] = s2[i]; }
        if (samp && t >= 2) {
#pragma unroll
            for (int i = 0; i < 8; ++i) F.out[O_SCA + (size_t)(b * 2 + (t - 2)) * 1024 + c0 + i] = s2[i]; }
    }
    for (size_t it = gtid; it < 128ull * 32; it += gsz) {
        const int j = (int)(it >> 5), c0 = (int)(it & 31) * 8; const bf16* zr = Z + (size_t)(SEQ - 128 + j) * N0;
        float f[8]; { const v4u a = *(const v4u*)(zr + C0_K + c0); UNPACK8(a, f); }
#pragma unroll
        for (int i = 0; i < 8; ++i) F.out[O_PWK + (size_t)j * 256 + c0 + i] = f[i];
        { const v4u a = *(const v4u*)(zr + C0_V + c0); UNPACK8(a, f); }
#pragma unroll
        for (int i = 0; i < 8; ++i) F.out[O_PWV + (size_t)j * 256 + c0 + i] = f[i];
    }
    for (size_t it = gtid; it < 512ull * 32; it += gsz) {
        const int r = (int)(it >> 5), c0 = (int)(it & 31) * 8, b = r >> 2, t = r & 3; const bf16* zr = Z + (size_t)(MS0 + r) * N0;
        float f[8]; { const v4u a = *(const v4u*)(zr + C0_K + c0); UNPACK8(a, f); }
#pragma unroll
        for (int i = 0; i < 8; ++i) F.out[O_SWK + ((size_t)b * 128 + 124 + t) * 256 + c0 + i] = f[i];
        { const v4u a = *(const v4u*)(zr + C0_V + c0); UNPACK8(a, f); }
#pragma unroll
        for (int i = 0; i < 8; ++i) F.out[O_SWV + ((size_t)b * 128 + 124 + t) * 256 + c0 + i] = f[i];
    }
}

__device__ __forceinline__ void row_pass(Frame& F, bool layer0, const float* gpost, const float* gpre, bf16* H) {
    const bf16* Yo = WSP(bf16, WS_Z);
    const int gw = F.bid * NWAVES + F.wave, NGW = F.G * NWAVES, lane = F.lane;
    for (int m = gw; m < MROWS; m += NGW) {
        float yv[32]; float ss = 0.f;
#pragma unroll
        for (int j = 0; j < 4; ++j) { const v4u a = *(const v4u*)(Yo + (size_t)m * DM + 512 * j + 8 * lane); float* f = yv + 8 * j; UNPACK8(a, f);
#pragma unroll
            for (int i = 0; i < 8; ++i) ss += f[i] * f[i]; }
        const float rstd = rsqrtf(wave_sum(ss) * (1.f / DM) + EPS);
        const float* xin = layer0 ? xrow_ptr(F, m) : F.out + (size_t)m * DM;
        float* xo = F.out + (size_t)m * DM;
        float s1 = 0.f;
#pragma unroll
        for (int j = 0; j < 4; ++j) {
            const int e = 512 * j + 8 * lane;
            const f32x4 x0 = *(const f32x4*)(xin + e), x1 = *(const f32x4*)(xin + e + 4), g0 = *(const f32x4*)(gpost + e), g1 = *(const f32x4*)(gpost + e + 4);
            f32x4 r0, r1;
#pragma unroll
            for (int i = 0; i < 4; ++i) { r0[i] = x0[i] + yv[8 * j + i] * rstd * g0[i]; r1[i] = x1[i] + yv[8 * j + 4 + i] * rstd * g1[i]; }
            *(f32x4*)(xo + e) = r0; *(f32x4*)(xo + e + 4) = r1;
#pragma unroll
            for (int i = 0; i < 4; ++i) { yv[8 * j + i] = r0[i]; yv[8 * j + 4 + i] = r1[i]; s1 += r0[i] * r0[i] + r1[i] * r1[i]; }
        }
        if (H != nullptr) {
            const float rs1 = rsqrtf(wave_sum(s1) * (1.f / DM) + EPS);
#pragma unroll
            for (int j = 0; j < 4; ++j) { const int e = 512 * j + 8 * lane; const f32x4 g0 = *(const f32x4*)(gpre + e), g1 = *(const f32x4*)(gpre + e + 4);
                float f[8];
#pragma unroll
                for (int i = 0; i < 4; ++i) { f[i] = yv[8 * j + i] * rs1 * g0[i]; f[4 + i] = yv[8 * j + 4 + i] * rs1 * g1[i]; }
                *(v4u*)(H + (size_t)m * DM + e) = pack8(f); }
        }
    }
}

__device__ __forceinline__ float softplus_f(float x) { return fmaxf(x, 0.f) + log1pf(__expf(-fabsf(x))); }

__device__ __forceinline__ void conv_act8(const bf16* Z, const float* cw, const float* cb, int row, int ch0, float* act) {
    float a[8];
#pragma unroll
    for (int i = 0; i < 8; ++i) a[i] = cb[ch0 + i];
#pragma unroll
    for (int j = 0; j < 4; ++j) {
        const int r = row - 3 + j;
        if (r >= 0) { const v4u v = *(const v4u*)(Z + (size_t)r * N1P + C1_X + ch0); float f[8]; UNPACK8(v, f);
#pragma unroll
            for (int i = 0; i < 8; ++i) a[i] += cw[j * 1536 + ch0 + i] * f[i]; }
    }
#pragma unroll
    for (int i = 0; i < 8; ++i) act[i] = silu(a[i]);
}

constexpr int LA_BT = 0;
constexpr int LA_XW = 34816;
constexpr int LA_ACS = LA_XW + 69632;
constexpr int LA_DT = LA_ACS + 2048;
constexpr int LA_SC = LA_DT + 2048;
static_assert(LA_SC + 2048 <= LDS_CTL_OFF, "P6a LDS");
__device__ __forceinline__ void p6a_unit(Frame& F, int c, int gi, int hq) {
    const bf16* Z = WSP(bf16, WS_Z); bf16* XA = WSP(bf16, WS_XA);
    const float* cw = F.in[20]; const float* cb = F.in[21];
    const int tid = F.tid, lane = F.lane, w = F.wave, T0 = 128 * c;
    if (w < 4) {
        const int hh = gi * 8 + hq * 4 + w;
        const float a = -__expf(F.in[23][hh]), bias = F.in[22][hh];
        const float d0 = softplus_f(WSP(float, WS_DTR)[(size_t)(T0 + 2 * lane) * 16 + hh] + bias), d1 = softplus_f(WSP(float, WS_DTR)[(size_t)(T0 + 2 * lane + 1) * 16 + hh] + bias);
        const float v0 = d0 * a, v1 = d1 * a;
        float inc = v0 + v1;
#pragma unroll
        for (int o = 1; o < 64; o <<= 1) { const float t = __shfl_up(inc, o); if (lane >= o) inc += t; }
        const float a1 = inc, a0 = inc - v1;
        const float total = __shfl(inc, 63);
        LDSP(float, LA_ACS)[w * 128 + 2 * lane] = a0; LDSP(float, LA_ACS)[w * 128 + 2 * lane + 1] = a1;
        LDSP(float, LA_DT)[w * 128 + 2 * lane] = d0; LDSP(float, LA_DT)[w * 128 + 2 * lane + 1] = d1;
        LDSP(float, LA_SC)[w * 128 + 2 * lane] = __expf(total - a0) * d0; LDSP(float, LA_SC)[w * 128 + 2 * lane + 1] = __expf(total - a1) * d1;
        WSP(float, WS_ACS)[(size_t)(T0 + 2 * lane) * 16 + hh] = a0; WSP(float, WS_ACS)[(size_t)(T0 + 2 * lane + 1) * 16 + hh] = a1;
        WSP(float, WS_DTV)[(size_t)(T0 + 2 * lane) * 16 + hh] = d0; WSP(float, WS_DTV)[(size_t)(T0 + 2 * lane + 1) * 16 + hh] = d1;
        if (lane == 0) WSP(float, WS_CD)[c * 16 + hh] = __expf(total);
    }
    __syncthreads();
#pragma unroll
    for (int i = 0; i < 4; ++i) {
        const int item = tid + 512 * i, s = item >> 4, ch8 = item & 15;
        float act[8]; conv_act8(Z, cw, cb, T0 + s, 1024 + gi * 128 + ch8 * 8, act);
        LAS bf16* bt = LDSP(bf16, LA_BT) + (ch8 * 8) * 136 + s;
#pragma unroll
        for (int k = 0; k < 8; ++k) bt[k * 136] = (bf16)f2bf(act[k]);
        if (hq == 0) *(v4u*)(XA + (size_t)(T0 + s) * 1536 + 1024 + gi * 128 + ch8 * 8) = pack8(act);
        else { conv_act8(Z, cw, cb, T0 + s, 1280 + gi * 128 + ch8 * 8, act); *(v4u*)(XA + (size_t)(T0 + s) * 1536 + 1280 + gi * 128 + ch8 * 8) = pack8(act); }
    }
#pragma unroll
    for (int i = 0; i < 8; ++i) {
        const int item = tid + 512 * i, s = item >> 5, ch = item & 31, h4 = ch >> 3, p0 = (ch & 7) * 8;
        const int chan = (gi * 8 + hq * 4 + h4) * 64 + p0;
        float act[8]; conv_act8(Z, cw, cb, T0 + s, chan, act);
        *(v4u*)(XA + (size_t)(T0 + s) * 1536 + chan) = pack8(act);
        const float scl = LDSP(float, LA_SC)[h4 * 128 + s];
        LAS bf16* xw = LDSP(bf16, LA_XW) + (h4 * 64 + p0) * 136 + s;
#pragma unroll
        for (int k = 0; k < 8; ++k) xw[k * 136] = (bf16)f2bf(act[k] * scl);
    }
    __syncthreads();
    {
        const int h4 = w >> 1, nh = w & 1, l31 = lane & 31, hl = lane >> 5, hh = gi * 8 + hq * 4 + h4;
        f32x16 acc[2][2] = {};
#pragma unroll
        for (int ks = 0; ks < 8; ++ks) {
            bf16x8 a[2], b[2];
#pragma unroll
            for (int pt = 0; pt < 2; ++pt) a[pt] = *(const LAS bf16x8*)(LDSP(bf16, LA_XW) + (h4 * 64 + 32 * pt + l31) * 136 + 16 * ks + 8 * hl);
#pragma unroll
            for (int n2 = 0; n2 < 2; ++n2) b[n2] = *(const LAS bf16x8*)(LDSP(bf16, LA_BT) + (32 * (2 * nh + n2) + l31) * 136 + 16 * ks + 8 * hl);
#pragma unroll
            for (int pt = 0; pt < 2; ++pt)
#pragma unroll
                for (int n2 = 0; n2 < 2; ++n2) acc[pt][n2] = MFMA32(a[pt], b[n2], acc[pt][n2]);
        }
        float* cs = WSP(float, WS_H) + ((size_t)(c * 16 + hh) * 64) * 128;
#pragma unroll
        for (int pt = 0; pt < 2; ++pt)
#pragma unroll
            for (int n2 = 0; n2 < 2; ++n2)
#pragma unroll
                for (int r = 0; r < 16; ++r) cs[(size_t)(32 * pt + crow(r, hl)) * 128 + 32 * (2 * nh + n2) + l31] = acc[pt][n2][r];
    }
    {
#pragma unroll
        for (int rr = 0; rr < 4; ++rr) {
            const int row = T0 + 32 * (2 * gi + hq) + 4 * w + rr;
            const bf16* vp = Z + (size_t)row * N1P + C1_V;
            float f[16]; { const v4u a = *(const v4u*)(vp + 8 * lane), b2 = *(const v4u*)(vp + 512 + 8 * lane); UNPACK8(a, f); float* f2 = f + 8; UNPACK8(b2, f2); }
            float s = 0.f;
#pragma unroll
            for (int i = 0; i < 16; ++i) s += f[i];
            const float mean = wave_sum(s) * (1.f / 1024.f);
            float q = 0.f;
#pragma unroll
            for (int i = 0; i < 16; ++i) { const float d = f[i] - mean; q += d * d; }
            const float rstd = rsqrtf(wave_sum(q) * (1.f / 1024.f) + EPS);
            if (lane == 0) { WSP(float, WS_VST)[2 * row] = mean; WSP(float, WS_VST)[2 * row + 1] = rstd; }
        }
    }
    __syncthreads();
}

__device__ __forceinline__ void p6b_scan(Frame& F) {
    float* cs = WSP(float, WS_H); const float* cd = WSP(float, WS_CD);
    for (int e = F.bid * NTHR + F.tid; e < 131072; e += F.G * NTHR) {
        const int hh = e >> 13; float st = 0.f;
        for (int c0 = 0; c0 < 64; c0 += 8) {
            float s[8];
#pragma unroll
            for (int i = 0; i < 8; ++i) s[i] = cs[(size_t)(c0 + i) * 131072 + e];
#pragma unroll
            for (int i = 0; i < 8; ++i) { cs[(size_t)(c0 + i) * 131072 + e] = st; st = cd[(c0 + i) * 16 + hh] * st + s[i]; }
        }
        F.out[O_PSSM + e] = st;
    }
}

constexpr int LC_XT = 0;
constexpr int LC_ACS = 135168;
constexpr int LC_DT = LC_ACS + 4096;
constexpr int LC_SSQ = LC_DT + 4096;
static_assert(LC_SSQ + 2048 <= LDS_CTL_OFF, "P6c LDS");
__device__ __forceinline__ void p6c_ssd_unit(Frame& F, int c, int gi, int th) {
    const bf16* Z = WSP(bf16, WS_Z); const bf16* XA = WSP(bf16, WS_XA); bf16* Y = WSP(bf16, WS_Y);
    const int tid = F.tid, lane = F.lane, w = F.wave, T0 = 128 * c, l31 = lane & 31, hl = lane >> 5;
    const int ns = 64 * (th + 1);
    for (int item = tid; item < ns * 64; item += NTHR) {
        const int s = item >> 6, ch = item & 63, h8 = ch >> 3, p0 = (ch & 7) * 8;
        const v4u v = *(const v4u*)(XA + (size_t)(T0 + s) * 1536 + (gi * 8 + h8) * 64 + p0);
        LAS bf16* xt = LDSP(bf16, LC_XT) + (h8 * 64 + p0) * 132 + s;
        xt[0 * 132] = (bf16)(v.x & 0xffffu); xt[1 * 132] = (bf16)(v.x >> 16); xt[2 * 132] = (bf16)(v.y & 0xffffu); xt[3 * 132] = (bf16)(v.y >> 16);
        xt[4 * 132] = (bf16)(v.z & 0xffffu); xt[5 * 132] = (bf16)(v.z >> 16); xt[6 * 132] = (bf16)(v.w & 0xffffu); xt[7 * 132] = (bf16)(v.w >> 16);
    }
    for (int i = tid; i < 8 * 128; i += NTHR) { const int h8 = i >> 7, s = i & 127;
        LDSP(float, LC_ACS)[i] = WSP(float, WS_ACS)[(size_t)(T0 + s) * 16 + gi * 8 + h8]; LDSP(float, LC_DT)[i] = WSP(float, WS_DTV)[(size_t)(T0 + s) * 16 + gi * 8 + h8]; }
    __syncthreads();
    const int hh = gi * 8 + w;
    const float dskip = F.in[24][hh];
    const LAS float* acsL = LDSP(float, LC_ACS) + w * 128; const LAS float* dtL = LDSP(float, LC_DT) + w * 128;
    const float* hprev = WSP(float, WS_H) + ((size_t)(c * 16 + hh) * 64) * 128;
    f32x16 G[2][2];
    float ssq[2];
#pragma unroll
    for (int t2 = 0; t2 < 2; ++t2) {
        const int tt = 2 * th + t2, tl = 32 * tt + l31;
        const float acs_t = acsL[tl];
        bf16x8 cf[8];
#pragma unroll
        for (int ks = 0; ks < 8; ++ks) cf[ks] = *(const bf16x8*)(XA + (size_t)(T0 + tl) * 1536 + 1280 + gi * 128 + 16 * ks + 8 * hl);
        f32x16 acc[2] = {};
#pragma unroll
        for (int ks = 0; ks < 8; ++ks)
#pragma unroll
            for (int pt = 0; pt < 2; ++pt) { const bf16x8 a = frag_from_f32(hprev + (size_t)(32 * pt + l31) * 128 + 16 * ks + 8 * hl); acc[pt] = MFMA32(a, cf[ks], acc[pt]); }
        const float ea = __expf(acs_t);
#pragma unroll
        for (int pt = 0; pt < 2; ++pt)
#pragma unroll
            for (int r = 0; r < 16; ++r) acc[pt][r] *= ea;
        for (int st = 0; st <= tt; ++st) {
            f32x16 cb = {};
#pragma unroll
            for (int ks = 0; ks < 8; ++ks) { const bf16x8 b = *(const bf16x8*)(XA + (size_t)(T0 + 32 * st + l31) * 1536 + 1024 + gi * 128 + 16 * ks + 8 * hl); cb = MFMA32(b, cf[ks], cb); }
#pragma unroll
            for (int q4 = 0; q4 < 4; ++q4) {
                const int sb = 32 * st + 8 * q4 + 4 * hl;
                const f32x4 as4 = *(const LAS f32x4*)(acsL + sb), dt4 = *(const LAS f32x4*)(dtL + sb);
#pragma unroll
                for (int i = 0; i < 4; ++i) {
                    const int s = sb + i;
                    float wv = cb[4 * q4 + i] * __expf(fminf(acs_t - as4[i], 0.f)) * dt4[i];
                    wv = (s <= tl) ? wv : 0.f;
                    wv += (s == tl) ? dskip : 0.f;
                    cb[4 * q4 + i] = wv;
                }
            }
#pragma unroll
            for (int sp = 0; sp < 2; ++sp) {
                const bf16x8 wf = pack_frag(cb, sp);
#pragma unroll
                for (int pt = 0; pt < 2; ++pt) {
                    const LAS bf16* xp = LDSP(bf16, LC_XT) + (w * 64 + 32 * pt + l31) * 132 + 32 * st + 16 * sp + 4 * hl;
                    const s16x4 a0 = *(const LAS s16x4*)(xp), a1 = *(const LAS s16x4*)(xp + 8);
                    const bf16x8 A = (bf16x8){a0[0], a0[1], a0[2], a0[3], a1[0], a1[1], a1[2], a1[3]};
                    acc[pt] = MFMA32(A, wf, acc[pt]);
                }
            }
        }
        float q = 0.f;
        const bf16* zrow = Z + (size_t)(T0 + tl) * N1P + C1_Z + hh * 64;
#pragma unroll
        for (int pt = 0; pt < 2; ++pt)
#pragma unroll
            for (int q4 = 0; q4 < 4; ++q4) {
                const v2u zz = *(const v2u*)(zrow + 32 * pt + 8 * q4 + 4 * hl);
                const float z0 = bflo(zz.x), z1 = bfhi(zz.x), z2 = bflo(zz.y), z3 = bfhi(zz.y);
                const float g0 = acc[pt][4 * q4] * silu(z0), g1 = acc[pt][4 * q4 + 1] * silu(z1), g2 = acc[pt][4 * q4 + 2] * silu(z2), g3 = acc[pt][4 * q4 + 3] * silu(z3);
                G[t2][pt][4 * q4] = g0; G[t2][pt][4 * q4 + 1] = g1; G[t2][pt][4 * q4 + 2] = g2; G[t2][pt][4 * q4 + 3] = g3;
                q += (g0 * g0 + g1 * g1) + (g2 * g2 + g3 * g3);
            }
        q += __shfl_xor(q, 32);
        ssq[t2] = q;
        if (hl == 0) LDSP(float, LC_SSQ)[w * 64 + 32 * t2 + l31] = q;
    }
    __syncthreads();
    const float* gng = F.in[25] + hh * 64;
#pragma unroll
    for (int t2 = 0; t2 < 2; ++t2) {
        float tot = 0.f;
#pragma unroll
        for (int k = 0; k < 8; ++k) tot += LDSP(float, LC_SSQ)[k * 64 + 32 * t2 + l31];
        const float rstd = rsqrtf(tot * (1.f / 512.f) + EPS);
        const int tl = 32 * (2 * th + t2) + l31;
        bf16* yrow = Y + (size_t)(T0 + tl) * DM + 1024 + hh * 64;
#pragma unroll
        for (int pt = 0; pt < 2; ++pt)
#pragma unroll
            for (int q4 = 0; q4 < 4; ++q4) {
                const int p = 32 * pt + 8 * q4 + 4 * hl;
                const f32x4 gg = *(const f32x4*)(gng + p);
                v2u o; o.x = pk2(G[t2][pt][4 * q4] * rstd * gg[0], G[t2][pt][4 * q4 + 1] * rstd * gg[1]); o.y = pk2(G[t2][pt][4 * q4 + 2] * rstd * gg[2], G[t2][pt][4 * q4 + 3] * rstd * gg[3]);
                *(v2u*)(yrow + p) = o;
            }
    }
    (void)ssq;
    __syncthreads();
}

constexpr int LM_VT = 0;
__device__ __forceinline__ void p6c_mlp_unit(Frame& F, int c, int g) {
    const bf16* Z = WSP(bf16, WS_Z); bf16* Y = WSP(bf16, WS_Y); const bf16* TR = WSP(bf16, WS_TRIL) + (size_t)g * 16384;
    const int tid = F.tid, lane = F.lane, w = F.wave, T0 = 128 * c, l31 = lane & 31, hl = lane >> 5;
    const float* lng = F.in[16]; const float* lnb = F.in[17];
#pragma unroll
    for (int i = 0; i < 4; ++i) {
        const int item = tid + 512 * i, s = item >> 4, ch8 = item & 15, col = g * 128 + ch8 * 8;
        const v4u v = *(const v4u*)(Z + (size_t)(T0 + s) * N1P + C1_V + col); float f[8]; UNPACK8(v, f);
        const float mean = WSP(float, WS_VST)[2 * (T0 + s)], rstd = WSP(float, WS_VST)[2 * (T0 + s) + 1];
        LAS bf16* vt = LDSP(bf16, LM_VT) + (ch8 * 8) * 136 + s;
#pragma unroll
        for (int k = 0; k < 8; ++k) vt[k * 136] = (bf16)f2bf((f[k] - mean) * rstd * lng[col + k] + lnb[col + k]);
    }
    __syncthreads();
    const int tt = w >> 1;
    f32x16 acc[2] = {};
    for (int ks = 0; ks < 2 * (tt + 1); ++ks) {
        const bf16x8 a = *(const bf16x8*)(TR + (size_t)(32 * tt + l31) * 128 + 16 * ks + 8 * hl);
#pragma unroll
        for (int w2 = 0; w2 < 2; ++w2) { const bf16x8 b = *(const LAS bf16x8*)(LDSP(bf16, LM_VT) + (32 * (2 * (w & 1) + w2) + l31) * 136 + 16 * ks + 8 * hl); acc[w2] = MFMA32(a, b, acc[w2]); }
    }
    const float* bs = F.in[19] + g * 128;
#pragma unroll
    for (int w2 = 0; w2 < 2; ++w2)
#pragma unroll
        for (int r = 0; r < 16; ++r) {
            const int t = 32 * tt + crow(r, hl), col = g * 128 + 32 * (2 * (w & 1) + w2) + l31;
            const bf16* zr = Z + (size_t)(T0 + t) * N1P;
            const float u = bf1(zr[C1_U + col]), cg = bf1(zr[C1_CG + col]);
            Y[(size_t)(T0 + t) * DM + col] = (bf16)f2bf(u * (acc[w2][r] + bs[t]) * silu(cg));
        }
    __syncthreads();
}

constexpr int LS_W = 0, LS_W_STRIDE = 6144;
constexpr int LS_SSQ = 8 * LS_W_STRIDE;
__device__ __forceinline__ void p6c_sample_unit(Frame& F, int b, int gi) {
    const bf16* Z = WSP(bf16, WS_Z); bf16* Y = WSP(bf16, WS_Y);
    const float* cw = F.in[20]; const float* cb = F.in[21]; const float* scd = F.in[5];
    const int lane = F.lane, w = F.wave, hh = gi * 8 + w; const size_t m0 = MS0 + 4 * b;
    LAS float* xs = LDSP(float, LS_W + w * LS_W_STRIDE); LAS float* Bs = xs + 256; LAS float* Cs = Bs + 512; LAS float* ys = Cs + 512;
#pragma unroll
    for (int k = 0; k < 5; ++k) {
        const int ch = (k == 0) ? hh * 64 + lane : (k < 3 ? 1024 + gi * 128 + (k - 1) * 64 + lane : 1280 + gi * 128 + (k - 3) * 64 + lane);
        float full[7];
#pragma unroll
        for (int i = 0; i < 3; ++i) full[i] = scd[((size_t)b * 3 + i) * 1536 + ch];
#pragma unroll
        for (int t = 0; t < 4; ++t) full[3 + t] = bf1(Z[(m0 + t) * N1P + C1_X + ch]);
        const float w0 = cw[ch], w1 = cw[1536 + ch], w2 = cw[3072 + ch], w3 = cw[4608 + ch], bb = cb[ch];
#pragma unroll
        for (int t = 0; t < 4; ++t) {
            const float a = silu(w0 * full[t] + w1 * full[t + 1] + w2 * full[t + 2] + w3 * full[t + 3] + bb);
            if (k == 0) xs[t * 64 + lane] = a; else if (k < 3) Bs[t * 128 + (k - 1) * 64 + lane] = a; else Cs[t * 128 + (k - 3) * 64 + lane] = a;
        }
        if (k == 0 || w == 0) {
#pragma unroll
            for (int i = 0; i < 3; ++i) F.out[O_SCD + ((size_t)b * 3 + i) * 1536 + ch] = full[4 + i]; }
    }
    float dtv[4], dA[4];
    { const float a = -__expf(F.in[23][hh]), bias = F.in[22][hh];
#pragma unroll
      for (int t = 0; t < 4; ++t) { dtv[t] = softplus_f(WSP(float, WS_DTR)[(m0 + t) * 16 + hh] + bias); dA[t] = __expf(dtv[t] * a); } }
    const int plo = lane >> 4, n0 = 8 * (lane & 15);
    float Br[4][8], Cr[4][8];
#pragma unroll
    for (int t = 0; t < 4; ++t) { const f32x4 b0 = *(const LAS f32x4*)(Bs + t * 128 + n0), b1 = *(const LAS f32x4*)(Bs + t * 128 + n0 + 4), c0 = *(const LAS f32x4*)(Cs + t * 128 + n0), c1 = *(const LAS f32x4*)(Cs + t * 128 + n0 + 4);
#pragma unroll
        for (int i = 0; i < 4; ++i) { Br[t][i] = b0[i]; Br[t][4 + i] = b1[i]; Cr[t][i] = c0[i]; Cr[t][4 + i] = c1[i]; } }
    const float* sin_ = F.in[6] + ((size_t)(b * 16 + hh) * 64) * 128; float* sout = F.out + O_SSSM + ((size_t)(b * 16 + hh) * 64) * 128;
    for (int pi = 0; pi < 16; ++pi) {
        const int p = 4 * pi + plo;
        const f32x4 h0 = *(const f32x4*)(sin_ + (size_t)p * 128 + n0), h1 = *(const f32x4*)(sin_ + (size_t)p * 128 + n0 + 4);
        float h[8];
#pragma unroll
        for (int i = 0; i < 4; ++i) { h[i] = h0[i]; h[4 + i] = h1[i]; }
        float yp[4];
#pragma unroll
        for (int t = 0; t < 4; ++t) {
            const float coef = dtv[t] * xs[t * 64 + p]; float acc = 0.f;
#pragma unroll
            for (int i = 0; i < 8; ++i) { h[i] = dA[t] * h[i] + coef * Br[t][i]; acc += h[i] * Cr[t][i]; }
            yp[t] = acc;
        }
        *(f32x4*)(sout + (size_t)p * 128 + n0) = (f32x4){h[0], h[1], h[2], h[3]}; *(f32x4*)(sout + (size_t)p * 128 + n0 + 4) = (f32x4){h[4], h[5], h[6], h[7]};
#pragma unroll
        for (int t = 0; t < 4; ++t) { float v = yp[t]; v += __shfl_xor(v, 1); v += __shfl_xor(v, 2); v += __shfl_xor(v, 4); v += __shfl_xor(v, 8); if ((lane & 15) == 0) ys[t * 64 + p] = v; }
    }
    float gv[4];
#pragma unroll
    for (int t = 0; t < 4; ++t) {
        const float yv = ys[t * 64 + lane] + F.in[24][hh] * xs[t * 64 + lane];
        const float z = bf1(Z[(m0 + t) * N1P + C1_Z + hh * 64 + lane]);
        gv[t] = yv * silu(z);
        const float q = wave_sum(gv[t] * gv[t]);
        if (lane == 0) LDSP(float, LS_SSQ)[w * 4 + t] = q;
    }
    __syncthreads();
#pragma unroll
    for (int t = 0; t < 4; ++t) {
        float tot = 0.f;
#pragma unroll
        for (int k = 0; k < 8; ++k) tot += LDSP(float, LS_SSQ)[k * 4 + t];
        const float rstd = rsqrtf(tot * (1.f / 512.f) + EPS);
        Y[(m0 + t) * DM + 1024 + hh * 64 + lane] = (bf16)f2bf(gv[t] * rstd * F.in[25][hh * 64 + lane]);
    }
    __syncthreads();
}

__device__ __forceinline__ void p6c_sample_mlp(Frame& F, int b) {
    const bf16* Z = WSP(bf16, WS_Z); bf16* Y = WSP(bf16, WS_Y);
    const int lane = F.lane, col = 16 * lane, g = lane >> 3; const size_t m0 = MS0 + 4 * b;
    const float* lng = F.in[16]; const float* lnb = F.in[17]; const float* ws = F.in[18] + (size_t)g * 16384; const float* bs = F.in[19] + g * 128;
    float vn[4][16];
#pragma unroll
    for (int t = 0; t < 4; ++t) {
        const bf16* vp = Z + (m0 + t) * N1P + C1_V + col;
        float* f = vn[t]; { const v4u a = *(const v4u*)vp, c = *(const v4u*)(vp + 8); UNPACK8(a, f); float* f2 = f + 8; UNPACK8(c, f2); }
        float s = 0.f;
#pragma unroll
        for (int i = 0; i < 16; ++i) s += f[i];
        const float mean = wave_sum(s) * (1.f / 1024.f); float q = 0.f;
#pragma unroll
        for (int i = 0; i < 16; ++i) { const float d = f[i] - mean; q += d * d; }
        const float rstd = rsqrtf(wave_sum(q) * (1.f / 1024.f) + EPS);
#pragma unroll
        for (int i = 0; i < 16; ++i) f[i] = (f[i] - mean) * rstd * lng[col + i] + lnb[col + i];
        float* o = F.out + O_SCV + ((size_t)b * 4 + t) * 1024 + col;
#pragma unroll
        for (int i = 0; i < 4; ++i) *(f32x4*)(o + 4 * i) = (f32x4){f[4 * i], f[4 * i + 1], f[4 * i + 2], f[4 * i + 3]};
    }
#pragma unroll
    for (int t = 0; t < 4; ++t) {
        const bf16* zr = Z + (m0 + t) * N1P;
        float uu[16], cgv[16];
        { const v4u a = *(const v4u*)(zr + C1_U + col), c = *(const v4u*)(zr + C1_U + col + 8); UNPACK8(a, uu); float* u2 = uu + 8; UNPACK8(c, u2); }
        { const v4u a = *(const v4u*)(zr + C1_CG + col), c = *(const v4u*)(zr + C1_CG + col + 8); UNPACK8(a, cgv); float* c2 = cgv + 8; UNPACK8(c, c2); }
        float y[16];
#pragma unroll
        for (int i = 0; i < 16; ++i) {
            float mix = bs[t];
#pragma unroll
            for (int s = 0; s < 4; ++s) if (s <= t) mix += ws[t * 128 + s] * vn[s][i];
            y[i] = uu[i] * mix * silu(cgv[i]);
        }
        *(v4u*)(Y + (m0 + t) * DM + col) = pack8(y); *(v4u*)(Y + (m0 + t) * DM + col + 8) = pack8(y + 8);
    }
}

#ifndef USE_CG_SYNC
#define USE_CG_SYNC 1
#endif
__global__ void __launch_bounds__(NTHR, 2) hybrid_fwd(Args args) {
    extern __shared__ __attribute__((aligned(16))) unsigned char lds[];
    cg::grid_group grid = cg::this_grid();
    Frame F;
    F.lds = (LAS unsigned char*)lds;
    F.tid = threadIdx.x; F.lane = F.tid & 63; F.wave = __builtin_amdgcn_readfirstlane(F.tid >> 6);
    F.G = gridDim.x; F.bid = blockIdx.x;
#pragma unroll
    for (int i = 0; i < 28; ++i) F.in[i] = args.in[i];
    F.out = args.out; F.ws = args.ws;
    for (int u = F.tid; u < (LDS_BYTES - LDS_CTL_OFF) / 4; u += NTHR) ((LAS unsigned*)(F.lds + LDS_CTL_OFF))[u] = 0u;
    __syncthreads();
    XcdBarrier bar = xcd_barrier_post((unsigned*)(F.ws + WS_CTL) + CW_BAR, (volatile LAS unsigned*)(F.lds + LDS_CTL_OFF) + 8);
    const int lo = args.ph_lo, hi = args.ph_hi;
#ifndef PHASE_MASK
#define PHASE_MASK 0x7ff
#endif
#define IN(k) (((PHASE_MASK >> (k)) & 1) && lo <= (k) && (k) < hi)
#define SEAM(k) do { if (IN(k) && IN((k) + 1)) { if (USE_CG_SYNC || (k) == 0) grid.sync(); else xcd_barrier(bar); } } while (0)

    if (IN(0)) { p0_prologue(F); }
    SEAM(0);
    if (IN(1)) {
        pg8::Gemm g{WSP(bf16, WS_H), WSP(bf16, WS_WT0), MROWS, N0, DM}; pg8::StaticOrder S; S.init(MROWS, N0, F.G, F.bid);
        pg8::EpiStore E{WSP(bf16, WS_Z), N0, nullptr, -1};
        pg8::gemm_phase<pg8::EpiStore, pg8::StaticOrder, true, true>(F.lds, g, S, E);
    }
    SEAM(1);
    if (IN(2)) { p2_mixers0(F); }
    SEAM(2);
    if (IN(3)) {
        pg8::Gemm g{WSP(bf16, WS_Y), WSP(bf16, WS_WO0), MROWS, DM, DM}; pg8::StaticOrder S; S.init(MROWS, DM, F.G, F.bid);
        pg8::EpiStore E{WSP(bf16, WS_Z), DM, nullptr, -1};
        pg8::gemm_phase<pg8::EpiStore, pg8::StaticOrder, true, true>(F.lds, g, S, E);
    }
    SEAM(3);
    if (IN(4)) { row_pass(F, true, F.in[13], F.in[14], WSP(bf16, WS_H)); }
    SEAM(4);
    if (IN(5)) {
        pg8::Gemm g{WSP(bf16, WS_H), WSP(bf16, WS_WT1), MROWS, N1P, DM}; pg8::StaticOrder S; S.init(MROWS, N1P, F.G, F.bid);
        pg8::EpiStore E{WSP(bf16, WS_Z), N1P, WSP(float, WS_DTR), C1_DT / 256};
        pg8::gemm_phase<pg8::EpiStore, pg8::StaticOrder, true, true>(F.lds, g, S, E);
    }
    SEAM(5);
    if (IN(6)) { for (int u = F.bid; u < 256; u += F.G) p6a_unit(F, u >> 2, (u >> 1) & 1, u & 1); }
    SEAM(6);
    if (IN(7)) { p6b_scan(F); }
    SEAM(7);
    if (IN(8)) {
        for (int u = F.bid; u < 256; u += F.G) p6c_ssd_unit(F, u >> 2, (u >> 1) & 1, u & 1);
        for (int u = F.bid; u < 512; u += F.G) p6c_mlp_unit(F, u >> 3, u & 7);
        for (int u = F.bid; u < 256; u += F.G) p6c_sample_unit(F, u >> 1, u & 1);
        for (int u = F.wave * F.G + F.bid; u < 128; u += NWAVES * F.G) p6c_sample_mlp(F, u);
        if (F.bid == F.G - 1) { const bf16* Z = WSP(bf16, WS_Z);
            for (int i = F.tid; i < 3 * 1536; i += NTHR) { const int r = i / 1536, ch = i % 1536; F.out[O_PCD + i] = bf1(Z[(size_t)(SEQ - 3 + r) * N1P + C1_X + ch]); } }
    }
    SEAM(8);
    if (IN(9)) {
        pg8::Gemm g{WSP(bf16, WS_Y), WSP(bf16, WS_WO1), MROWS, DM, DM}; pg8::StaticOrder S; S.init(MROWS, DM, F.G, F.bid);
        pg8::EpiStore E{WSP(bf16, WS_Z), DM, nullptr, -1};
        pg8::gemm_phase<pg8::EpiStore, pg8::StaticOrder, true, true>(F.lds, g, S, E);
    }
    SEAM(9);
    if (IN(10)) { row_pass(F, false, F.in[27], nullptr, nullptr); }
#undef IN
#undef SEAM
}

#ifndef N_LAUNCHES
#define N_LAUNCHES 1
#endif
extern "C" void kernel_launch(void* const* d_in, const int* in_sizes, int n_in, void* d_out, int out_size, void* d_ws, size_t ws_size, hipStream_t stream) {
    static int grid = 0;
    if (grid == 0) {
        int dev = 0, cus = 0, per_cu = 0;
        if (n_in != 28 || (size_t)out_size != O_END || ws_size < WS_END) { fprintf(stderr, "kernel_launch: unexpected shapes n_in %d out %d ws %zu\n", n_in, out_size, ws_size); grid = -1; return; }
        (void)hipGetDevice(&dev); (void)hipDeviceGetAttribute(&cus, hipDeviceAttributeMultiprocessorCount, dev);
        (void)hipFuncSetAttribute((const void*)hybrid_fwd, hipFuncAttributeMaxDynamicSharedMemorySize, LDS_BYTES);
        (void)hipOccupancyMaxActiveBlocksPerMultiprocessor(&per_cu, (const void*)hybrid_fwd, NTHR, LDS_BYTES);
        (void)hipGetLastError();
        if (per_cu < 1) { fprintf(stderr, "kernel_launch: occupancy query says %d blocks per CU\n", per_cu); grid = -1; return; }
        grid = cus;
    }
    if (grid < 0) return;
    (void)hipMemsetAsync((char*)d_ws + WS_CTL, 0, CTL_ZERO_BYTES, stream);
    Args a{};
    for (int i = 0; i < 28; ++i) a.in[i] = (const float*)d_in[i];
    a.out = (float*)d_out; a.ws = (unsigned char*)d_ws;
    if (N_LAUNCHES == 1) {
        a.ph_lo = 0; a.ph_hi = 11;
        void* params[] = {&a};
        hipError_t e = hipLaunchCooperativeKernel((const void*)hybrid_fwd, dim3(grid), dim3(NTHR), params, LDS_BYTES, stream);
        if (e != hipSuccess) fprintf(stderr, "cooperative launch failed: %s (grid %d)\n", hipGetErrorString(e), grid);
    } else {
        for (int p = 0; p < 11; ++p) { a.ph_lo = p; a.ph_hi = p + 1; hipLaunchKernelGGL(hybrid_fwd, dim3(grid), dim3(NTHR), LDS_BYTES, stream, a); }
    }
}
```

```cpp
#include <hip/hip_runtime.h>
#include <hip/hip_cooperative_groups.h>
#include <cstdio>
#include <cstdint>
namespace cg = cooperative_groups;

namespace pg8 {
#define PG8_LAS __attribute__((address_space(3)))
typedef unsigned short bf16_t;
typedef short bf16x8 __attribute__((ext_vector_type(8)));
typedef float f32x4 __attribute__((ext_vector_type(4)));
typedef unsigned u32x4 __attribute__((ext_vector_type(4)));
constexpr int BM = 256, BK = 64, HALF = 128, HTB = HALF * BK * 2  , STAGE_BYTES = 8 * HTB, NXCD = 8, WGM = 8;

__host__ __device__ __forceinline__ int lds_byte(int r, int c) { const int st = (r >> 4) * 2 + (c >> 5), rr = r & 15, cc = c & 31, ob = rr * 64 + cc * 2; return st * 1024 + (ob ^ (((ob >> 9) & 1) << 5)); }
__host__ __device__ __forceinline__ void stage_rc(int b, int& R, int& C) { const int st = b / 1024, sb = b % 1024, swz = sb ^ (((sb >> 9) & 1) << 5); R = (st >> 1) * 16 + swz / 64; C = (st & 1) * 32 + (swz % 64) / 2; }
__host__ __device__ __forceinline__ int perm32(int rho) { const int n = rho >> 4, i = rho & 15; return 8 * (i >> 2) + 4 * n + (i & 3); }

struct Unit { int pm, pn; };
struct Gemm { const bf16_t* A; const bf16_t* Bt; int M, N, K; };

struct StaticOrder {
    int nM, nN, nwg, G, c;
    __host__ __device__ void init(int M, int N, int G_, int c_) { nM = M / BM; nN = N / BM; nwg = nM * nN; G = G_; c = c_; }
    __host__ __device__ bool next(int i, Unit& u) const {
        const long L = (long)i * G + c; if (L >= nwg) return false;
        int wgid = (int)L; { const int q = nwg / NXCD, r = nwg % NXCD, xcd = wgid % NXCD, off = wgid / NXCD; wgid = (xcd < r ? xcd * (q + 1) : r * (q + 1) + (xcd - r) * q) + off; }
        const int nig = WGM * nN, gid = wgid / nig, fm = gid * WGM, gsz = (nM - fm) < WGM ? (nM - fm) : WGM;
        u.pm = fm + ((wgid % nig) % gsz); u.pn = (wgid % nig) / gsz; return true;
    }
    __device__ __forceinline__ void a_ready(const Unit&) const {}
    __device__ __forceinline__ void done(const Unit&) const {}
};

__device__ __forceinline__ unsigned cvt_pk_bf16(float lo, float hi) { unsigned r; asm volatile("v_cvt_pk_bf16_f32 %0, %1, %2" : "=v"(r) : "v"(lo), "v"(hi)); return r; }
struct EpiStore {
    static constexpr bool PERM = true, AFTER_DRAIN = false;
    bf16_t* O; int ldc; float* dt_out; int dt_tile;
    __device__ __forceinline__ void operator()(const f32x4 (&acc)[2][2][4][2], const Unit& u, int wr, int wc, int fr, int fq) const {
        const int row0 = u.pm * BM + wr * 64 + fr; const int col0 = u.pn * BM + wc * 32 + 8 * fq;
#pragma unroll
        for (int ai = 0; ai < 2; ++ai)
#pragma unroll
            for (int m = 0; m < 4; ++m) { bf16_t* rowp = O + (size_t)(row0 + ai * HALF + m * 16) * ldc + col0;
#pragma unroll
                for (int bj = 0; bj < 2; ++bj) { const f32x4 v0 = acc[ai][bj][m][0], v1 = acc[ai][bj][m][1];
                    u32x4 w; w.x = cvt_pk_bf16(v0[0], v0[1]); w.y = cvt_pk_bf16(v0[2], v0[3]); w.z = cvt_pk_bf16(v1[0], v1[1]); w.w = cvt_pk_bf16(v1[2], v1[3]);
                    *(u32x4*)(rowp + bj * HALF) = w; } }
        if (dt_out != nullptr && u.pn == dt_tile && wc == 0 && fq < 2) {
#pragma unroll
            for (int ai = 0; ai < 2; ++ai)
#pragma unroll
                for (int m = 0; m < 4; ++m) { float* p = dt_out + (size_t)(row0 + ai * HALF + m * 16) * 16 + 8 * fq;
                    *(f32x4*)(p) = acc[ai][0][m][0]; *(f32x4*)(p + 4) = acc[ai][0][m][1]; }
        }
    }
};

template <class Epi, class Sched, bool ALIGN_EPI = false, bool SP2 = false>
__device__ __forceinline__ void gemm_phase(PG8_LAS unsigned char* lds, const Gemm g, const Sched& S, const Epi& E) {
    const int tid = threadIdx.x, wid = __builtin_amdgcn_readfirstlane(tid >> 6), lane = tid & 63, wr = wid >> 2, wc = wid & 3, fr = lane & 15, fq = lane >> 4;
    const int K = g.K, nt = K / BK;
    unsigned voffA[2], voffB[2];
#pragma unroll
    for (int i = 0; i < 2; ++i) { int R, C; stage_rc(tid * 16 + i * 8192, R, C); const int Rb = Epi::PERM ? ((R & ~31) + perm32(R & 31)) : R;
        voffA[i] = (unsigned)(R * K + C) * 2u; voffB[i] = (unsigned)(Rb * K + C) * 2u; }
    const size_t kstep = (size_t)(BK * 2);
    const size_t hstep = (size_t)HALF * K * 2;
    const size_t tstep = 2 * hstep;
    const unsigned ldsw = (unsigned)wid * 1024u;
    const int aoff = lds_byte(wr * 64 + fr, fq * 8), boff = lds_byte(wc * 32 + fr, fq * 8);
#define PG8_SA(b, h) (((b) * 2 + (h)) * HTB)
#define PG8_SB(b, h) ((4 + (b) * 2 + (h)) * HTB)
#define PG8_STAGE(bufoff, gbase, voff) do { _Pragma("unroll") for (int _i = 0; _i < 2; ++_i) \
        __builtin_amdgcn_global_load_lds((const unsigned*)((const char*)(gbase) + (voff)[_i]), (PG8_LAS unsigned*)(lds + (bufoff) + ldsw + _i * 8192), 16, 0, 0); } while (0)
#define PG8_LDA(dst, b, h) do { _Pragma("unroll") for (int m = 0; m < 4; ++m) _Pragma("unroll") for (int k = 0; k < 2; ++k) dst[m][k] = *(const PG8_LAS bf16x8*)(lds + PG8_SA(b, h) + aoff + m * 2048 + k * 1024); } while (0)
#define PG8_LDB(dst, b, h) do { _Pragma("unroll") for (int n = 0; n < 2; ++n) _Pragma("unroll") for (int k = 0; k < 2; ++k) dst[n][k] = *(const PG8_LAS bf16x8*)(lds + PG8_SB(b, h) + boff + n * 2048 + k * 1024); } while (0)
#define PG8_MMA(ai, bj, At, Bt) do { __builtin_amdgcn_s_setprio(1); _Pragma("unroll") for (int m = 0; m < 4; ++m) _Pragma("unroll") for (int n = 0; n < 2; ++n) _Pragma("unroll") for (int k = 0; k < 2; ++k) \
        acc[ai][bj][m][n] = __builtin_amdgcn_mfma_f32_16x16x32_bf16(Bt[n][k], At[m][k], acc[ai][bj][m][n], 0, 0, 0); __builtin_amdgcn_s_setprio(0); } while (0)
#define PG8_WAIT_V(n) asm volatile("s_waitcnt vmcnt(" #n ")" ::: "memory")
#define PG8_WAIT_L(n) asm volatile("s_waitcnt lgkmcnt(" #n ")" ::: "memory")
#define PG8_BAR __builtin_amdgcn_s_barrier()
#define PG8_SCHED __builtin_amdgcn_sched_barrier(0)
    Unit cur, nxt; int ui = 0;
    if (!S.next(0, cur)) return;
    f32x4 acc[2][2][4][2];
#pragma unroll
    for (int a = 0; a < 2; ++a)
#pragma unroll
        for (int b = 0; b < 2; ++b)
#pragma unroll
            for (int m = 0; m < 4; ++m)
#pragma unroll
                for (int n = 0; n < 2; ++n) acc[a][b][m][n] = (f32x4){0.f, 0.f, 0.f, 0.f};
    bf16x8 At[4][2], B0[2][2], B1[2][2];
    const char* cA = (const char*)g.A + (size_t)cur.pm * tstep; const char* cB = (const char*)g.Bt + (size_t)cur.pn * tstep;
    S.a_ready(cur);
    if constexpr (SP2) {
        PG8_STAGE(PG8_SB(0, 0), cB, voffB); PG8_STAGE(PG8_SB(0, 1), cB + hstep, voffB); PG8_STAGE(PG8_SA(0, 0), cA, voffA); PG8_STAGE(PG8_SA(0, 1), cA + hstep, voffA);
        if (wr == 1) PG8_BAR;
        PG8_WAIT_V(2); PG8_BAR;
        PG8_STAGE(PG8_SB(1, 0), cB + kstep, voffB); PG8_STAGE(PG8_SA(1, 0), cA + kstep, voffA); PG8_STAGE(PG8_SB(1, 1), cB + hstep + kstep, voffB);
        PG8_WAIT_V(6); PG8_BAR;
    } else {
        PG8_STAGE(PG8_SB(0, 0), cB, voffB); PG8_STAGE(PG8_SA(0, 0), cA, voffA); PG8_STAGE(PG8_SB(0, 1), cB + hstep, voffB); PG8_STAGE(PG8_SA(0, 1), cA + hstep, voffA);
        if (wr == 1) PG8_BAR;
        PG8_WAIT_V(4); PG8_BAR;
        PG8_STAGE(PG8_SB(1, 0), cB + kstep, voffB); PG8_STAGE(PG8_SA(1, 0), cA + kstep, voffA); PG8_STAGE(PG8_SB(1, 1), cB + hstep + kstep, voffB);
        PG8_WAIT_V(6); PG8_BAR;
    }
    for (;;) {
        const bool has_next = S.next(ui + 1, nxt);
        const char* nA = has_next ? (const char*)g.A + (size_t)nxt.pm * tstep : cA; const char* nB = has_next ? (const char*)g.Bt + (size_t)nxt.pn * tstep : cB;
        for (int t = 0; t < nt; t += 2) {
            const bool last = (t == nt - 2);
            const char* a1 = cA + (size_t)(t + 1) * kstep;
            const char* a2 = last ? nA : cA + (size_t)(t + 2) * kstep; const char* b2 = last ? nB : cB + (size_t)(t + 2) * kstep;
            const char* a3 = a2 + kstep; const char* b3 = b2 + kstep;
            if (last && has_next) S.a_ready(nxt);
            if constexpr (SP2) {
            PG8_LDB(B0, 0, 0); PG8_LDB(B1, 0, 1); PG8_SCHED; PG8_LDA(At, 0, 0); PG8_STAGE(PG8_SA(1, 1), a1 + hstep, voffA);
            PG8_WAIT_V(8); PG8_WAIT_L(0); PG8_BAR; PG8_MMA(0, 0, At, B0); PG8_MMA(0, 1, At, B1); PG8_BAR; PG8_SCHED;
            PG8_LDA(At, 0, 1); PG8_STAGE(PG8_SB(0, 0), b2, voffB); PG8_STAGE(PG8_SB(0, 1), b2 + hstep, voffB); PG8_STAGE(PG8_SA(0, 0), a2, voffA);
            PG8_WAIT_V(8); PG8_WAIT_L(0); PG8_BAR; PG8_MMA(1, 0, At, B0); PG8_MMA(1, 1, At, B1); PG8_BAR; PG8_SCHED;
            PG8_LDB(B0, 1, 0); PG8_LDB(B1, 1, 1); PG8_SCHED; PG8_LDA(At, 1, 0); PG8_STAGE(PG8_SA(0, 1), a2 + hstep, voffA);
            PG8_WAIT_V(8); PG8_WAIT_L(0); PG8_BAR; PG8_MMA(0, 0, At, B0); PG8_MMA(0, 1, At, B1); PG8_BAR; PG8_SCHED;
            PG8_LDA(At, 1, 1); PG8_STAGE(PG8_SB(1, 0), b3, voffB); PG8_STAGE(PG8_SB(1, 1), b3 + hstep, voffB); PG8_STAGE(PG8_SA(1, 0), a3, voffA);
            PG8_WAIT_V(8); PG8_WAIT_L(0); PG8_BAR; PG8_MMA(1, 0, At, B0); PG8_MMA(1, 1, At, B1); PG8_BAR; PG8_SCHED;
            } else {
            PG8_LDB(B0, 0, 0); PG8_SCHED; PG8_LDA(At, 0, 0); PG8_STAGE(PG8_SA(1, 1), a1 + hstep, voffA);
            PG8_WAIT_L(8); PG8_BAR; PG8_WAIT_L(0); PG8_MMA(0, 0, At, B0); PG8_BAR; PG8_SCHED;
            PG8_LDB(B1, 0, 1); PG8_STAGE(PG8_SB(0, 0), b2, voffB);
            PG8_BAR; PG8_WAIT_L(0); PG8_MMA(0, 1, At, B1); PG8_BAR;
            PG8_LDA(At, 0, 1); PG8_STAGE(PG8_SA(0, 0), a2, voffA);
            PG8_BAR; PG8_WAIT_L(0); PG8_MMA(1, 0, At, B0); PG8_BAR; PG8_SCHED;
            PG8_STAGE(PG8_SB(0, 1), b2 + hstep, voffB);
            PG8_WAIT_V(6); PG8_BAR; PG8_MMA(1, 1, At, B1); PG8_BAR;
            PG8_LDB(B0, 1, 0); PG8_SCHED; PG8_LDA(At, 1, 0); PG8_STAGE(PG8_SA(0, 1), a2 + hstep, voffA);
            PG8_WAIT_L(8); PG8_BAR; PG8_WAIT_L(0); PG8_MMA(0, 0, At, B0); PG8_BAR; PG8_SCHED;
            PG8_LDB(B1, 1, 1); PG8_STAGE(PG8_SB(1, 0), b3, voffB);
            PG8_BAR; PG8_WAIT_L(0); PG8_MMA(0, 1, At, B1); PG8_BAR;
            PG8_LDA(At, 1, 1); PG8_STAGE(PG8_SA(1, 0), a3, voffA);
            PG8_BAR; PG8_WAIT_L(0); PG8_MMA(1, 0, At, B0); PG8_BAR; PG8_SCHED;
            PG8_STAGE(PG8_SB(1, 1), b3 + hstep, voffB);
            PG8_WAIT_V(6); PG8_BAR; PG8_MMA(1, 1, At, B1); PG8_BAR;
            }
        }
        if constexpr (ALIGN_EPI) { if (wr == 0) PG8_BAR; }
        if constexpr (!Epi::AFTER_DRAIN) { E(acc, cur, wr, wc, fr, fq); S.done(cur); }
        if (!has_next) break;
#pragma unroll
        for (int a = 0; a < 2; ++a)
#pragma unroll
            for (int b = 0; b < 2; ++b)
#pragma unroll
                for (int m = 0; m < 4; ++m)
#pragma unroll
                    for (int n = 0; n < 2; ++n) acc[a][b][m][n] = (f32x4){0.f, 0.f, 0.f, 0.f};
        cur = nxt; cA = nA; cB = nB; ++ui;
        if constexpr (ALIGN_EPI) { if (wr == 1) PG8_BAR; }
    }
    PG8_WAIT_V(0);
    if constexpr (!ALIGN_EPI) { if (wr == 0) PG8_BAR; }
    PG8_BAR;
    if constexpr (Epi::AFTER_DRAIN) { E.fused(acc, cur, wr, wc, fr, fq, lds, wid, lane); S.done(cur); }
#undef PG8_SA
#undef PG8_SB
#undef PG8_STAGE
#undef PG8_LDA
#undef PG8_LDB
#undef PG8_MMA
#undef PG8_WAIT_V
#undef PG8_WAIT_L
#undef PG8_BAR
#undef PG8_SCHED
}
}

#define GAS __attribute__((address_space(1)))
#define LAS __attribute__((address_space(3)))
typedef unsigned short bf16;
typedef unsigned v4u __attribute__((ext_vector_type(4)));
typedef unsigned v2u __attribute__((ext_vector_type(2)));
typedef float f32x4 __attribute__((ext_vector_type(4)));
typedef float f32x16 __attribute__((ext_vector_type(16)));
typedef short bf16x8 __attribute__((ext_vector_type(8)));
typedef short s16x4 __attribute__((ext_vector_type(4)));

constexpr int NWAVES = 8, NTHR = 512;
constexpr int DM = 2048, SEQ = 8192, NB = 128, NT = 4, MROWS = 8704, MS0 = 8192;
constexpr int N0 = 6656, N1 = 5648, N1P = 5888;
constexpr int C0_AB = 0, C0_AC = 1024, C0_AH = 2048, C0_AG = 3072, C0_Q = 4096, C0_K = 5120, C0_V = 5376, C0_G = 5632;
constexpr int C1_U = 0, C1_V = 1024, C1_CG = 2048, C1_Z = 3072, C1_X = 4096, C1_B = 5120, C1_C = 5376, C1_DT = 5632;
constexpr float EPS = 1e-6f, LOG2E = 1.4426950408889634f, QSCALE = 0.125f * 1.4426950408889634f, NEGBIG = -1e30f;
constexpr size_t O_YP = 0, O_YS = O_YP + 8192ull * 2048, O_PCA = O_YS + 512ull * 2048, O_SCA = O_PCA + 2048, O_PWK = O_SCA + 128ull * 2048,
                 O_PWV = O_PWK + 128ull * 256, O_SWK = O_PWV + 128ull * 256, O_SWV = O_SWK + 128ull * 128 * 256, O_SCV = O_SWV + 128ull * 128 * 256,
                 O_PCD = O_SCV + 128ull * 4 * 1024, O_SCD = O_PCD + 3 * 1536, O_PSSM = O_SCD + 128ull * 3 * 1536, O_SSSM = O_PSSM + 131072, O_END = O_SSSM + 128ull * 131072;
static_assert(O_END == 44571136ull, "output size");
constexpr size_t MiB = 1u << 20;
constexpr size_t WS_CTL = 0, CTL_ZERO_BYTES = 1 * MiB;
constexpr size_t WS_WT0 = 1 * MiB;
constexpr size_t WS_WO0 = WS_WT0 + (size_t)N0 * DM * 2;
constexpr size_t WS_WT1 = WS_WO0 + (size_t)DM * DM * 2;
constexpr size_t WS_WO1 = WS_WT1 + (size_t)N1P * DM * 2;
constexpr size_t WS_TRIL = WS_WO1 + (size_t)DM * DM * 2;
constexpr size_t WS_H = WS_TRIL + 8 * 128 * 128 * 2;
constexpr size_t WS_Z = WS_H + (size_t)MROWS * DM * 2;
constexpr size_t WS_Y = WS_Z + (size_t)MROWS * N0 * 2;
constexpr size_t WS_XA = WS_Y + (size_t)MROWS * DM * 2;
constexpr size_t WS_DTR = WS_XA + (size_t)SEQ * 1536 * 2;
constexpr size_t WS_ACS = WS_DTR + (size_t)MROWS * 16 * 4;
constexpr size_t WS_DTV = WS_ACS + (size_t)SEQ * 16 * 4;
constexpr size_t WS_CD = WS_DTV + (size_t)SEQ * 16 * 4;
constexpr size_t WS_VST = WS_CD + 64 * 16 * 4;
constexpr size_t WS_END = WS_VST + (size_t)SEQ * 2 * 4;
static_assert(WS_END <= 290ull * MiB, "workspace map");
static_assert((size_t)64 * 16 * 64 * 128 * 4 <= (size_t)MROWS * DM * 2, "CS fits in H");
constexpr int CW_BAR = 4096;
constexpr int LDS_BYTES = 147456, LDS_CTL_OFF = 147200;

#define RLX_AGENT __ATOMIC_RELAXED, __HIP_MEMORY_SCOPE_AGENT
__device__ __forceinline__ unsigned f2bf(float f) { unsigned u = __builtin_bit_cast(unsigned, f); return (u + 0x7fffu + ((u >> 16) & 1u)) >> 16; }
__device__ __forceinline__ unsigned pk2(float lo, float hi) { return f2bf(lo) | (f2bf(hi) << 16); }
__device__ __forceinline__ float bflo(unsigned w) { return __uint_as_float(w << 16); }
__device__ __forceinline__ float bfhi(unsigned w) { return __uint_as_float(w & 0xffff0000u); }
__device__ __forceinline__ float bf1(bf16 b) { return __uint_as_float((unsigned)b << 16); }
#define UNPACK8(v, f) do { f[0] = bflo(v.x); f[1] = bfhi(v.x); f[2] = bflo(v.y); f[3] = bfhi(v.y); f[4] = bflo(v.z); f[5] = bfhi(v.z); f[6] = bflo(v.w); f[7] = bfhi(v.w); } while (0)
__device__ __forceinline__ v4u pack8(const float* f) { v4u o; o.x = pk2(f[0], f[1]); o.y = pk2(f[2], f[3]); o.z = pk2(f[4], f[5]); o.w = pk2(f[6], f[7]); return o; }
__device__ __forceinline__ float silu(float x) { return x / (1.f + __expf(-x)); }
__device__ __forceinline__ float wave_sum(float v) {
#pragma unroll
    for (int o = 1; o < 64; o <<= 1) v += __shfl_xor(v, o);
    return v;
}
__device__ __forceinline__ float wave_max(float v) {
#pragma unroll
    for (int o = 1; o < 64; o <<= 1) v = fmaxf(v, __shfl_xor(v, o));
    return v;
}
__device__ __forceinline__ int crow(int r, int hi) { return (r & 3) + 8 * (r >> 2) + 4 * hi; }
#define MFMA32(a, b, c) __builtin_amdgcn_mfma_f32_32x32x16_bf16((a), (b), (c), 0, 0, 0)
__device__ __forceinline__ bf16x8 pack_frag(const f32x16& x, int s) {
    v4u p; p.x = pk2(x[8 * s + 0], x[8 * s + 1]); p.y = pk2(x[8 * s + 2], x[8 * s + 3]); p.z = pk2(x[8 * s + 4], x[8 * s + 5]); p.w = pk2(x[8 * s + 6], x[8 * s + 7]);
    return __builtin_bit_cast(bf16x8, p);
}
__device__ __forceinline__ bf16x8 frag_from_f32(const float* p) {
    const f32x4 a = *(const f32x4*)p, b = *(const f32x4*)(p + 4);
    v4u o; o.x = pk2(a[0], a[1]); o.y = pk2(a[2], a[3]); o.z = pk2(b[0], b[1]); o.w = pk2(b[2], b[3]);
    return __builtin_bit_cast(bf16x8, o);
}

#define XB_TMO      128
#define XB_XCNT(j)  (256  + 64 * (j))
#define XB_XSUB(j)  (1280 + 64 * (j))
#define XB_XGEN(j)  (2304 + 64 * (j))
#define XB_TOP      3328
#define XB_TOPGEN   3392
#define XCD_BAR_WORDS 3456
#define XB_SPIN_CAP (1u << 18)
__device__ __forceinline__ unsigned xb_ld(unsigned* p)              { return __hip_atomic_load(p, __ATOMIC_RELAXED, __HIP_MEMORY_SCOPE_AGENT); }
__device__ __forceinline__ unsigned xb_add(unsigned* p, unsigned v) { return __hip_atomic_fetch_add(p, v, __ATOMIC_RELAXED, __HIP_MEMORY_SCOPE_AGENT); }
__device__ __forceinline__ unsigned xb_xcc_id() { return (unsigned)__builtin_amdgcn_s_getreg((3 << 11) | 20) & 0xFu; }
#define XB_SPIN(cond, bar) do { unsigned _sp = 0; while (cond) { __builtin_amdgcn_s_sleep(1); \
    if ((++_sp & 255u) == 0u) { if (xb_ld(&(bar)[XB_TMO])) break; if (_sp > XB_SPIN_CAP) { atomicAdd(&(bar)[XB_TMO], 1u); break; } } } } while (0)
struct XcdBarrier { unsigned* bar; unsigned x; volatile LAS unsigned* st; };
__device__ __forceinline__ XcdBarrier xcd_barrier_post(unsigned* bar, volatile LAS unsigned* st) {
    XcdBarrier b; b.bar = bar; b.x = xb_xcc_id(); b.st = st;
    if (threadIdx.x == 0) (void)xb_add(&bar[XB_XCNT(b.x)], 1u);
    return b;
}
__device__ __forceinline__ void xcd_barrier_complete(unsigned* bar, unsigned x, unsigned& nloc, unsigned& nx) {
    const unsigned G = gridDim.x * gridDim.y * gridDim.z;
    unsigned sum, cnt, mine, sp = 0u;
    for (;;) {
        sum = 0u; cnt = 0u; mine = 0u;
#pragma unroll
        for (unsigned j = 0; j < 16; ++j) { const unsigned c = xb_ld(&bar[XB_XCNT(j)]); sum += c; cnt += (c > 0u) ? 1u : 0u; mine = (j == x) ? c : mine; }
        if (sum == G) break;
        __builtin_amdgcn_s_sleep(1);
        if ((++sp & 255u) == 0u) { if (xb_ld(&bar[XB_TMO])) break; if (sp > XB_SPIN_CAP) { atomicAdd(&bar[XB_TMO], 1u); break; } }
    }
    nloc = mine > 0u ? mine : 1u; nx = cnt > 0u ? cnt : 1u;
}
__device__ __forceinline__ void xcd_barrier(const XcdBarrier& b) {
    asm volatile("s_waitcnt vmcnt(0)" ::: "memory");
    __syncthreads();
    if (threadIdx.x == 0) {
        unsigned* bar = b.bar;
        __builtin_amdgcn_s_waitcnt(0);
        unsigned nloc = b.st[0], nx = b.st[1];
        if (nloc == 0u) { xcd_barrier_complete(bar, b.x, nloc, nx); b.st[0] = nloc; b.st[1] = nx; }
        const unsigned old = xb_add(&bar[XB_XSUB(b.x)], 1u);
        const unsigned gen = old / nloc;
        if (old + 1u == (gen + 1u) * nloc) {
            __builtin_amdgcn_fence(__ATOMIC_RELEASE, "agent");
            asm volatile("s_waitcnt vmcnt(0)" ::: "memory");
            const unsigned og = xb_add(&bar[XB_TOP], 1u);
            const unsigned tg = og / nx;
            if (og + 1u == (tg + 1u) * nx) xb_add(&bar[XB_TOPGEN], 1u);
            else XB_SPIN(xb_ld(&bar[XB_TOPGEN]) == tg, bar);
            __builtin_amdgcn_fence(__ATOMIC_ACQUIRE, "agent");
            xb_add(&bar[XB_XGEN(b.x)], 1u);
            asm volatile("s_waitcnt vmcnt(0)" ::: "memory");
        } else {
            XB_SPIN(xb_ld(&bar[XB_XGEN(b.x)]) == gen, bar);
            __builtin_amdgcn_fence(__ATOMIC_ACQUIRE, "agent");
            asm volatile("s_waitcnt vmcnt(0)" ::: "memory");
        }
    }
    __syncthreads();
}

struct Args { const float* in[28]; float* out; unsigned char* ws; int ph_lo, ph_hi; };

struct Frame {
    LAS unsigned char* lds;
    int tid, lane, wave, G, bid;
    const float* in[28];
    float* out; unsigned char* ws;
};
#define WSP(T, off) ((T*)(F.ws + (off)))
#define LDSP(T, off) ((LAS T*)(F.lds + (off)))

__device__ __forceinline__ void p0_transpose_item(const float* W, int K, int N, bf16* WT, LAS float* scr, int item, int nblk, int lane, int sc_lo, int sc_hi, float sc) {
    const int kb = item / nblk, nb = item % nblk, k0 = 64 * kb, n0 = 32 * nb;
    const int ncol = n0 + (lane & 31);
    const float mul = (ncol >= sc_lo && ncol < sc_hi) ? sc : 1.f;
#pragma unroll 8
    for (int i = 0; i < 32; ++i) { const int kk = 2 * i + (lane >> 5); scr[kk * 33 + (lane & 31)] = (ncol < N) ? W[(size_t)(k0 + kk) * N + ncol] * mul : 0.f; }
    asm volatile("s_waitcnt lgkmcnt(0)" ::: "memory");
    const int c = lane & 7;
#pragma unroll
    for (int j = 0; j < 4; ++j) { const int n = (lane >> 3) + 8 * j; const LAS float* s = scr + (8 * c) * 33 + n;
        v4u o; o.x = pk2(s[0 * 33], s[1 * 33]); o.y = pk2(s[2 * 33], s[3 * 33]); o.z = pk2(s[4 * 33], s[5 * 33]); o.w = pk2(s[6 * 33], s[7 * 33]);
        *(v4u*)(WT + (size_t)(n0 + n) * K + k0 + 8 * c) = o; }
    asm volatile("s_waitcnt lgkmcnt(0)" ::: "memory");
}
__device__ __forceinline__ void rms_row_to_bf16(const float* xrow, const float* g, bf16* orow, int lane) {
    f32x4 v[8]; float s = 0.f;
#pragma unroll
    for (int j = 0; j < 4; ++j) { v[2 * j] = *(const f32x4*)(xrow + 512 * j + 8 * lane); v[2 * j + 1] = *(const f32x4*)(xrow + 512 * j + 8 * lane + 4);
        s += (v[2 * j][0] * v[2 * j][0] + v[2 * j][1] * v[2 * j][1]) + (v[2 * j][2] * v[2 * j][2] + v[2 * j][3] * v[2 * j][3]);
        s += (v[2 * j + 1][0] * v[2 * j + 1][0] + v[2 * j + 1][1] * v[2 * j + 1][1]) + (v[2 * j + 1][2] * v[2 * j + 1][2] + v[2 * j + 1][3] * v[2 * j + 1][3]); }
    const float rstd = rsqrtf(wave_sum(s) * (1.f / DM) + EPS);
#pragma unroll
    for (int j = 0; j < 4; ++j) { const f32x4 g0 = *(const f32x4*)(g + 512 * j + 8 * lane), g1 = *(const f32x4*)(g + 512 * j + 8 * lane + 4);
        const f32x4 a = v[2 * j] * rstd * g0, b = v[2 * j + 1] * rstd * g1;
        v4u o; o.x = pk2(a[0], a[1]); o.y = pk2(a[2], a[3]); o.z = pk2(b[0], b[1]); o.w = pk2(b[2], b[3]);
        *(v4u*)(orow + 512 * j + 8 * lane) = o; }
}
__device__ __forceinline__ const float* xrow_ptr(const Frame& F, int m) { return m < MS0 ? F.in[0] + (size_t)m * DM : F.in[1] + (size_t)(m - MS0) * DM; }

__device__ __forceinline__ void p0_prologue(Frame& F) {
    LAS float* scr = LDSP(float, F.wave * 16384);
    const int gw = F.bid * NWAVES + F.wave, NGW = F.G * NWAVES;
    constexpr int I0 = 32 * (N0 / 32), I1 = 32 * (DM / 32), I2 = 32 * (N1P / 32), I3 = 32 * (DM / 32);
    constexpr int NITEMS = I0 + I1 + I2 + I3;
    for (int it = gw; it < NITEMS; it += NGW) {
        int r = it;
        if (r < I0) { p0_transpose_item(F.in[9], DM, N0, WSP(bf16, WS_WT0), scr, r, N0 / 32, F.lane, C0_Q, C0_K, QSCALE); continue; } r -= I0;
        if (r < I1) { p0_transpose_item(F.in[12], DM, DM, WSP(bf16, WS_WO0), scr, r, DM / 32, F.lane, 0, 0, 1.f); continue; } r -= I1;
        if (r < I2) { p0_transpose_item(F.in[15], DM, N1, WSP(bf16, WS_WT1), scr, r, N1P / 32, F.lane, 0, 0, 1.f); continue; } r -= I2;
        p0_transpose_item(F.in[26], DM, DM, WSP(bf16, WS_WO1), scr, r, DM / 32, F.lane, 0, 0, 1.f);
    }
    for (int m = gw; m < MROWS; m += NGW) rms_row_to_bf16(xrow_ptr(F, m), F.in[8], WSP(bf16, WS_H) + (size_t)m * DM, F.lane);
    const size_t gtid = (size_t)F.bid * NTHR + F.tid, gsz = (size_t)F.G * NTHR;
    for (size_t i = gtid; i < 8 * 128 * 128; i += gsz) { const int t = (int)((i >> 7) & 127), s = (int)(i & 127); WSP(bf16, WS_TRIL)[i] = (bf16)f2bf(s <= t ? F.in[18][i] : 0.f); }
    { const f32x4* ck = (const f32x4*)F.in[3]; const f32x4* cv = (const f32x4*)F.in[4]; f32x4* ok = (f32x4*)(F.out + O_SWK); f32x4* ov = (f32x4*)(F.out + O_SWV);
      for (size_t i = gtid; i < 128ull * 124 * 64; i += gsz) { const size_t b = i / (124 * 64), r = i % (124 * 64);
          ok[b * 128 * 64 + r] = ck[b * 128 * 64 + 4 * 64 + r]; ov[b * 128 * 64 + r] = cv[b * 128 * 64 + 4 * 64 + r]; } }
}

__device__ __forceinline__ int rel_bucket(int d) {
    if (d < 16) return d;
    const int large = 16 + (int)(logf((float)d * (1.f / 16.f)) / logf(8.f) * 16.f);
    return large < 31 ? large : 31;
}
constexpr int L2_BIAS = 0;
constexpr int L2_K = 8192;
constexpr int L2_VT = L2_K + 256 * 144;
constexpr int L2_SW = 8192;
constexpr int L2_SW_STRIDE = 12544;
static_assert(L2_VT + 64 * 520 <= LDS_CTL_OFF && L2_SW + 8 * L2_SW_STRIDE <= LDS_CTL_OFF, "P2 LDS");

__device__ __forceinline__ void attn_prompt_unit(Frame& F, int n, int hk) {
    const bf16* Z = WSP(bf16, WS_Z); bf16* Y = WSP(bf16, WS_Y);
    const int tid = F.tid, lane = F.lane, w = F.wave, l31 = lane & 31, hl = lane >> 5;
#pragma unroll
    for (int i = 0; i < 4; ++i) {
        const int item = tid + 512 * i, key = item >> 3, ch = item & 7, pos = 128 * (n - 1) + key;
        v4u kv = (v4u){0u, 0u, 0u, 0u}, vv = (v4u){0u, 0u, 0u, 0u};
        if (pos >= 0) { kv = *(const v4u*)(Z + (size_t)pos * N0 + C0_K + hk * 64 + ch * 8); vv = *(const v4u*)(Z + (size_t)pos * N0 + C0_V + hk * 64 + ch * 8); }
        *(LAS v4u*)(F.lds + L2_K + key * 144 + ch * 16) = kv;
        LAS bf16* vt = LDSP(bf16, L2_VT) + (ch * 8) * 260 + key;
        vt[0 * 260] = (bf16)(vv.x & 0xffffu); vt[1 * 260] = (bf16)(vv.x >> 16); vt[2 * 260] = (bf16)(vv.y & 0xffffu); vt[3 * 260] = (bf16)(vv.y >> 16);
        vt[4 * 260] = (bf16)(vv.z & 0xffffu); vt[5 * 260] = (bf16)(vv.z >> 16); vt[6 * 260] = (bf16)(vv.w & 0xffffu); vt[7 * 260] = (bf16)(vv.w >> 16);
    }
    __syncthreads();
    const int g = w >> 1, head = hk * 4 + g;
    const float sink2 = F.in[11][head] * LOG2E;
    const LAS float* biasd = LDSP(float, L2_BIAS) + head * 128;
    for (int qq = 0; qq < 2; ++qq) {
        const int qt = 2 * (w & 1) + qq;
        const int pos_q = 128 * n + 32 * qt + l31;
        const bf16* qrow = Z + (size_t)pos_q * N0 + C0_Q + head * 64 + 8 * hl;
        bf16x8 qf[4];
#pragma unroll
        for (int ks = 0; ks < 4; ++ks) qf[ks] = *(const bf16x8*)(qrow + 16 * ks);
        f32x16 S[5];
#pragma unroll
        for (int k5 = 0; k5 < 5; ++k5) {
            f32x16 acc = {};
            const LAS unsigned char* kp = F.lds + L2_K + (32 * (qt + k5) + l31) * 144 + 16 * hl;
#pragma unroll
            for (int ks = 0; ks < 4; ++ks) { const bf16x8 a = *(const LAS bf16x8*)(kp + 32 * ks); acc = MFMA32(a, qf[ks], acc); }
            S[k5] = acc;
        }
        float mx = NEGBIG;
#pragma unroll
        for (int k5 = 0; k5 < 5; ++k5)
#pragma unroll
            for (int r = 0; r < 16; ++r) {
                const int cr = crow(r, hl), dist = 128 - 32 * k5 + l31 - cr, j = 32 * (qt + k5) + cr;
                const bool valid = (dist >= 0) && (dist < 128) && (n > 0 || j >= 128);
                const float b = biasd[dist & 127];
                const float s = valid ? S[k5][r] + b : NEGBIG;
                S[k5][r] = s; mx = fmaxf(mx, s);
            }
        mx = fmaxf(mx, __shfl_xor(mx, 32));
        mx = fmaxf(mx, sink2);
        float sum = 0.f;
#pragma unroll
        for (int k5 = 0; k5 < 5; ++k5)
#pragma unroll
            for (int r = 0; r < 16; ++r) { const float p = exp2f(S[k5][r] - mx); S[k5][r] = p; sum += p; }
        sum += __shfl_xor(sum, 32);
        const float inv = 1.f / (sum + exp2f(sink2 - mx));
        f32x16 o0 = {}, o1 = {};
#pragma unroll
        for (int k5 = 0; k5 < 5; ++k5)
#pragma unroll
            for (int sp = 0; sp < 2; ++sp) {
                const bf16x8 pf = pack_frag(S[k5], sp);
                const int kb = 32 * (qt + k5) + 16 * sp + 4 * hl;
                const LAS bf16* v0 = LDSP(bf16, L2_VT) + l31 * 260 + kb;
                const LAS bf16* v1 = v0 + 32 * 260;
                const s16x4 a0 = *(const LAS s16x4*)(v0), a1 = *(const LAS s16x4*)(v0 + 8);
                const s16x4 b0 = *(const LAS s16x4*)(v1), b1 = *(const LAS s16x4*)(v1 + 8);
                const bf16x8 A0 = (bf16x8){a0[0], a0[1], a0[2], a0[3], a1[0], a1[1], a1[2], a1[3]};
                const bf16x8 A1 = (bf16x8){b0[0], b0[1], b0[2], b0[3], b1[0], b1[1], b1[2], b1[3]};
                o0 = MFMA32(A0, pf, o0); o1 = MFMA32(A1, pf, o1);
            }
        const bf16* grow = Z + (size_t)pos_q * N0 + C0_G + head * 64;
        bf16* yrow = Y + (size_t)pos_q * DM + 1024 + head * 64;
#pragma unroll
        for (int dt = 0; dt < 2; ++dt)
#pragma unroll
            for (int q4 = 0; q4 < 4; ++q4) {
                const int d = 32 * dt + 8 * q4 + 4 * hl;
                const v2u gz = *(const v2u*)(grow + d);
                const float g0 = bflo(gz.x), g1 = bfhi(gz.x), g2 = bflo(gz.y), g3 = bfhi(gz.y);
                const float a = (dt ? o1[4 * q4 + 0] : o0[4 * q4 + 0]) * inv, b = (dt ? o1[4 * q4 + 1] : o0[4 * q4 + 1]) * inv,
                            c = (dt ? o1[4 * q4 + 2] : o0[4 * q4 + 2]) * inv, e = (dt ? o1[4 * q4 + 3] : o0[4 * q4 + 3]) * inv;
                v2u o; o.x = pk2(a * silu(g0), b * silu(g1)); o.y = pk2(c * silu(g2), e * silu(g3));
                *(v2u*)(yrow + d) = o;
            }
    }
    __syncthreads();
}

__device__ __forceinline__ void attn_sample_unit(Frame& F, int b, int hk) {
    const bf16* Z = WSP(bf16, WS_Z); bf16* Y = WSP(bf16, WS_Y);
    const int lane = F.lane, w = F.wave;
    LAS float* qs = LDSP(float, L2_SW + w * L2_SW_STRIDE);
    LAS float* ps = qs + 1024;
    const float* ck = F.in[3]; const float* cv = F.in[4];
    {
        const int qi = lane >> 2, d0 = (lane & 3) * 16, gq = qi >> 2, t = qi & 3;
        const bf16* qp = Z + (size_t)(MS0 + 4 * b + t) * N0 + C0_Q + (hk * 4 + gq) * 64 + d0;
        const v4u a = *(const v4u*)qp, c = *(const v4u*)(qp + 8);
        float f[8]; UNPACK8(a, f);
#pragma unroll
        for (int i = 0; i < 8; ++i) qs[qi * 64 + d0 + i] = f[i];
        UNPACK8(c, f);
#pragma unroll
        for (int i = 0; i < 8; ++i) qs[qi * 64 + d0 + 8 + i] = f[i];
    }
#pragma unroll 1
    for (int pss = 0; pss < 3; ++pss) {
        const int j = 64 * pss + lane;
        if (j < 132) {
            float acc[16];
#pragma unroll
            for (int qi = 0; qi < 16; ++qi) acc[qi] = 0.f;
#pragma unroll 1
            for (int dc = 0; dc < 4; ++dc) {
                float k[16];
                if (j < 128) { const float* kp = ck + ((size_t)(b * 128 + j) * 4 + hk) * 64 + 16 * dc;
#pragma unroll
                    for (int i = 0; i < 4; ++i) { const f32x4 t4 = *(const f32x4*)(kp + 4 * i); k[4 * i] = t4[0]; k[4 * i + 1] = t4[1]; k[4 * i + 2] = t4[2]; k[4 * i + 3] = t4[3]; } }
                else { const bf16* kp = Z + (size_t)(MS0 + 4 * b + (j - 128)) * N0 + C0_K + hk * 64 + 16 * dc;
                    const v4u a = *(const v4u*)kp, c = *(const v4u*)(kp + 8);
                    k[0] = bflo(a.x); k[1] = bfhi(a.x); k[2] = bflo(a.y); k[3] = bfhi(a.y); k[4] = bflo(a.z); k[5] = bfhi(a.z); k[6] = bflo(a.w); k[7] = bfhi(a.w);
                    k[8] = bflo(c.x); k[9] = bfhi(c.x); k[10] = bflo(c.y); k[11] = bfhi(c.y); k[12] = bflo(c.z); k[13] = bfhi(c.z); k[14] = bflo(c.w); k[15] = bfhi(c.w); }
#pragma unroll
                for (int qi = 0; qi < 16; ++qi) {
#pragma unroll
                    for (int i = 0; i < 4; ++i) { const f32x4 q4 = *(const LAS f32x4*)(qs + qi * 64 + 16 * dc + 4 * i);
                        acc[qi] += k[4 * i] * q4[0] + k[4 * i + 1] * q4[1] + k[4 * i + 2] * q4[2] + k[4 * i + 3] * q4[3]; }
                }
            }
#pragma unroll
            for (int qi = 0; qi < 16; ++qi) {
                const int t = qi & 3, gq = qi >> 2, dist = 128 + t - j;
                const bool valid = (dist >= 0) && (dist < 128);
                const float bb = LDSP(float, L2_BIAS)[(hk * 4 + gq) * 128 + (dist & 127)];
                ps[j * 16 + qi] = valid ? acc[qi] + bb : NEGBIG;
            }
        }
    }
#pragma unroll 1
    for (int qi = 0; qi < 16; ++qi) {
        const float sink2 = F.in[11][hk * 4 + (qi >> 2)] * LOG2E;
        const float s0 = ps[lane * 16 + qi], s1 = ps[(64 + lane) * 16 + qi], s2 = (lane < 4) ? ps[(128 + lane) * 16 + qi] : NEGBIG;
        float m = fmaxf(fmaxf(s0, s1), s2);
        m = fmaxf(wave_max(m), sink2);
        const float p0 = exp2f(s0 - m), p1 = exp2f(s1 - m), p2 = exp2f(s2 - m);
        const float inv = 1.f / (wave_sum(p0 + p1 + p2) + exp2f(sink2 - m));
        ps[lane * 16 + qi] = p0 * inv; ps[(64 + lane) * 16 + qi] = p1 * inv;
        if (lane < 4) ps[(128 + lane) * 16 + qi] = p2 * inv;
    }
    float o[16];
#pragma unroll
    for (int qi = 0; qi < 16; ++qi) o[qi] = 0.f;
#pragma unroll 2
    for (int j = 0; j < 132; ++j) {
        const float v = (j < 128) ? cv[((size_t)(b * 128 + j) * 4 + hk) * 64 + lane] : bf1(Z[(size_t)(MS0 + 4 * b + (j - 128)) * N0 + C0_V + hk * 64 + lane]);
#pragma unroll
        for (int i = 0; i < 4; ++i) { const f32x4 p4 = *(const LAS f32x4*)(ps + j * 16 + 4 * i);
            o[4 * i] += p4[0] * v; o[4 * i + 1] += p4[1] * v; o[4 * i + 2] += p4[2] * v; o[4 * i + 3] += p4[3] * v; }
    }
#pragma unroll
    for (int qi = 0; qi < 16; ++qi) {
        const int t = qi & 3, head = hk * 4 + (qi >> 2); const size_t m = MS0 + 4 * b + t;
        const float gate = bf1(Z[m * N0 + C0_G + head * 64 + lane]);
        Y[m * DM + 1024 + head * 64 + lane] = (bf16)f2bf(o[qi] * silu(gate));
    }
}

__device__ __forceinline__ void p2_mixers0(Frame& F) {
    const bf16* Z = WSP(bf16, WS_Z); bf16* Y = WSP(bf16, WS_Y);
    for (int i = F.tid; i < 16 * 128; i += NTHR) { const int head = i >> 7, d = i & 127; LDSP(float, L2_BIAS)[i] = F.in[7][rel_bucket(d) * 16 + head] * LOG2E; }
    __syncthreads();
#ifndef NO_PROMPT
    for (int u = F.bid; u < 256; u += F.G) attn_prompt_unit(F, u >> 2, u & 3);
#endif
    __syncthreads();
#ifndef NO_SAMPLE
    for (int u = F.wave * F.G + F.bid; u < 512; u += NWAVES * F.G) attn_sample_unit(F, u >> 2, u & 3);
#endif
    const size_t gtid = (size_t)F.bid * NTHR + F.tid, gsz = (size_t)F.G * NTHR;
    const float* cw = F.in[10]; const float* sca = F.in[2];
    for (size_t it = gtid; it < (size_t)MROWS * 128; it += gsz) {
        const int m = (int)(it >> 7), c0 = (int)(it & 127) * 8;
        const bf16* zr = Z + (size_t)m * N0;
        float ac[8], ah[8], s0[8], s1[8], s2[8];
        { const v4u a = *(const v4u*)(zr + C0_AC + c0), h = *(const v4u*)(zr + C0_AH + c0); UNPACK8(a, ac); UNPACK8(h, ah); }
#pragma unroll
        for (int i = 0; i < 8; ++i) s2[i] = ac[i] * ah[i];
        int t, b = 0; bool samp = m >= MS0;
        if (!samp) t = m; else { b = (m - MS0) >> 2; t = (m - MS0) & 3; }
        if (t >= 1) { const v4u a = *(const v4u*)(zr - N0 + C0_AC + c0), h = *(const v4u*)(zr - N0 + C0_AH + c0); UNPACK8(a, ac); UNPACK8(h, ah);
#pragma unroll
            for (int i = 0; i < 8; ++i) s1[i] = ac[i] * ah[i]; }
        else if (samp) {
#pragma unroll
            for (int i = 0; i < 8; ++i) s1[i] = sca[(size_t)(b * 2 + 1) * 1024 + c0 + i]; }
        else {
#pragma unroll
            for (int i = 0; i < 8; ++i) s1[i] = 0.f; }
        if (t >= 2) { const v4u a = *(const v4u*)(zr - 2 * N0 + C0_AC + c0), h = *(const v4u*)(zr - 2 * N0 + C0_AH + c0); UNPACK8(a, ac); UNPACK8(h, ah);
#pragma unroll
            for (int i = 0; i < 8; ++i) s0[i] = ac[i] * ah[i]; }
        else if (samp) {
#pragma unroll
            for (int i = 0; i < 8; ++i) s0[i] = sca[(size_t)(b * 2 + t) * 1024 + c0 + i]; }
        else {
#pragma unroll
            for (int i = 0; i < 8; ++i) s0[i] = 0.f; }
        float ab[8], ag[8], y[8];
        { const v4u a = *(const v4u*)(zr + C0_AB + c0), h = *(const v4u*)(zr + C0_AG + c0); UNPACK8(a, ab); UNPACK8(h, ag); }
#pragma unroll
        for (int i = 0; i < 8; ++i) { const float cv_ = cw[c0 + i] * s0[i] + cw[1024 + c0 + i] * s1[i] + cw[2048 + c0 + i] * s2[i]; y[i] = ab[i] * cv_ * silu(ag[i]); }
        *(v4u*)(Y + (size_t)m * DM + c0) = pack8(y);
        if (!samp && m >= SEQ - 2) {
#pragma unroll
            for (int i = 0; i < 8; ++i) F.out[O_PCA + (size_t)(m - (SEQ - 2)) * 1024 + c0 + i] = s2[i]; }
        if (samp && t >= 2) {
#pragma unroll
            for (int i = 0; i < 8; ++i) F.out[O_SCA + (size_t)(b * 2 + (t - 2)) * 1024 + c0 + i] = s2[i]; }
    }
    for (size_t it = gtid; it < 128ull * 32; it += gsz) {
        const int j = (int)(it >> 5), c0 = (int)(it & 31) * 8; const bf16* zr = Z + (size_t)(SEQ - 128 + j) * N0;
        float f[8]; { const v4u a = *(const v4u*)(zr + C0_K + c0); UNPACK8(a, f); }
#pragma unroll
        for (int i = 0; i < 8; ++i) F.out[O_PWK + (size_t)j * 256 + c0 + i] = f[i];
        { const v4u a = *(const v4u*)(zr + C0_V + c0); UNPACK8(a, f); }
#pragma unroll
        for (int i = 0; i < 8; ++i) F.out[O_PWV + (size_t)j * 256 + c0 + i] = f[i];
    }
    for (size_t it = gtid; it < 512ull * 32; it += gsz) {
        const int r = (int)(it >> 5), c0 = (int)(it & 31) * 8, b = r >> 2, t = r & 3; const bf16* zr = Z + (size_t)(MS0 + r) * N0;
        float f[8]; { const v4u a = *(const v4u*)(zr + C0_K + c0); UNPACK8(a, f); }
#pragma unroll
        for (int i = 0; i < 8; ++i) F.out[O_SWK + ((size_t)b * 128 + 124 + t) * 256 + c0 + i] = f[i];
        { const v4u a = *(const v4u*)(zr + C0_V + c0); UNPACK8(a, f); }
#pragma unroll
        for (int i = 0; i < 8; ++i) F.out[O_SWV + ((size_t)b * 128 + 124 + t) * 256 + c0 + i] = f[i];
    }
}

__device__ __forceinline__ void row_pass(Frame& F, bool layer0, const float* gpost, const float* gpre, bf16* H) {
    const bf16* Yo = WSP(bf16, WS_Z);
    const int gw = F.bid * NWAVES + F.wave, NGW = F.G * NWAVES, lane = F.lane;
    for (int m = gw; m < MROWS; m += NGW) {
        float yv[32]; float ss = 0.f;
#pragma unroll
        for (int j = 0; j < 4; ++j) { const v4u a = *(const v4u*)(Yo + (size_t)m * DM + 512 * j + 8 * lane); float* f = yv + 8 * j; UNPACK8(a, f);
#pragma unroll
            for (int i = 0; i < 8; ++i) ss += f[i] * f[i]; }
        const float rstd = rsqrtf(wave_sum(ss) * (1.f / DM) + EPS);
        const float* xin = layer0 ? xrow_ptr(F, m) : F.out + (size_t)m * DM;
        float* xo = F.out + (size_t)m * DM;
        float s1 = 0.f;
#pragma unroll
        for (int j = 0; j < 4; ++j) {
            const int e = 512 * j + 8 * lane;
            const f32x4 x0 = *(const f32x4*)(xin + e), x1 = *(const f32x4*)(xin + e + 4), g0 = *(const f32x4*)(gpost + e), g1 = *(const f32x4*)(gpost + e + 4);
            f32x4 r0, r1;
#pragma unroll
            for (int i = 0; i < 4; ++i) { r0[i] = x0[i] + yv[8 * j + i] * rstd * g0[i]; r1[i] = x1[i] + yv[8 * j + 4 + i] * rstd * g1[i]; }
            *(f32x4*)(xo + e) = r0; *(f32x4*)(xo + e + 4) = r1;
#pragma unroll
            for (int i = 0; i < 4; ++i) { yv[8 * j + i] = r0[i]; yv[8 * j + 4 + i] = r1[i]; s1 += r0[i] * r0[i] + r1[i] * r1[i]; }
        }
        if (H != nullptr) {
            const float rs1 = rsqrtf(wave_sum(s1) * (1.f / DM) + EPS);
#pragma unroll
            for (int j = 0; j < 4; ++j) { const int e = 512 * j + 8 * lane; const f32x4 g0 = *(const f32x4*)(gpre + e), g1 = *(const f32x4*)(gpre + e + 4);
                float f[8];
#pragma unroll
                for (int i = 0; i < 4; ++i) { f[i] = yv[8 * j + i] * rs1 * g0[i]; f[4 + i] = yv[8 * j + 4 + i] * rs1 * g1[i]; }
                *(v4u*)(H + (size_t)m * DM + e) = pack8(f); }
        }
    }
}

__device__ __forceinline__ float softplus_f(float x) { return fmaxf(x, 0.f) + log1pf(__expf(-fabsf(x))); }

__device__ __forceinline__ void conv_act8(const bf16* Z, const float* cw, const float* cb, int row, int ch0, float* act) {
    float a[8];
#pragma unroll
    for (int i = 0; i < 8; ++i) a[i] = cb[ch0 + i];
#pragma unroll
    for (int j = 0; j < 4; ++j) {
        const int r = row - 3 + j;
        if (r >= 0) { const v4u v = *(const v4u*)(Z + (size_t)r * N1P + C1_X + ch0); float f[8]; UNPACK8(v, f);
#pragma unroll
            for (int i = 0; i < 8; ++i) a[i] += cw[j * 1536 + ch0 + i] * f[i]; }
    }
#pragma unroll
    for (int i = 0; i < 8; ++i) act[i] = silu(a[i]);
}

constexpr int LA_BT = 0;
constexpr int LA_XW = 34816;
constexpr int LA_ACS = LA_XW + 69632;
constexpr int LA_DT = LA_ACS + 2048;
constexpr int LA_SC = LA_DT + 2048;
static_assert(LA_SC + 2048 <= LDS_CTL_OFF, "P6a LDS");
__device__ __forceinline__ void p6a_unit(Frame& F, int c, int gi, int hq) {
    const bf16* Z = WSP(bf16, WS_Z); bf16* XA = WSP(bf16, WS_XA);
    const float* cw = F.in[20]; const float* cb = F.in[21];
    const int tid = F.tid, lane = F.lane, w = F.wave, T0 = 128 * c;
    if (w < 4) {
        const int hh = gi * 8 + hq * 4 + w;
        const float a = -__expf(F.in[23][hh]), bias = F.in[22][hh];
        const float d0 = softplus_f(WSP(float, WS_DTR)[(size_t)(T0 + 2 * lane) * 16 + hh] + bias), d1 = softplus_f(WSP(float, WS_DTR)[(size_t)(T0 + 2 * lane + 1) * 16 + hh] + bias);
        const float v0 = d0 * a, v1 = d1 * a;
        float inc = v0 + v1;
#pragma unroll
        for (int o = 1; o < 64; o <<= 1) { const float t = __shfl_up(inc, o); if (lane >= o) inc += t; }
        const float a1 = inc, a0 = inc - v1;
        const float total = __shfl(inc, 63);
        LDSP(float, LA_ACS)[w * 128 + 2 * lane] = a0; LDSP(float, LA_ACS)[w * 128 + 2 * lane + 1] = a1;
        LDSP(float, LA_DT)[w * 128 + 2 * lane] = d0; LDSP(float, LA_DT)[w * 128 + 2 * lane + 1] = d1;
        LDSP(float, LA_SC)[w * 128 + 2 * lane] = __expf(total - a0) * d0; LDSP(float, LA_SC)[w * 128 + 2 * lane + 1] = __expf(total - a1) * d1;
        WSP(float, WS_ACS)[(size_t)(T0 + 2 * lane) * 16 + hh] = a0; WSP(float, WS_ACS)[(size_t)(T0 + 2 * lane + 1) * 16 + hh] = a1;
        WSP(float, WS_DTV)[(size_t)(T0 + 2 * lane) * 16 + hh] = d0; WSP(float, WS_DTV)[(size_t)(T0 + 2 * lane + 1) * 16 + hh] = d1;
        if (lane == 0) WSP(float, WS_CD)[c * 16 + hh] = __expf(total);
    }
    __syncthreads();
#pragma unroll
    for (int i = 0; i < 4; ++i) {
        const int item = tid + 512 * i, s = item >> 4, ch8 = item & 15;
        float act[8]; conv_act8(Z, cw, cb, T0 + s, 1024 + gi * 128 + ch8 * 8, act);
        LAS bf16* bt = LDSP(bf16, LA_BT) + (ch8 * 8) * 136 + s;
#pragma unroll
        for (int k = 0; k < 8; ++k) bt[k * 136] = (bf16)f2bf(act[k]);
        if (hq == 0) *(v4u*)(XA + (size_t)(T0 + s) * 1536 + 1024 + gi * 128 + ch8 * 8) = pack8(act);
        else { conv_act8(Z, cw, cb, T0 + s, 1280 + gi * 128 + ch8 * 8, act); *(v4u*)(XA + (size_t)(T0 + s) * 1536 + 1280 + gi * 128 + ch8 * 8) = pack8(act); }
    }
#pragma unroll
    for (int i = 0; i < 8; ++i) {
        const int item = tid + 512 * i, s = item >> 5, ch = item & 31, h4 = ch >> 3, p0 = (ch & 7) * 8;
        const int chan = (gi * 8 + hq * 4 + h4) * 64 + p0;
        float act[8]; conv_act8(Z, cw, cb, T0 + s, chan, act);
        *(v4u*)(XA + (size_t)(T0 + s) * 1536 + chan) = pack8(act);
        const float scl = LDSP(float, LA_SC)[h4 * 128 + s];
        LAS bf16* xw = LDSP(bf16, LA_XW) + (h4 * 64 + p0) * 136 + s;
#pragma unroll
        for (int k = 0; k < 8; ++k) xw[k * 136] = (bf16)f2bf(act[k] * scl);
    }
    __syncthreads();
    {
        const int h4 = w >> 1, nh = w & 1, l31 = lane & 31, hl = lane >> 5, hh = gi * 8 + hq * 4 + h4;
        f32x16 acc[2][2] = {};
#pragma unroll
        for (int ks = 0; ks < 8; ++ks) {
            bf16x8 a[2], b[2];
#pragma unroll
            for (int pt = 0; pt < 2; ++pt) a[pt] = *(const LAS bf16x8*)(LDSP(bf16, LA_XW) + (h4 * 64 + 32 * pt + l31) * 136 + 16 * ks + 8 * hl);
#pragma unroll
            for (int n2 = 0; n2 < 2; ++n2) b[n2] = *(const LAS bf16x8*)(LDSP(bf16, LA_BT) + (32 * (2 * nh + n2) + l31) * 136 + 16 * ks + 8 * hl);
#pragma unroll
            for (int pt = 0; pt < 2; ++pt)
#pragma unroll
                for (int n2 = 0; n2 < 2; ++n2) acc[pt][n2] = MFMA32(a[pt], b[n2], acc[pt][n2]);
        }
        float* cs = WSP(float, WS_H) + ((size_t)(c * 16 + hh) * 64) * 128;
#pragma unroll
        for (int pt = 0; pt < 2; ++pt)
#pragma unroll
            for (int n2 = 0; n2 < 2; ++n2)
#pragma unroll
                for (int r = 0; r < 16; ++r) cs[(size_t)(32 * pt + crow(r, hl)) * 128 + 32 * (2 * nh + n2) + l31] = acc[pt][n2][r];
    }
    {
#pragma unroll
        for (int rr = 0; rr < 4; ++rr) {
            const int row = T0 + 32 * (2 * gi + hq) + 4 * w + rr;
            const bf16* vp = Z + (size_t)row * N1P + C1_V;
            float f[16]; { const v4u a = *(const v4u*)(vp + 8 * lane), b2 = *(const v4u*)(vp + 512 + 8 * lane); UNPACK8(a, f); float* f2 = f + 8; UNPACK8(b2, f2); }
            float s = 0.f;
#pragma unroll
            for (int i = 0; i < 16; ++i) s += f[i];
            const float mean = wave_sum(s) * (1.f / 1024.f);
            float q = 0.f;
#pragma unroll
            for (int i = 0; i < 16; ++i) { const float d = f[i] - mean; q += d * d; }
            const float rstd = rsqrtf(wave_sum(q) * (1.f / 1024.f) + EPS);
            if (lane == 0) { WSP(float, WS_VST)[2 * row] = mean; WSP(float, WS_VST)[2 * row + 1] = rstd; }
        }
    }
    __syncthreads();
}

__device__ __forceinline__ void p6b_scan(Frame& F) {
    float* cs = WSP(float, WS_H); const float* cd = WSP(float, WS_CD);
    for (int e = F.bid * NTHR + F.tid; e < 131072; e += F.G * NTHR) {
        const int hh = e >> 13; float st = 0.f;
        for (int c0 = 0; c0 < 64; c0 += 8) {
            float s[8];
#pragma unroll
            for (int i = 0; i < 8; ++i) s[i] = cs[(size_t)(c0 + i) * 131072 + e];
#pragma unroll
            for (int i = 0; i < 8; ++i) { cs[(size_t)(c0 + i) * 131072 + e] = st; st = cd[(c0 + i) * 16 + hh] * st + s[i]; }
        }
        F.out[O_PSSM + e] = st;
    }
}

constexpr int LC_XT = 0;
constexpr int LC_ACS = 135168;
constexpr int LC_DT = LC_ACS + 4096;
constexpr int LC_SSQ = LC_DT + 4096;
static_assert(LC_SSQ + 2048 <= LDS_CTL_OFF, "P6c LDS");
__device__ __forceinline__ void p6c_ssd_unit(Frame& F, int c, int gi, int th) {
    const bf16* Z = WSP(bf16, WS_Z); const bf16* XA = WSP(bf16, WS_XA); bf16* Y = WSP(bf16, WS_Y);
    const int tid = F.tid, lane = F.lane, w = F.wave, T0 = 128 * c, l31 = lane & 31, hl = lane >> 5;
    const int ns = 64 * (th + 1);
    for (int item = tid; item < ns * 64; item += NTHR) {
        const int s = item >> 6, ch = item & 63, h8 = ch >> 3, p0 = (ch & 7) * 8;
        const v4u v = *(const v4u*)(XA + (size_t)(T0 + s) * 1536 + (gi * 8 + h8) * 64 + p0);
        LAS bf16* xt = LDSP(bf16, LC_XT) + (h8 * 64 + p0) * 132 + s;
        xt[0 * 132] = (bf16)(v.x & 0xffffu); xt[1 * 132] = (bf16)(v.x >> 16); xt[2 * 132] = (bf16)(v.y & 0xffffu); xt[3 * 132] = (bf16)(v.y >> 16);
        xt[4 * 132] = (bf16)(v.z & 0xffffu); xt[5 * 132] = (bf16)(v.z >> 16); xt[6 * 132] = (bf16)(v.w & 0xffffu); xt[7 * 132] = (bf16)(v.w >> 16);
    }
    for (int i = tid; i < 8 * 128; i += NTHR) { const int h8 = i >> 7, s = i & 127;
        LDSP(float, LC_ACS)[i] = WSP(float, WS_ACS)[(size_t)(T0 + s) * 16 + gi * 8 + h8]; LDSP(float, LC_DT)[i] = WSP(float, WS_DTV)[(size_t)(T0 + s) * 16 + gi * 8 + h8]; }
    __syncthreads();
    const int hh = gi * 8 + w;
    const float dskip = F.in[24][hh];
    const LAS float* acsL = LDSP(float, LC_ACS) + w * 128; const LAS float* dtL = LDSP(float, LC_DT) + w * 128;
    const float* hprev = WSP(float, WS_H) + ((size_t)(c * 16 + hh) * 64) * 128;
    f32x16 G[2][2];
    float ssq[2];
#pragma unroll
    for (int t2 = 0; t2 < 2; ++t2) {
        const int tt = 2 * th + t2, tl = 32 * tt + l31;
        const float acs_t = acsL[tl];
        bf16x8 cf[8];
#pragma unroll
        for (int ks = 0; ks < 8; ++ks) cf[ks] = *(const bf16x8*)(XA + (size_t)(T0 + tl) * 1536 + 1280 + gi * 128 + 16 * ks + 8 * hl);
        f32x16 acc[2] = {};
#pragma unroll
        for (int ks = 0; ks < 8; ++ks)
#pragma unroll
            for (int pt = 0; pt < 2; ++pt) { const bf16x8 a = frag_from_f32(hprev + (size_t)(32 * pt + l31) * 128 + 16 * ks + 8 * hl); acc[pt] = MFMA32(a, cf[ks], acc[pt]); }
        const float ea = __expf(acs_t);
#pragma unroll
        for (int pt = 0; pt < 2; ++pt)
#pragma unroll
            for (int r = 0; r < 16; ++r) acc[pt][r] *= ea;
        for (int st = 0; st <= tt; ++st) {
            f32x16 cb = {};
#pragma unroll
            for (int ks = 0; ks < 8; ++ks) { const bf16x8 b = *(const bf16x8*)(XA + (size_t)(T0 + 32 * st + l31) * 1536 + 1024 + gi * 128 + 16 * ks + 8 * hl); cb = MFMA32(b, cf[ks], cb); }
#pragma unroll
            for (int q4 = 0; q4 < 4; ++q4) {
                const int sb = 32 * st + 8 * q4 + 4 * hl;
                const f32x4 as4 = *(const LAS f32x4*)(acsL + sb), dt4 = *(const LAS f32x4*)(dtL + sb);
#pragma unroll
                for (int i = 0; i < 4; ++i) {
                    const int s = sb + i;
                    float wv = cb[4 * q4 + i] * __expf(fminf(acs_t - as4[i], 0.f)) * dt4[i];
                    wv = (s <= tl) ? wv : 0.f;
                    wv += (s == tl) ? dskip : 0.f;
                    cb[4 * q4 + i] = wv;
                }
            }
#pragma unroll
            for (int sp = 0; sp < 2; ++sp) {
                const bf16x8 wf = pack_frag(cb, sp);
#pragma unroll
                for (int pt = 0; pt < 2; ++pt) {
                    const LAS bf16* xp = LDSP(bf16, LC_XT) + (w * 64 + 32 * pt + l31) * 132 + 32 * st + 16 * sp + 4 * hl;
                    const s16x4 a0 = *(const LAS s16x4*)(xp), a1 = *(const LAS s16x4*)(xp + 8);
                    const bf16x8 A = (bf16x8){a0[0], a0[1], a0[2], a0[3], a1[0], a1[1], a1[2], a1[3]};
                    acc[pt] = MFMA32(A, wf, acc[pt]);
                }
            }
        }
        float q = 0.f;
        const bf16* zrow = Z + (size_t)(T0 + tl) * N1P + C1_Z + hh * 64;
#pragma unroll
        for (int pt = 0; pt < 2; ++pt)
#pragma unroll
            for (int q4 = 0; q4 < 4; ++q4) {
                const v2u zz = *(const v2u*)(zrow + 32 * pt + 8 * q4 + 4 * hl);
                const float z0 = bflo(zz.x), z1 = bfhi(zz.x), z2 = bflo(zz.y), z3 = bfhi(zz.y);
                const float g0 = acc[pt][4 * q4] * silu(z0), g1 = acc[pt][4 * q4 + 1] * silu(z1), g2 = acc[pt][4 * q4 + 2] * silu(z2), g3 = acc[pt][4 * q4 + 3] * silu(z3);
                G[t2][pt][4 * q4] = g0; G[t2][pt][4 * q4 + 1] = g1; G[t2][pt][4 * q4 + 2] = g2; G[t2][pt][4 * q4 + 3] = g3;
                q += (g0 * g0 + g1 * g1) + (g2 * g2 + g3 * g3);
            }
        q += __shfl_xor(q, 32);
        ssq[t2] = q;
        if (hl == 0) LDSP(float, LC_SSQ)[w * 64 + 32 * t2 + l31] = q;
    }
    __syncthreads();
    const float* gng = F.in[25] + hh * 64;
#pragma unroll
    for (int t2 = 0; t2 < 2; ++t2) {
        float tot = 0.f;
#pragma unroll
        for (int k = 0; k < 8; ++k) tot += LDSP(float, LC_SSQ)[k * 64 + 32 * t2 + l31];
        const float rstd = rsqrtf(tot * (1.f / 512.f) + EPS);
        const int tl = 32 * (2 * th + t2) + l31;
        bf16* yrow = Y + (size_t)(T0 + tl) * DM + 1024 + hh * 64;
#pragma unroll
        for (int pt = 0; pt < 2; ++pt)
#pragma unroll
            for (int q4 = 0; q4 < 4; ++q4) {
                const int p = 32 * pt + 8 * q4 + 4 * hl;
                const f32x4 gg = *(const f32x4*)(gng + p);
                v2u o; o.x = pk2(G[t2][pt][4 * q4] * rstd * gg[0], G[t2][pt][4 * q4 + 1] * rstd * gg[1]); o.y = pk2(G[t2][pt][4 * q4 + 2] * rstd * gg[2], G[t2][pt][4 * q4 + 3] * rstd * gg[3]);
                *(v2u*)(yrow + p) = o;
            }
    }
    (void)ssq;
    __syncthreads();
}

constexpr int LM_VT = 0;
__device__ __forceinline__ void p6c_mlp_unit(Frame& F, int c, int g) {
    const bf16* Z = WSP(bf16, WS_Z); bf16* Y = WSP(bf16, WS_Y); const bf16* TR = WSP(bf16, WS_TRIL) + (size_t)g * 16384;
    const int tid = F.tid, lane = F.lane, w = F.wave, T0 = 128 * c, l31 = lane & 31, hl = lane >> 5;
    const float* lng = F.in[16]; const float* lnb = F.in[17];
#pragma unroll
    for (int i = 0; i < 4; ++i) {
        const int item = tid + 512 * i, s = item >> 4, ch8 = item & 15, col = g * 128 + ch8 * 8;
        const v4u v = *(const v4u*)(Z + (size_t)(T0 + s) * N1P + C1_V + col); float f[8]; UNPACK8(v, f);
        const float mean = WSP(float, WS_VST)[2 * (T0 + s)], rstd = WSP(float, WS_VST)[2 * (T0 + s) + 1];
        LAS bf16* vt = LDSP(bf16, LM_VT) + (ch8 * 8) * 136 + s;
#pragma unroll
        for (int k = 0; k < 8; ++k) vt[k * 136] = (bf16)f2bf((f[k] - mean) * rstd * lng[col + k] + lnb[col + k]);
    }
    __syncthreads();
    const int tt = w >> 1;
    f32x16 acc[2] = {};
    for (int ks = 0; ks < 2 * (tt + 1); ++ks) {
        const bf16x8 a = *(const bf16x8*)(TR + (size_t)(32 * tt + l31) * 128 + 16 * ks + 8 * hl);
#pragma unroll
        for (int w2 = 0; w2 < 2; ++w2) { const bf16x8 b = *(const LAS bf16x8*)(LDSP(bf16, LM_VT) + (32 * (2 * (w & 1) + w2) + l31) * 136 + 16 * ks + 8 * hl); acc[w2] = MFMA32(a, b, acc[w2]); }
    }
    const float* bs = F.in[19] + g * 128;
#pragma unroll
    for (int w2 = 0; w2 < 2; ++w2)
#pragma unroll
        for (int r = 0; r < 16; ++r) {
            const int t = 32 * tt + crow(r, hl), col = g * 128 + 32 * (2 * (w & 1) + w2) + l31;
            const bf16* zr = Z + (size_t)(T0 + t) * N1P;
            const float u = bf1(zr[C1_U + col]), cg = bf1(zr[C1_CG + col]);
            Y[(size_t)(T0 + t) * DM + col] = (bf16)f2bf(u * (acc[w2][r] + bs[t]) * silu(cg));
        }
    __syncthreads();
}

constexpr int LS_W = 0, LS_W_STRIDE = 6144;
constexpr int LS_SSQ = 8 * LS_W_STRIDE;
__device__ __forceinline__ void p6c_sample_unit(Frame& F, int b, int gi) {
    const bf16* Z = WSP(bf16, WS_Z); bf16* Y = WSP(bf16, WS_Y);
    const float* cw = F.in[20]; const float* cb = F.in[21]; const float* scd = F.in[5];
    const int lane = F.lane, w = F.wave, hh = gi * 8 + w; const size_t m0 = MS0 + 4 * b;
    LAS float* xs = LDSP(float, LS_W + w * LS_W_STRIDE); LAS float* Bs = xs + 256; LAS float* Cs = Bs + 512; LAS float* ys = Cs + 512;
#pragma unroll
    for (int k = 0; k < 5; ++k) {
        const int ch = (k == 0) ? hh * 64 + lane : (k < 3 ? 1024 + gi * 128 + (k - 1) * 64 + lane : 1280 + gi * 128 + (k - 3) * 64 + lane);
        float full[7];
#pragma unroll
        for (int i = 0; i < 3; ++i) full[i] = scd[((size_t)b * 3 + i) * 1536 + ch];
#pragma unroll
        for (int t = 0; t < 4; ++t) full[3 + t] = bf1(Z[(m0 + t) * N1P + C1_X + ch]);
        const float w0 = cw[ch], w1 = cw[1536 + ch], w2 = cw[3072 + ch], w3 = cw[4608 + ch], bb = cb[ch];
#pragma unroll
        for (int t = 0; t < 4; ++t) {
            const float a = silu(w0 * full[t] + w1 * full[t + 1] + w2 * full[t + 2] + w3 * full[t + 3] + bb);
            if (k == 0) xs[t * 64 + lane] = a; else if (k < 3) Bs[t * 128 + (k - 1) * 64 + lane] = a; else Cs[t * 128 + (k - 3) * 64 + lane] = a;
        }
        if (k == 0 || w == 0) {
#pragma unroll
            for (int i = 0; i < 3; ++i) F.out[O_SCD + ((size_t)b * 3 + i) * 1536 + ch] = full[4 + i]; }
    }
    float dtv[4], dA[4];
    { const float a = -__expf(F.in[23][hh]), bias = F.in[22][hh];
#pragma unroll
      for (int t = 0; t < 4; ++t) { dtv[t] = softplus_f(WSP(float, WS_DTR)[(m0 + t) * 16 + hh] + bias); dA[t] = __expf(dtv[t] * a); } }
    const int plo = lane >> 4, n0 = 8 * (lane & 15);
    float Br[4][8], Cr[4][8];
#pragma unroll
    for (int t = 0; t < 4; ++t) { const f32x4 b0 = *(const LAS f32x4*)(Bs + t * 128 + n0), b1 = *(const LAS f32x4*)(Bs + t * 128 + n0 + 4), c0 = *(const LAS f32x4*)(Cs + t * 128 + n0), c1 = *(const LAS f32x4*)(Cs + t * 128 + n0 + 4);
#pragma unroll
        for (int i = 0; i < 4; ++i) { Br[t][i] = b0[i]; Br[t][4 + i] = b1[i]; Cr[t][i] = c0[i]; Cr[t][4 + i] = c1[i]; } }
    const float* sin_ = F.in[6] + ((size_t)(b * 16 + hh) * 64) * 128; float* sout = F.out + O_SSSM + ((size_t)(b * 16 + hh) * 64) * 128;
    for (int pi = 0; pi < 16; ++pi) {
        const int p = 4 * pi + plo;
        const f32x4 h0 = *(const f32x4*)(sin_ + (size_t)p * 128 + n0), h1 = *(const f32x4*)(sin_ + (size_t)p * 128 + n0 + 4);
        float h[8];
#pragma unroll
        for (int i = 0; i < 4; ++i) { h[i] = h0[i]; h[4 + i] = h1[i]; }
        float yp[4];
#pragma unroll
        for (int t = 0; t < 4; ++t) {
            const float coef = dtv[t] * xs[t * 64 + p]; float acc = 0.f;
#pragma unroll
            for (int i = 0; i < 8; ++i) { h[i] = dA[t] * h[i] + coef * Br[t][i]; acc += h[i] * Cr[t][i]; }
            yp[t] = acc;
        }
        *(f32x4*)(sout + (size_t)p * 128 + n0) = (f32x4){h[0], h[1], h[2], h[3]}; *(f32x4*)(sout + (size_t)p * 128 + n0 + 4) = (f32x4){h[4], h[5], h[6], h[7]};
#pragma unroll
        for (int t = 0; t < 4; ++t) { float v = yp[t]; v += __shfl_xor(v, 1); v += __shfl_xor(v, 2); v += __shfl_xor(v, 4); v += __shfl_xor(v, 8); if ((lane & 15) == 0) ys[t * 64 + p] = v; }
    }
    float gv[4];
#pragma unroll
    for (int t = 0; t < 4; ++t) {
        const float yv = ys[t * 64 + lane] + F.in[24][hh] * xs[t * 64 + lane];
        const float z = bf1(Z[(m0 + t) * N1P + C1_Z + hh * 64 + lane]);
        gv[t] = yv * silu(z);
        const float q = wave_sum(gv[t] * gv[t]);
        if (lane == 0) LDSP(float, LS_SSQ)[w * 4 + t] = q;
    }
    __syncthreads();
#pragma unroll
    for (int t = 0; t < 4; ++t) {
        float tot = 0.f;
#pragma unroll
        for (int k = 0; k < 8; ++k) tot += LDSP(float, LS_SSQ)[k * 4 + t];
        const float rstd = rsqrtf(tot * (1.f / 512.f) + EPS);
        Y[(m0 + t) * DM + 1024 + hh * 64 + lane] = (bf16)f2bf(gv[t] * rstd * F.in[25][hh * 64 + lane]);
    }
    __syncthreads();
}

__device__ __forceinline__ void p6c_sample_mlp(Frame& F, int b) {
    const bf16* Z = WSP(bf16, WS_Z); bf16* Y = WSP(bf16, WS_Y);
    const int lane = F.lane, col = 16 * lane, g = lane >> 3; const size_t m0 = MS0 + 4 * b;
    const float* lng = F.in[16]; const float* lnb = F.in[17]; const float* ws = F.in[18] + (size_t)g * 16384; const float* bs = F.in[19] + g * 128;
    float vn[4][16];
#pragma unroll
    for (int t = 0; t < 4; ++t) {
        const bf16* vp = Z + (m0 + t) * N1P + C1_V + col;
        float* f = vn[t]; { const v4u a = *(const v4u*)vp, c = *(const v4u*)(vp + 8); UNPACK8(a, f); float* f2 = f + 8; UNPACK8(c, f2); }
        float s = 0.f;
#pragma unroll
        for (int i = 0; i < 16; ++i) s += f[i];
        const float mean = wave_sum(s) * (1.f / 1024.f); float q = 0.f;
#pragma unroll
        for (int i = 0; i < 16; ++i) { const float d = f[i] - mean; q += d * d; }
        const float rstd = rsqrtf(wave_sum(q) * (1.f / 1024.f) + EPS);
#pragma unroll
        for (int i = 0; i < 16; ++i) f[i] = (f[i] - mean) * rstd * lng[col + i] + lnb[col + i];
        float* o = F.out + O_SCV + ((size_t)b * 4 + t) * 1024 + col;
#pragma unroll
        for (int i = 0; i < 4; ++i) *(f32x4*)(o + 4 * i) = (f32x4){f[4 * i], f[4 * i + 1], f[4 * i + 2], f[4 * i + 3]};
    }
#pragma unroll
    for (int t = 0; t < 4; ++t) {
        const bf16* zr = Z + (m0 + t) * N1P;
        float uu[16], cgv[16];
        { const v4u a = *(const v4u*)(zr + C1_U + col), c = *(const v4u*)(zr + C1_U + col + 8); UNPACK8(a, uu); float* u2 = uu + 8; UNPACK8(c, u2); }
        { const v4u a = *(const v4u*)(zr + C1_CG + col), c = *(const v4u*)(zr + C1_CG + col + 8); UNPACK8(a, cgv); float* c2 = cgv + 8; UNPACK8(c, c2); }
        float y[16];
#pragma unroll
        for (int i = 0; i < 16; ++i) {
            float mix = bs[t];
#pragma unroll
            for (int s = 0; s < 4; ++s) if (s <= t) mix += ws[t * 128 + s] * vn[s][i];
            y[i] = uu[i] * mix * silu(cgv[i]);
        }
        *(v4u*)(Y + (m0 + t) * DM + col) = pack8(y); *(v4u*)(Y + (m0 + t) * DM + col + 8) = pack8(y + 8);
    }
}

#ifndef USE_CG_SYNC
#define USE_CG_SYNC 0
#endif
__global__ void __launch_bounds__(NTHR, 2) hybrid_fwd(Args args) {
    extern __shared__ __attribute__((aligned(16))) unsigned char lds[];
    cg::grid_group grid = cg::this_grid();
    Frame F;
    F.lds = (LAS unsigned char*)lds;
    F.tid = threadIdx.x; F.lane = F.tid & 63; F.wave = __builtin_amdgcn_readfirstlane(F.tid >> 6);
    F.G = gridDim.x; F.bid = blockIdx.x;
#pragma unroll
    for (int i = 0; i < 28; ++i) F.in[i] = args.in[i];
    F.out = args.out; F.ws = args.ws;
    for (int u = F.tid; u < (LDS_BYTES - LDS_CTL_OFF) / 4; u += NTHR) ((LAS unsigned*)(F.lds + LDS_CTL_OFF))[u] = 0u;
    __syncthreads();
    XcdBarrier bar = xcd_barrier_post((unsigned*)(F.ws + WS_CTL) + CW_BAR, (volatile LAS unsigned*)(F.lds + LDS_CTL_OFF) + 8);
    const int lo = args.ph_lo, hi = args.ph_hi;
#ifndef PHASE_MASK
#define PHASE_MASK 0x7ff
#endif
#define IN(k) (((PHASE_MASK >> (k)) & 1) && lo <= (k) && (k) < hi)
#define SEAM(k) do { if (IN(k) && IN((k) + 1)) { if (USE_CG_SYNC || (k) == 0) grid.sync(); else xcd_barrier(bar); } } while (0)

    if (IN(0)) { p0_prologue(F); }
    SEAM(0);
    if (IN(1)) {
        pg8::Gemm g{WSP(bf16, WS_H), WSP(bf16, WS_WT0), MROWS, N0, DM}; pg8::StaticOrder S; S.init(MROWS, N0, F.G, F.bid);
        pg8::EpiStore E{WSP(bf16, WS_Z), N0, nullptr, -1};
        pg8::gemm_phase<pg8::EpiStore, pg8::StaticOrder, true, true>(F.lds, g, S, E);
    }
    SEAM(1);
    if (IN(2)) { p2_mixers0(F); }
    SEAM(2);
    if (IN(3)) {
        pg8::Gemm g{WSP(bf16, WS_Y), WSP(bf16, WS_WO0), MROWS, DM, DM}; pg8::StaticOrder S; S.init(MROWS, DM, F.G, F.bid);
        pg8::EpiStore E{WSP(bf16, WS_Z), DM, nullptr, -1};
        pg8::gemm_phase<pg8::EpiStore, pg8::StaticOrder, true, true>(F.lds, g, S, E);
    }
    SEAM(3);
    if (IN(4)) { row_pass(F, true, F.in[13], F.in[14], WSP(bf16, WS_H)); }
    SEAM(4);
    if (IN(5)) {
        pg8::Gemm g{WSP(bf16, WS_H), WSP(bf16, WS_WT1), MROWS, N1P, DM}; pg8::StaticOrder S; S.init(MROWS, N1P, F.G, F.bid);
        pg8::EpiStore E{WSP(bf16, WS_Z), N1P, WSP(float, WS_DTR), C1_DT / 256};
        pg8::gemm_phase<pg8::EpiStore, pg8::StaticOrder, true, true>(F.lds, g, S, E);
    }
    SEAM(5);
    if (IN(6)) { for (int u = F.bid; u < 256; u += F.G) p6a_unit(F, u >> 2, (u >> 1) & 1, u & 1); }
    SEAM(6);
    if (IN(7)) { p6b_scan(F); }
    SEAM(7);
    if (IN(8)) {
        for (int u = F.bid; u < 256; u += F.G) p6c_ssd_unit(F, u >> 2, (u >> 1) & 1, u & 1);
        for (int u = F.bid; u < 512; u += F.G) p6c_mlp_unit(F, u >> 3, u & 7);
        for (int u = F.bid; u < 256; u += F.G) p6c_sample_unit(F, u >> 1, u & 1);
        for (int u = F.wave * F.G + F.bid; u < 128; u += NWAVES * F.G) p6c_sample_mlp(F, u);
        if (F.bid == F.G - 1) { const bf16* Z = WSP(bf16, WS_Z);
            for (int i = F.tid; i < 3 * 1536; i += NTHR) { const int r = i / 1536, ch = i % 1536; F.out[O_PCD + i] = bf1(Z[(size_t)(SEQ - 3 + r) * N1P + C1_X + ch]); } }
    }
    SEAM(8);
    if (IN(9)) {
        pg8::Gemm g{WSP(bf16, WS_Y), WSP(bf16, WS_WO1), MROWS, DM, DM}; pg8::StaticOrder S; S.init(MROWS, DM, F.G, F.bid);
        pg8::EpiStore E{WSP(bf16, WS_Z), DM, nullptr, -1};
        pg8::gemm_phase<pg8::EpiStore, pg8::StaticOrder, true, true>(F.lds, g, S, E);
    }
    SEAM(9);
    if (IN(10)) { row_pass(F, false, F.in[27], nullptr, nullptr); }
#undef IN
#undef SEAM
}

#ifndef N_LAUNCHES
#define N_LAUNCHES 1
#endif
extern "C" void kernel_launch(void* const* d_in, const int* in_sizes, int n_in, void* d_out, int out_size, void* d_ws, size_t ws_size, hipStream_t stream) {
    static int grid = 0;
    if (grid == 0) {
        int dev = 0, cus = 0, per_cu = 0;
        if (n_in != 28 || (size_t)out_size != O_END || ws_size < WS_END) { fprintf(stderr, "kernel_launch: unexpected shapes n_in %d out %d ws %zu\n", n_in, out_size, ws_size); grid = -1; return; }
        (void)hipGetDevice(&dev); (void)hipDeviceGetAttribute(&cus, hipDeviceAttributeMultiprocessorCount, dev);
        (void)hipFuncSetAttribute((const void*)hybrid_fwd, hipFuncAttributeMaxDynamicSharedMemorySize, LDS_BYTES);
        (void)hipOccupancyMaxActiveBlocksPerMultiprocessor(&per_cu, (const void*)hybrid_fwd, NTHR, LDS_BYTES);
        (void)hipGetLastError();
        if (per_cu < 1) { fprintf(stderr, "kernel_launch: occupancy query says %d blocks per CU\n", per_cu); grid = -1; return; }
        grid = cus;
    }
    if (grid < 0) return;
    (void)hipMemsetAsync((char*)d_ws + WS_CTL, 0, CTL_ZERO_BYTES, stream);
    Args a{};
    for (int i = 0; i < 28; ++i) a.in[i] = (const float*)d_in[i];
    a.out = (float*)d_out; a.ws = (unsigned char*)d_ws;
    if (N_LAUNCHES == 1) {
        a.ph_lo = 0; a.ph_hi = 11;
        void* params[] = {&a};
        hipError_t e = hipLaunchCooperativeKernel((const void*)hybrid_fwd, dim3(grid), dim3(NTHR), params, LDS_BYTES, stream);
        if (e != hipSuccess) fprintf(stderr, "cooperative launch failed: %s (grid %d)\n", hipGetErrorString(e), grid);
    } else {
        for (int p = 0; p < 11; ++p) { a.ph_lo = p; a.ph_hi = p + 1; hipLaunchKernelGGL(hybrid_fwd, dim3(grid), dim3(NTHR), LDS_BYTES, stream, a); }
    }
}
```

```cpp
#include <hip/hip_runtime.h>
#include <hip/hip_cooperative_groups.h>
#include <cstdio>
#include <cstdint>
namespace cg = cooperative_groups;

namespace pg8 {
#define PG8_LAS __attribute__((address_space(3)))
typedef unsigned short bf16_t;
typedef short bf16x8 __attribute__((ext_vector_type(8)));
typedef float f32x4 __attribute__((ext_vector_type(4)));
typedef unsigned u32x4 __attribute__((ext_vector_type(4)));
constexpr int BM = 256, BK = 64, HALF = 128, HTB = HALF * BK * 2  , STAGE_BYTES = 8 * HTB, NXCD = 8, WGM = 4;

__host__ __device__ __forceinline__ int lds_byte(int r, int c) { const int st = (r >> 4) * 2 + (c >> 5), rr = r & 15, cc = c & 31, ob = rr * 64 + cc * 2; return st * 1024 + (ob ^ (((ob >> 9) & 1) << 5)); }
__host__ __device__ __forceinline__ void stage_rc(int b, int& R, int& C) { const int st = b / 1024, sb = b % 1024, swz = sb ^ (((sb >> 9) & 1) << 5); R = (st >> 1) * 16 + swz / 64; C = (st & 1) * 32 + (swz % 64) / 2; }
__host__ __device__ __forceinline__ int perm32(int rho) { const int n = rho >> 4, i = rho & 15; return 8 * (i >> 2) + 4 * n + (i & 3); }

struct Unit { int pm, pn; };
struct Gemm { const bf16_t* A; const bf16_t* Bt; int M, N, K; int ld = 0; };

struct StaticOrder {
    int nM, nN, nwg, G, c;
    __host__ __device__ __forceinline__ void init(int M, int N, int G_, int c_) { nM = M / BM; nN = N / BM; nwg = nM * nN; G = G_; c = c_; }
    __host__ __device__ __forceinline__ bool next(int i, Unit& u) const {
        const long L = (long)i * G + c; if (L >= nwg) return false;
        int wgid = (int)L; { const int q = nwg / NXCD, r = nwg % NXCD, xcd = wgid % NXCD, off = wgid / NXCD; wgid = (xcd < r ? xcd * (q + 1) : r * (q + 1) + (xcd - r) * q) + off; }
        const int nig = WGM * nN, gid = wgid / nig, fm = gid * WGM, gsz = (nM - fm) < WGM ? (nM - fm) : WGM;
        u.pm = fm + ((wgid % nig) % gsz); u.pn = (wgid % nig) / gsz; return true;
    }
    __device__ __forceinline__ void a_ready(const Unit&) const {}
    __device__ __forceinline__ void done(const Unit&) const {}
};

__device__ __forceinline__ unsigned cvt_pk_bf16(float lo, float hi) { unsigned r; asm volatile("v_cvt_pk_bf16_f32 %0, %1, %2" : "=v"(r) : "v"(lo), "v"(hi)); return r; }
struct EpiStore {
    static constexpr bool PERM = true, AFTER_DRAIN = false;
    bf16_t* O; int ldc; float* dt_out; int dt_tile;
    __device__ __forceinline__ void operator()(const f32x4 (&acc)[2][2][4][2], const Unit& u, int wr, int wc, int fr, int fq) const {
        const int row0 = u.pm * BM + wr * 64 + fr; const int col0 = u.pn * BM + wc * 32 + 8 * fq;
#pragma unroll
        for (int ai = 0; ai < 2; ++ai)
#pragma unroll
            for (int m = 0; m < 4; ++m) { bf16_t* rowp = O + (size_t)(row0 + ai * HALF + m * 16) * ldc + col0;
#pragma unroll
                for (int bj = 0; bj < 2; ++bj) { const f32x4 v0 = acc[ai][bj][m][0], v1 = acc[ai][bj][m][1];
                    u32x4 w; w.x = cvt_pk_bf16(v0[0], v0[1]); w.y = cvt_pk_bf16(v0[2], v0[3]); w.z = cvt_pk_bf16(v1[0], v1[1]); w.w = cvt_pk_bf16(v1[2], v1[3]);
                    *(u32x4*)(rowp + bj * HALF) = w; } }
        if (dt_out != nullptr && u.pn == dt_tile && wc == 0 && fq < 2) {
#pragma unroll
            for (int ai = 0; ai < 2; ++ai)
#pragma unroll
                for (int m = 0; m < 4; ++m) { float* p = dt_out + (size_t)(row0 + ai * HALF + m * 16) * 16 + 8 * fq;
                    *(f32x4*)(p) = acc[ai][0][m][0]; *(f32x4*)(p + 4) = acc[ai][0][m][1]; }
        }
    }
};
__device__ __forceinline__ float silu_f(float x) { return x * __builtin_amdgcn_rcpf(1.f + __expf(-x)); }
struct EpiL0 {
    static constexpr bool PERM = true, AFTER_DRAIN = false;
    bf16_t* O; int ldc;
    __device__ __forceinline__ void operator()(const f32x4 (&acc)[2][2][4][2], const Unit& u, int wr, int wc, int fr, int fq) const {
        const int row0 = u.pm * BM + wr * 64 + fr;
        if (u.pn >= 16) {
            const int col0 = u.pn * BM + wc * 32 + 8 * fq;
#pragma unroll
            for (int ai = 0; ai < 2; ++ai)
#pragma unroll
                for (int m = 0; m < 4; ++m) { bf16_t* rowp = O + (size_t)(row0 + ai * HALF + m * 16) * ldc + col0;
#pragma unroll
                    for (int bj = 0; bj < 2; ++bj) { const f32x4 v0 = acc[ai][bj][m][0], v1 = acc[ai][bj][m][1];
                        u32x4 w; w.x = cvt_pk_bf16(v0[0], v0[1]); w.y = cvt_pk_bf16(v0[2], v0[3]); w.z = cvt_pk_bf16(v1[0], v1[1]); w.w = cvt_pk_bf16(v1[2], v1[3]);
                        *(u32x4*)(rowp + bj * HALF) = w; } }
        } else {
            const int col = ((wc >> 1) ? 1024 : 0) + u.pn * 64 + (wc & 1) * 32 + 8 * fq;
#pragma unroll
            for (int ai = 0; ai < 2; ++ai)
#pragma unroll
                for (int m = 0; m < 4; ++m) {
                    f32x4 r0, r1;
                    if (wc < 2) { r0 = acc[ai][0][m][0] * acc[ai][1][m][0]; r1 = acc[ai][0][m][1] * acc[ai][1][m][1]; }
                    else {
#pragma unroll
                        for (int i = 0; i < 4; ++i) { r0[i] = acc[ai][0][m][0][i] * silu_f(acc[ai][1][m][0][i]); r1[i] = acc[ai][0][m][1][i] * silu_f(acc[ai][1][m][1][i]); } }
                    u32x4 w; w.x = cvt_pk_bf16(r0[0], r0[1]); w.y = cvt_pk_bf16(r0[2], r0[3]); w.z = cvt_pk_bf16(r1[0], r1[1]); w.w = cvt_pk_bf16(r1[2], r1[3]);
                    *(u32x4*)(O + (size_t)(row0 + ai * HALF + m * 16) * ldc + col) = w; }
        }
    }
};
struct EpiL1 {
    static constexpr bool PERM = true, AFTER_DRAIN = false;
    bf16_t* O; int ldc; const float* rs;
    __device__ __forceinline__ void operator()(const f32x4 (&acc_)[2][2][4][2], const Unit& u, int wr, int wc, int fr, int fq) const {
        const int row0 = u.pm * BM + wr * 64 + fr;
        f32x4 acc[2][2][4][2];
#pragma unroll
        for (int ai = 0; ai < 2; ++ai)
#pragma unroll
            for (int m = 0; m < 4; ++m) { const float r = rs[row0 + ai * HALF + m * 16];
#pragma unroll
                for (int bj = 0; bj < 2; ++bj)
#pragma unroll
                    for (int n = 0; n < 2; ++n) acc[ai][bj][m][n] = acc_[ai][bj][m][n] * r; }
        if (u.pn >= 8) {
            const int col0 = (u.pn < 12 ? 1024 + (u.pn - 8) * BM : u.pn * BM) + wc * 32 + 8 * fq;
#pragma unroll
            for (int ai = 0; ai < 2; ++ai)
#pragma unroll
                for (int m = 0; m < 4; ++m) { bf16_t* rowp = O + (size_t)(row0 + ai * HALF + m * 16) * ldc + col0;
#pragma unroll
                    for (int bj = 0; bj < 2; ++bj) { const f32x4 v0 = acc[ai][bj][m][0], v1 = acc[ai][bj][m][1];
                        u32x4 w; w.x = cvt_pk_bf16(v0[0], v0[1]); w.y = cvt_pk_bf16(v0[2], v0[3]); w.z = cvt_pk_bf16(v1[0], v1[1]); w.w = cvt_pk_bf16(v1[2], v1[3]);
                        *(u32x4*)(rowp + bj * HALF) = w; } }
        } else {
            const int col = u.pn * 128 + wc * 32 + 8 * fq;
#pragma unroll
            for (int ai = 0; ai < 2; ++ai)
#pragma unroll
                for (int m = 0; m < 4; ++m) {
                    f32x4 r0, r1;
#pragma unroll
                    for (int i = 0; i < 4; ++i) { r0[i] = acc[ai][0][m][0][i] * silu_f(acc[ai][1][m][0][i]); r1[i] = acc[ai][0][m][1][i] * silu_f(acc[ai][1][m][1][i]); }
                    u32x4 w; w.x = cvt_pk_bf16(r0[0], r0[1]); w.y = cvt_pk_bf16(r0[2], r0[3]); w.z = cvt_pk_bf16(r1[0], r1[1]); w.w = cvt_pk_bf16(r1[2], r1[3]);
                    *(u32x4*)(O + (size_t)(row0 + ai * HALF + m * 16) * ldc + col) = w; }
        }
    }
};
struct EpiF32 {
    static constexpr bool PERM = true, AFTER_DRAIN = false;
    float* P; int ldc;
    __device__ __forceinline__ void operator()(const f32x4 (&acc)[2][2][4][2], const Unit& u, int wr, int wc, int fr, int fq) const {
        const int row0 = u.pm * BM + wr * 64 + fr; const int col0 = u.pn * BM + wc * 32 + 8 * fq;
#pragma unroll
        for (int ai = 0; ai < 2; ++ai)
#pragma unroll
            for (int m = 0; m < 4; ++m) { float* rowp = P + (size_t)(row0 + ai * HALF + m * 16) * ldc + col0;
#pragma unroll
                for (int bj = 0; bj < 2; ++bj) { *(f32x4*)(rowp + bj * HALF) = acc[ai][bj][m][0]; *(f32x4*)(rowp + bj * HALF + 4) = acc[ai][bj][m][1]; } }
    }
};

template <class Epi, class Sched, bool ALIGN_EPI = false, bool SP2 = false>
__device__ __forceinline__ void gemm_phase(PG8_LAS unsigned char* lds, const Gemm g, const Sched& S, const Epi& E) {
    const int tid = threadIdx.x, wid = __builtin_amdgcn_readfirstlane(tid >> 6), lane = tid & 63, wr = wid >> 2, wc = wid & 3, fr = lane & 15, fq = lane >> 4;
    const int K = g.ld ? g.ld : g.K, nt = g.K / BK;
    unsigned voffA[2], voffB[2];
#pragma unroll
    for (int i = 0; i < 2; ++i) { int R, C; stage_rc(tid * 16 + i * 8192, R, C); const int Rb = Epi::PERM ? ((R & ~31) + perm32(R & 31)) : R;
        voffA[i] = (unsigned)(R * K + C) * 2u; voffB[i] = (unsigned)(Rb * K + C) * 2u; }
    const size_t kstep = (size_t)(BK * 2);
    const size_t hstep = (size_t)HALF * K * 2;
    const size_t tstep = 2 * hstep;
    const unsigned ldsw = (unsigned)wid * 1024u;
    const int aoff = lds_byte(wr * 64 + fr, fq * 8), boff = lds_byte(wc * 32 + fr, fq * 8);
#define PG8_SA(b, h) (((b) * 2 + (h)) * HTB)
#define PG8_SB(b, h) ((4 + (b) * 2 + (h)) * HTB)
#define PG8_STAGE(bufoff, gbase, voff) do { _Pragma("unroll") for (int _i = 0; _i < 2; ++_i) \
        __builtin_amdgcn_global_load_lds((const unsigned*)((const char*)(gbase) + (voff)[_i]), (PG8_LAS unsigned*)(lds + (bufoff) + ldsw + _i * 8192), 16, 0, 0); } while (0)
#define PG8_LDA(dst, b, h) do { _Pragma("unroll") for (int m = 0; m < 4; ++m) _Pragma("unroll") for (int k = 0; k < 2; ++k) dst[m][k] = *(const PG8_LAS bf16x8*)(lds + PG8_SA(b, h) + aoff + m * 2048 + k * 1024); } while (0)
#define PG8_LDB(dst, b, h) do { _Pragma("unroll") for (int n = 0; n < 2; ++n) _Pragma("unroll") for (int k = 0; k < 2; ++k) dst[n][k] = *(const PG8_LAS bf16x8*)(lds + PG8_SB(b, h) + boff + n * 2048 + k * 1024); } while (0)
#define PG8_MMA(ai, bj, At, Bt) do { __builtin_amdgcn_s_setprio(1); _Pragma("unroll") for (int m = 0; m < 4; ++m) _Pragma("unroll") for (int n = 0; n < 2; ++n) _Pragma("unroll") for (int k = 0; k < 2; ++k) \
        acc[ai][bj][m][n] = __builtin_amdgcn_mfma_f32_16x16x32_bf16(Bt[n][k], At[m][k], acc[ai][bj][m][n], 0, 0, 0); __builtin_amdgcn_s_setprio(0); } while (0)
#define PG8_WAIT_V(n) asm volatile("s_waitcnt vmcnt(" #n ")" ::: "memory")
#define PG8_WAIT_L(n) asm volatile("s_waitcnt lgkmcnt(" #n ")" ::: "memory")
#define PG8_BAR __builtin_amdgcn_s_barrier()
#define PG8_SCHED __builtin_amdgcn_sched_barrier(0)
    Unit cur, nxt; int ui = 0;
    if (!S.next(0, cur)) return;
    f32x4 acc[2][2][4][2];
#pragma unroll
    for (int a = 0; a < 2; ++a)
#pragma unroll
        for (int b = 0; b < 2; ++b)
#pragma unroll
            for (int m = 0; m < 4; ++m)
#pragma unroll
                for (int n = 0; n < 2; ++n) acc[a][b][m][n] = (f32x4){0.f, 0.f, 0.f, 0.f};
    bf16x8 At[4][2], B0[2][2], B1[2][2];
    const char* cA = (const char*)g.A + (size_t)cur.pm * tstep; const char* cB = (const char*)g.Bt + (size_t)cur.pn * tstep;
    S.a_ready(cur);
    if constexpr (SP2) {
        PG8_STAGE(PG8_SB(0, 0), cB, voffB); PG8_STAGE(PG8_SB(0, 1), cB + hstep, voffB); PG8_STAGE(PG8_SA(0, 0), cA, voffA); PG8_STAGE(PG8_SA(0, 1), cA + hstep, voffA);
        if (wr == 1) PG8_BAR;
        PG8_WAIT_V(2); PG8_BAR;
        PG8_STAGE(PG8_SB(1, 0), cB + kstep, voffB); PG8_STAGE(PG8_SA(1, 0), cA + kstep, voffA); PG8_STAGE(PG8_SB(1, 1), cB + hstep + kstep, voffB);
        PG8_WAIT_V(6); PG8_BAR;
    } else {
        PG8_STAGE(PG8_SB(0, 0), cB, voffB); PG8_STAGE(PG8_SA(0, 0), cA, voffA); PG8_STAGE(PG8_SB(0, 1), cB + hstep, voffB); PG8_STAGE(PG8_SA(0, 1), cA + hstep, voffA);
        if (wr == 1) PG8_BAR;
        PG8_WAIT_V(4); PG8_BAR;
        PG8_STAGE(PG8_SB(1, 0), cB + kstep, voffB); PG8_STAGE(PG8_SA(1, 0), cA + kstep, voffA); PG8_STAGE(PG8_SB(1, 1), cB + hstep + kstep, voffB);
        PG8_WAIT_V(6); PG8_BAR;
    }
    for (;;) {
        const bool has_next = S.next(ui + 1, nxt);
        const char* nA = has_next ? (const char*)g.A + (size_t)nxt.pm * tstep : cA; const char* nB = has_next ? (const char*)g.Bt + (size_t)nxt.pn * tstep : cB;
        for (int t = 0; t < nt; t += 2) {
            const bool last = (t == nt - 2);
            const char* a1 = cA + (size_t)(t + 1) * kstep;
            const char* a2 = last ? nA : cA + (size_t)(t + 2) * kstep; const char* b2 = last ? nB : cB + (size_t)(t + 2) * kstep;
            const char* a3 = a2 + kstep; const char* b3 = b2 + kstep;
            if (last && has_next) S.a_ready(nxt);
            if constexpr (SP2) {
            PG8_LDB(B0, 0, 0); PG8_LDB(B1, 0, 1); PG8_SCHED; PG8_LDA(At, 0, 0); PG8_STAGE(PG8_SA(1, 1), a1 + hstep, voffA);
            PG8_WAIT_V(8); PG8_WAIT_L(0); PG8_BAR; PG8_MMA(0, 0, At, B0); PG8_MMA(0, 1, At, B1); PG8_BAR; PG8_SCHED;
            PG8_LDA(At, 0, 1); PG8_STAGE(PG8_SB(0, 0), b2, voffB); PG8_STAGE(PG8_SB(0, 1), b2 + hstep, voffB); PG8_STAGE(PG8_SA(0, 0), a2, voffA);
            PG8_WAIT_V(8); PG8_WAIT_L(0); PG8_BAR; PG8_MMA(1, 0, At, B0); PG8_MMA(1, 1, At, B1); PG8_BAR; PG8_SCHED;
            PG8_LDB(B0, 1, 0); PG8_LDB(B1, 1, 1); PG8_SCHED; PG8_LDA(At, 1, 0); PG8_STAGE(PG8_SA(0, 1), a2 + hstep, voffA);
            PG8_WAIT_V(8); PG8_WAIT_L(0); PG8_BAR; PG8_MMA(0, 0, At, B0); PG8_MMA(0, 1, At, B1); PG8_BAR; PG8_SCHED;
            PG8_LDA(At, 1, 1); PG8_STAGE(PG8_SB(1, 0), b3, voffB); PG8_STAGE(PG8_SB(1, 1), b3 + hstep, voffB); PG8_STAGE(PG8_SA(1, 0), a3, voffA);
            PG8_WAIT_V(8); PG8_WAIT_L(0); PG8_BAR; PG8_MMA(1, 0, At, B0); PG8_MMA(1, 1, At, B1); PG8_BAR; PG8_SCHED;
            } else {
            PG8_LDB(B0, 0, 0); PG8_SCHED; PG8_LDA(At, 0, 0); PG8_STAGE(PG8_SA(1, 1), a1 + hstep, voffA);
            PG8_WAIT_L(8); PG8_BAR; PG8_WAIT_L(0); PG8_MMA(0, 0, At, B0); PG8_BAR; PG8_SCHED;
            PG8_LDB(B1, 0, 1); PG8_STAGE(PG8_SB(0, 0), b2, voffB);
            PG8_BAR; PG8_WAIT_L(0); PG8_MMA(0, 1, At, B1); PG8_BAR;
            PG8_LDA(At, 0, 1); PG8_STAGE(PG8_SA(0, 0), a2, voffA);
            PG8_BAR; PG8_WAIT_L(0); PG8_MMA(1, 0, At, B0); PG8_BAR; PG8_SCHED;
            PG8_STAGE(PG8_SB(0, 1), b2 + hstep, voffB);
            PG8_WAIT_V(6); PG8_BAR; PG8_MMA(1, 1, At, B1); PG8_BAR;
            PG8_LDB(B0, 1, 0); PG8_SCHED; PG8_LDA(At, 1, 0); PG8_STAGE(PG8_SA(0, 1), a2 + hstep, voffA);
            PG8_WAIT_L(8); PG8_BAR; PG8_WAIT_L(0); PG8_MMA(0, 0, At, B0); PG8_BAR; PG8_SCHED;
            PG8_LDB(B1, 1, 1); PG8_STAGE(PG8_SB(1, 0), b3, voffB);
            PG8_BAR; PG8_WAIT_L(0); PG8_MMA(0, 1, At, B1); PG8_BAR;
            PG8_LDA(At, 1, 1); PG8_STAGE(PG8_SA(1, 0), a3, voffA);
            PG8_BAR; PG8_WAIT_L(0); PG8_MMA(1, 0, At, B0); PG8_BAR; PG8_SCHED;
            PG8_STAGE(PG8_SB(1, 1), b3 + hstep, voffB);
            PG8_WAIT_V(6); PG8_BAR; PG8_MMA(1, 1, At, B1); PG8_BAR;
            }
        }
        if constexpr (ALIGN_EPI) { if (wr == 0) PG8_BAR; }
        if constexpr (!Epi::AFTER_DRAIN) { E(acc, cur, wr, wc, fr, fq); S.done(cur); }
        if (!has_next) break;
#pragma unroll
        for (int a = 0; a < 2; ++a)
#pragma unroll
            for (int b = 0; b < 2; ++b)
#pragma unroll
                for (int m = 0; m < 4; ++m)
#pragma unroll
                    for (int n = 0; n < 2; ++n) acc[a][b][m][n] = (f32x4){0.f, 0.f, 0.f, 0.f};
        cur = nxt; cA = nA; cB = nB; ++ui;
        if constexpr (ALIGN_EPI) { if (wr == 1) PG8_BAR; }
    }
    PG8_WAIT_V(0);
    if constexpr (!ALIGN_EPI) { if (wr == 0) PG8_BAR; }
    PG8_BAR;
    if constexpr (Epi::AFTER_DRAIN) { E.fused(acc, cur, wr, wc, fr, fq, lds, wid, lane); S.done(cur); }
#undef PG8_SA
#undef PG8_SB
#undef PG8_STAGE
#undef PG8_LDA
#undef PG8_LDB
#undef PG8_MMA
#undef PG8_WAIT_V
#undef PG8_WAIT_L
#undef PG8_BAR
#undef PG8_SCHED
}
}

#define GAS __attribute__((address_space(1)))
#define LAS __attribute__((address_space(3)))
typedef unsigned short bf16;
typedef unsigned v4u __attribute__((ext_vector_type(4)));
typedef unsigned v2u __attribute__((ext_vector_type(2)));
typedef float f32x4 __attribute__((ext_vector_type(4)));
typedef float f32x16 __attribute__((ext_vector_type(16)));
typedef short bf16x8 __attribute__((ext_vector_type(8)));
typedef short s16x4 __attribute__((ext_vector_type(4)));

constexpr int NWAVES = 8, NTHR = 512;
constexpr int DM = 2048, SEQ = 8192, NB = 128, NT = 4, MROWS = 8704, MS0 = 8192;
constexpr int N0 = 6656, N1 = 5648, N1P = 5632;
constexpr int W0_AB = 0, W0_AC = 1024, W0_AH = 2048, W0_AG = 3072;
constexpr int C0_S = 0, C0_T = 1024, C0_Q = 4096, C0_K = 5120, C0_V = 5376, C0_G = 5632;
constexpr int W1_U = 0, W1_V = 1024, W1_CG = 2048;
constexpr int C1_UC = 0, C1_V = 1024, C1_Z = 3072, C1_X = 4096, C1_B = 5120, C1_C = 5376, C1_DT = 5632;
constexpr float EPS = 1e-6f, LOG2E = 1.4426950408889634f, QSCALE = 0.125f * 1.4426950408889634f, NEGBIG = -1e30f;
constexpr size_t O_YP = 0, O_YS = O_YP + 8192ull * 2048, O_PCA = O_YS + 512ull * 2048, O_SCA = O_PCA + 2048, O_PWK = O_SCA + 128ull * 2048,
                 O_PWV = O_PWK + 128ull * 256, O_SWK = O_PWV + 128ull * 256, O_SWV = O_SWK + 128ull * 128 * 256, O_SCV = O_SWV + 128ull * 128 * 256,
                 O_PCD = O_SCV + 128ull * 4 * 1024, O_SCD = O_PCD + 3 * 1536, O_PSSM = O_SCD + 128ull * 3 * 1536, O_SSSM = O_PSSM + 131072, O_END = O_SSSM + 128ull * 131072;
static_assert(O_END == 44571136ull, "output size");
constexpr size_t MiB = 1u << 20;
constexpr size_t WS_CTL = 0, CTL_ZERO_BYTES = 1 * MiB;
constexpr size_t WS_WT0 = 1 * MiB;
constexpr size_t WS_HB = WS_WT0;
constexpr size_t WS_WO0 = WS_WT0 + (size_t)N0 * DM * 2;
constexpr size_t WS_WT1 = WS_WO0 + (size_t)DM * DM * 2;
constexpr size_t WS_WO1 = WS_WT1 + (size_t)N1P * DM * 2;
constexpr size_t WS_TRIL = WS_WO1 + (size_t)DM * DM * 2;
constexpr size_t WS_H = WS_TRIL + 8 * 128 * 128 * 2;
constexpr size_t WS_Z = WS_H + (size_t)MROWS * DM * 2;
constexpr size_t WS_Y = WS_Z + (size_t)MROWS * N0 * 2;
constexpr size_t WS_CS = WS_Y;
constexpr size_t WS_XA = WS_Y + (size_t)MROWS * DM * 2;
constexpr size_t WS_DTR = WS_XA + (size_t)SEQ * 1536 * 2;
constexpr size_t WS_ACS = WS_DTR + (size_t)MROWS * 16 * 4;
constexpr size_t WS_DTV = WS_ACS + (size_t)SEQ * 16 * 4;
constexpr size_t WS_CD = WS_DTV + (size_t)SEQ * 16 * 4;
constexpr size_t WS_VST = WS_CD + 64 * 16 * 4;
constexpr size_t WS_RS1 = WS_VST + (size_t)SEQ * 2 * 4;
constexpr size_t WS_PT = WS_RS1 + (size_t)MROWS * 4 + 192;
constexpr int TSPLIT = 2;
constexpr size_t WS_END = WS_PT + (size_t)TSPLIT * 512 * 2048 * 4;
static_assert(WS_END <= 290ull * MiB, "workspace map");
static_assert((size_t)64 * 16 * 64 * 128 * 4 <= (size_t)MROWS * DM * 2, "CS fits in Y");
constexpr int CW_BAR = 4096, CW_FILL = 8192, CW_TAIL0 = 8256, CW_TAIL1 = 8320, CW_PANEL0 = 8448, CW_PANEL1 = CW_PANEL0 + 64 * 32;
constexpr int LDS_BYTES = 147456, LDS_CTL_OFF = 147200;

#define RLX_AGENT __ATOMIC_RELAXED, __HIP_MEMORY_SCOPE_AGENT
__device__ __forceinline__ unsigned f2bf(float f) { unsigned u = __builtin_bit_cast(unsigned, f); return (u + 0x7fffu + ((u >> 16) & 1u)) >> 16; }
typedef float f32x2_t __attribute__((ext_vector_type(2))); typedef __bf16 bf16x2_t __attribute__((ext_vector_type(2)));
__device__ __forceinline__ unsigned pk2(float lo, float hi) { f32x2_t v = {lo, hi}; bf16x2_t b = __builtin_convertvector(v, bf16x2_t); return __builtin_bit_cast(unsigned, b); }
__device__ __forceinline__ float bflo(unsigned w) { return __uint_as_float(w << 16); }
__device__ __forceinline__ float bfhi(unsigned w) { return __uint_as_float(w & 0xffff0000u); }
__device__ __forceinline__ float bf1(bf16 b) { return __uint_as_float((unsigned)b << 16); }
#define UNPACK8(v, f) do { f[0] = bflo(v.x); f[1] = bfhi(v.x); f[2] = bflo(v.y); f[3] = bfhi(v.y); f[4] = bflo(v.z); f[5] = bfhi(v.z); f[6] = bflo(v.w); f[7] = bfhi(v.w); } while (0)
__device__ __forceinline__ v4u pack8(const float* f) { v4u o; o.x = pk2(f[0], f[1]); o.y = pk2(f[2], f[3]); o.z = pk2(f[4], f[5]); o.w = pk2(f[6], f[7]); return o; }
__device__ __forceinline__ float silu(float x) { return x * __builtin_amdgcn_rcpf(1.f + __expf(-x)); }
#define DPPF(v, ctrl) __builtin_bit_cast(float, __builtin_amdgcn_update_dpp(0, __builtin_bit_cast(int, (v)), (ctrl), 0xf, 0xf, true))
__device__ __forceinline__ float row16_sum(float v) { v += DPPF(v, 0xB1); v += DPPF(v, 0x4E); v += DPPF(v, 0x141); v += DPPF(v, 0x140); return v; }
__device__ __forceinline__ float row16_max(float v) { v = fmaxf(v, DPPF(v, 0xB1)); v = fmaxf(v, DPPF(v, 0x4E)); v = fmaxf(v, DPPF(v, 0x141)); v = fmaxf(v, DPPF(v, 0x140)); return v; }
__device__ __forceinline__ float wave_sum(float v) { v = row16_sum(v); v += __shfl_xor(v, 16); v += __shfl_xor(v, 32); return v; }
__device__ __forceinline__ float wave_max(float v) { v = row16_max(v); v = fmaxf(v, __shfl_xor(v, 16)); v = fmaxf(v, __shfl_xor(v, 32)); return v; }
__device__ __forceinline__ int crow(int r, int hi) { return (r & 3) + 8 * (r >> 2) + 4 * hi; }
#define MFMA32(a, b, c) __builtin_amdgcn_mfma_f32_32x32x16_bf16((a), (b), (c), 0, 0, 0)
__device__ __forceinline__ bf16x8 pack_frag(const f32x16& x, int s) {
    v4u p; p.x = pk2(x[8 * s + 0], x[8 * s + 1]); p.y = pk2(x[8 * s + 2], x[8 * s + 3]); p.z = pk2(x[8 * s + 4], x[8 * s + 5]); p.w = pk2(x[8 * s + 6], x[8 * s + 7]);
    return __builtin_bit_cast(bf16x8, p);
}
__device__ __forceinline__ bf16x8 frag_from_f32(const float* p) {
    const f32x4 a = *(const f32x4*)p, b = *(const f32x4*)(p + 4);
    v4u o; o.x = pk2(a[0], a[1]); o.y = pk2(a[2], a[3]); o.z = pk2(b[0], b[1]); o.w = pk2(b[2], b[3]);
    return __builtin_bit_cast(bf16x8, o);
}

typedef short v4i16_t __attribute__((ext_vector_type(4)));
__device__ __forceinline__ bf16x8 tr_frag(const LAS unsigned char* base, int pitch, int row0, int col0, int rstep, int lane) {
    const int h = lane >> 5, q = (lane & 15) >> 2, pp = lane & 3, cg = (lane >> 4) & 1;
    const LAS unsigned char* p = base + (row0 + 4 * h + q) * pitch + (col0 + 16 * cg + 4 * pp) * 2;
    const s16x4 a = __builtin_bit_cast(s16x4, __builtin_amdgcn_ds_read_tr16_b64_v4i16((LAS v4i16_t*)p));
    const s16x4 b = __builtin_bit_cast(s16x4, __builtin_amdgcn_ds_read_tr16_b64_v4i16((LAS v4i16_t*)(p + rstep * pitch)));
    return (bf16x8){a[0], a[1], a[2], a[3], b[0], b[1], b[2], b[3]};
}
__device__ __forceinline__ bf16x8 tr_frag_nat(const LAS unsigned char* base, int pitch, int row0, int col0, int lane) {
    return tr_frag(base, pitch, row0 + 4 * (lane >> 5), col0, 4, lane);
}

#define XB_TMO      128
#define XB_XCNT(j)  (256  + 64 * (j))
#define XB_XSUB(j)  (1280 + 64 * (j))
#define XB_XGEN(j)  (2304 + 64 * (j))
#define XB_TOP      3328
#define XB_TOPGEN   3392
#define XCD_BAR_WORDS 3456
#define XB_SPIN_CAP (1u << 18)
__device__ __forceinline__ unsigned xb_ld(unsigned* p)              { return __hip_atomic_load(p, __ATOMIC_RELAXED, __HIP_MEMORY_SCOPE_AGENT); }
__device__ __forceinline__ unsigned xb_add(unsigned* p, unsigned v) { return __hip_atomic_fetch_add(p, v, __ATOMIC_RELAXED, __HIP_MEMORY_SCOPE_AGENT); }
__device__ __forceinline__ unsigned xb_xcc_id() { return (unsigned)__builtin_amdgcn_s_getreg((3 << 11) | 20) & 0xFu; }
#define XB_SPIN(cond, bar) do { unsigned _sp = 0; while (cond) { __builtin_amdgcn_s_sleep(1); \
    if ((++_sp & 255u) == 0u) { if (xb_ld(&(bar)[XB_TMO])) break; if (_sp > XB_SPIN_CAP) { atomicAdd(&(bar)[XB_TMO], 1u); break; } } } } while (0)
struct XcdBarrier { unsigned* bar; unsigned x; volatile LAS unsigned* st; };
__device__ __forceinline__ XcdBarrier xcd_barrier_post(unsigned* bar, volatile LAS unsigned* st) {
    XcdBarrier b; b.bar = bar; b.x = xb_xcc_id(); b.st = st;
    if (threadIdx.x == 0) (void)xb_add(&bar[XB_XCNT(b.x)], 1u);
    return b;
}
__device__ __forceinline__ void xcd_barrier_complete(unsigned* bar, unsigned x, unsigned& nloc, unsigned& nx) {
    const unsigned G = gridDim.x * gridDim.y * gridDim.z;
    unsigned sum, cnt, mine, sp = 0u;
    for (;;) {
        sum = 0u; cnt = 0u; mine = 0u;
#pragma unroll
        for (unsigned j = 0; j < 16; ++j) { const unsigned c = xb_ld(&bar[XB_XCNT(j)]); sum += c; cnt += (c > 0u) ? 1u : 0u; mine = (j == x) ? c : mine; }
        if (sum == G) break;
        __builtin_amdgcn_s_sleep(1);
        if ((++sp & 255u) == 0u) { if (xb_ld(&bar[XB_TMO])) break; if (sp > XB_SPIN_CAP) { atomicAdd(&bar[XB_TMO], 1u); break; } }
    }
    nloc = mine > 0u ? mine : 1u; nx = cnt > 0u ? cnt : 1u;
}
__device__ __forceinline__ void xcd_barrier(const XcdBarrier& b) {
    asm volatile("s_waitcnt vmcnt(0)" ::: "memory");
    __syncthreads();
    if (threadIdx.x == 0) {
        unsigned* bar = b.bar;
        __builtin_amdgcn_s_waitcnt(0);
        unsigned nloc = b.st[0], nx = b.st[1];
        if (nloc == 0u) { xcd_barrier_complete(bar, b.x, nloc, nx); b.st[0] = nloc; b.st[1] = nx; }
        const unsigned old = xb_add(&bar[XB_XSUB(b.x)], 1u);
        const unsigned gen = old / nloc;
        if (old + 1u == (gen + 1u) * nloc) {
            __builtin_amdgcn_fence(__ATOMIC_RELEASE, "agent");
            asm volatile("s_waitcnt vmcnt(0)" ::: "memory");
            const unsigned og = xb_add(&bar[XB_TOP], 1u);
            const unsigned tg = og / nx;
            if (og + 1u == (tg + 1u) * nx) xb_add(&bar[XB_TOPGEN], 1u);
            else XB_SPIN(xb_ld(&bar[XB_TOPGEN]) == tg, bar);
            __builtin_amdgcn_fence(__ATOMIC_ACQUIRE, "agent");
            xb_add(&bar[XB_XGEN(b.x)], 1u);
            asm volatile("s_waitcnt vmcnt(0)" ::: "memory");
        } else {
            XB_SPIN(xb_ld(&bar[XB_XGEN(b.x)]) == gen, bar);
            __builtin_amdgcn_fence(__ATOMIC_ACQUIRE, "agent");
            asm volatile("s_waitcnt vmcnt(0)" ::: "memory");
        }
    }
    __syncthreads();
}

__device__ __forceinline__ void group_arrive(unsigned* ctr) {
    asm volatile("s_waitcnt vmcnt(0)" ::: "memory");
    __syncthreads();
    if (threadIdx.x == 0) { __builtin_amdgcn_fence(__ATOMIC_RELEASE, "agent"); asm volatile("s_waitcnt vmcnt(0)" ::: "memory"); (void)xb_add(ctr, 1u); }
}
__device__ __forceinline__ void group_wait(unsigned* ctr, unsigned want) {
    if (threadIdx.x == 0) { unsigned sp = 0; while (xb_ld(ctr) < want) { __builtin_amdgcn_s_sleep(2); if (++sp > (1u << 22)) break; }
        __builtin_amdgcn_fence(__ATOMIC_ACQUIRE, "agent"); asm volatile("s_waitcnt vmcnt(0)" ::: "memory"); }
    __syncthreads();
}

#ifdef DELAY_REG
#define REG_BEGIN(id) unsigned long long t0_##id = 0; if ((id) == DELAY_REG && blockIdx.x == DELAY_WG && threadIdx.x == 0) t0_##id = __builtin_amdgcn_s_memrealtime();
#define REG_END(id) if ((id) == DELAY_REG && blockIdx.x == DELAY_WG && threadIdx.x == 0) { const unsigned long long t1_ = __builtin_amdgcn_s_memrealtime(), d_ = t1_ - t0_##id; while (__builtin_amdgcn_s_memrealtime() < t1_ + d_) __builtin_amdgcn_s_sleep(8); }
#else
#define REG_BEGIN(id)
#define REG_END(id)
#endif
struct Args { const float* in[28]; float* out; unsigned char* ws; int ph_lo, ph_hi; };

struct Frame {
    LAS unsigned char* lds;
    int tid, lane, wave, G, bid;
    const float* in[28];
    float* out; unsigned char* ws;
};
#define WSP(T, off) ((T*)(F.ws + (off)))
#define LDSP(T, off) ((LAS T*)(F.lds + (off)))

__device__ __forceinline__ void tile64_load(const float* W, int N, int k0, int n0, int lane, f32x4 (&v)[16]) {
    const int kr = lane >> 4, nc = 4 * (lane & 15);
#pragma unroll
    for (int i = 0; i < 16; ++i) v[i] = __builtin_nontemporal_load((const f32x4*)(W + (size_t)(k0 + 4 * i + kr) * N + n0 + nc));
}
__device__ __forceinline__ void tile64_finish(const f32x4 (&v)[16], bf16* WT, LAS float* scr, int k0, int n0, int d0, int lane, int sc_lo, int sc_hi, float sc, const float* kg = nullptr) {
    const int kr = lane >> 4, nc = 4 * (lane & 15);
#pragma unroll
    for (int i = 0; i < 16; ++i) *(LAS f32x4*)(scr + (4 * i + kr) * 68 + nc) = v[i];
    asm volatile("s_waitcnt lgkmcnt(0)" ::: "memory");
    const int n = n0 + lane; const float mul = (n >= sc_lo && n < sc_hi) ? sc : 1.f;
#pragma unroll
    for (int c = 0; c < 8; ++c) { float f[8];
#pragma unroll
        for (int i = 0; i < 8; ++i) f[i] = scr[(8 * c + i) * 68 + lane] * mul;
        if (kg != nullptr) { const f32x4 g0 = *(const f32x4*)(kg + k0 + 8 * c), g1 = *(const f32x4*)(kg + k0 + 8 * c + 4);
#pragma unroll
            for (int i = 0; i < 4; ++i) { f[i] *= g0[i]; f[4 + i] *= g1[i]; } }
        *(v4u*)(WT + (size_t)(d0 + lane) * DM + k0 + 8 * c) = pack8(f); }
    asm volatile("s_waitcnt lgkmcnt(0)" ::: "memory");
}
__device__ __forceinline__ void transpose_tile64(const float* W, int N, bf16* WT, LAS float* scr, int k0, int n0, int d0, int lane, int sc_lo, int sc_hi, float sc, const float* kg = nullptr) {
    f32x4 v[16]; tile64_load(W, N, k0, n0, lane, v); tile64_finish(v, WT, scr, k0, n0, d0, lane, sc_lo, sc_hi, sc, kg);
}
__device__ __forceinline__ void rms_row_load(const float* xrow, int lane, f32x4 (&v)[8]) {
#pragma unroll
    for (int j = 0; j < 4; ++j) { v[2 * j] = __builtin_nontemporal_load((const f32x4*)(xrow + 512 * j + 8 * lane)); v[2 * j + 1] = __builtin_nontemporal_load((const f32x4*)(xrow + 512 * j + 8 * lane + 4)); }
}
__device__ __forceinline__ void rms_row_finish(const f32x4 (&v)[8], const float* g, bf16* orow, int lane) {
    float s = 0.f;
#pragma unroll
    for (int j = 0; j < 8; ++j) s += (v[j][0] * v[j][0] + v[j][1] * v[j][1]) + (v[j][2] * v[j][2] + v[j][3] * v[j][3]);
    const float rstd = rsqrtf(wave_sum(s) * (1.f / DM) + EPS);
#pragma unroll
    for (int j = 0; j < 4; ++j) { const f32x4 g0 = *(const f32x4*)(g + 512 * j + 8 * lane), g1 = *(const f32x4*)(g + 512 * j + 8 * lane + 4);
        const f32x4 a = v[2 * j] * rstd * g0, b = v[2 * j + 1] * rstd * g1;
        v4u o; o.x = pk2(a[0], a[1]); o.y = pk2(a[2], a[3]); o.z = pk2(b[0], b[1]); o.w = pk2(b[2], b[3]);
        *(v4u*)(orow + 512 * j + 8 * lane) = o; }
}
__device__ __forceinline__ const float* xrow_ptr(const Frame& F, int m) { return m < MS0 ? F.in[0] + (size_t)m * DM : F.in[1] + (size_t)(m - MS0) * DM; }

__device__ __forceinline__ void w0_tile_coords(int it, int& k0, int& src, int& dst) {
    const int db = it % (N0 / 64), j = db >> 2, q = db & 3;
    k0 = 64 * (it / (N0 / 64)); dst = 64 * db; src = db < 64 ? (q == 0 ? W0_AC : q == 1 ? W0_AB : q == 2 ? W0_AH : W0_AG) + 64 * j : 64 * db;
}
__device__ __forceinline__ void p0_prologue(Frame& F) {
    LAS float* scr = LDSP(float, F.wave * 17408);
    const int gw = F.bid * NWAVES + F.wave, NGW = F.G * NWAVES, lane = F.lane;
    constexpr int NTILE = 32 * (N0 / 64);
    f32x4 tv[16], rv[8];
    int it = gw, r = NGW - 1 - gw, k0 = 0, src = 0, dst = 0;
    if (it < NTILE) { w0_tile_coords(it, k0, src, dst); tile64_load(F.in[9], N0, k0, src, lane, tv); }
    if (r < MROWS) rms_row_load(xrow_ptr(F, r), lane, rv);
    while (it < NTILE) {
        f32x4 cur[16];
#pragma unroll
        for (int i = 0; i < 16; ++i) cur[i] = tv[i];
        const int ck0 = k0, csrc = src, cdst = dst;
        it += NGW;
        if (it < NTILE) { w0_tile_coords(it, k0, src, dst); tile64_load(F.in[9], N0, k0, src, lane, tv); }
        tile64_finish(cur, WSP(bf16, WS_WT0), scr, ck0, csrc, cdst, lane, C0_Q, C0_K, QSCALE);
    }
    while (r < MROWS) {
        f32x4 cur[8];
#pragma unroll
        for (int i = 0; i < 8; ++i) cur[i] = rv[i];
        const int cr = r; r += NGW;
        if (r < MROWS) rms_row_load(xrow_ptr(F, r), lane, rv);
        rms_row_finish(cur, F.in[8], WSP(bf16, WS_H) + (size_t)cr * DM, lane);
    }
    for (int i = F.bid * NTHR + F.tid; i < 8 * 128 * 128; i += F.G * NTHR) { const int t = (i >> 7) & 127, s = i & 127; WSP(bf16, WS_TRIL)[i] = (bf16)f2bf(s <= t ? F.in[18][i] : 0.f); }
}
constexpr int FI_WO0 = 0, FI_WT1 = FI_WO0 + 32 * 32 / 8, FI_WO1 = FI_WT1 + 32 * (N1P / 64) / 8, FI_CACHE = FI_WO1 + 32 * 32 / 8, FI_TRIL = FI_CACHE + 256, FI_END = FI_TRIL;
__device__ __forceinline__ void filler_item(Frame& F, int idx) {
    LAS float* scr = LDSP(float, F.wave * 17408);
    if (idx < FI_WT1) { const int t = (idx - FI_WO0) * 8 + F.wave; transpose_tile64(F.in[12], DM, WSP(bf16, WS_WO0), scr, 64 * (t / 32), 64 * (t % 32), 64 * (t % 32), F.lane, 0, 0, 1.f); }
    else if (idx < FI_WO1) { const int t = (idx - FI_WT1) * 8 + F.wave; const int db = t % (N1P / 64);
        const int src = db < 32 ? ((db & 2) ? W1_CG : W1_U) + 128 * (db >> 2) + 64 * (db & 1) : db < 48 ? W1_V + 64 * (db - 32) : 64 * db;
        transpose_tile64(F.in[15], N1, WSP(bf16, WS_WT1), scr, 64 * (t / (N1P / 64)), src, 64 * db, F.lane, 0, 0, 1.f, F.in[14]); }
    else if (idx < FI_CACHE) { const int t = (idx - FI_WO1) * 8 + F.wave; transpose_tile64(F.in[26], DM, WSP(bf16, WS_WO1), scr, 64 * (t / 32), 64 * (t % 32), 64 * (t % 32), F.lane, 0, 0, 1.f); }
    else if (idx < FI_TRIL) {
        const int c = idx - FI_CACHE, b = c >> 1; const f32x4* src = (const f32x4*)((c & 1) ? F.in[4] : F.in[3]) + (size_t)b * 128 * 64 + 4 * 64; f32x4* dst = (f32x4*)(F.out + ((c & 1) ? O_SWV : O_SWK)) + (size_t)b * 128 * 64;
#pragma unroll 4
        for (int i = F.tid; i < 124 * 64; i += NTHR) __builtin_nontemporal_store(__builtin_nontemporal_load(src + i), dst + i);
    }
}
__device__ __forceinline__ void filler_loop(Frame& F) {
    volatile LAS int* flag = (volatile LAS int*)(F.lds + LDS_CTL_OFF + 192);
    for (;;) {
        if (F.tid == 0) *flag = (int)__hip_atomic_fetch_add((unsigned*)(F.ws + WS_CTL) + CW_FILL, 1u, __ATOMIC_RELAXED, __HIP_MEMORY_SCOPE_AGENT);
        __syncthreads();
        const int idx = *flag;
        __syncthreads();
#ifdef PROBE_FILL2
        if (idx >= 2 * FI_END) break;
        filler_item(F, idx >= FI_END ? idx - FI_END : idx);
#else
        if (idx >= FI_END) break;
        filler_item(F, idx);
#endif
    }
}

__device__ __forceinline__ int rel_bucket(int d) {
    if (d < 16) return d;
    const int large = 16 + (int)(logf((float)d * (1.f / 16.f)) / logf(8.f) * 16.f);
    return large < 31 ? large : 31;
}
constexpr int L2_BIAS = 0;
constexpr int L2_K = 8192;
constexpr int L2_VT = L2_K + 256 * 144;
constexpr int L2_SK = 8192;
constexpr int L2_SVT = L2_SK + 2 * 160 * 144;
static_assert(L2_VT + 256 * 144 <= LDS_CTL_OFF && L2_SVT + 2 * 160 * 144 <= LDS_CTL_OFF, "P2 LDS");

__device__ __forceinline__ void attn_core(Frame& F, const bf16x8 (&qf)[4], int k_off, int v_off, int kt0, const LAS float* biasd, float sink2, bool first_block,
                                          f32x16& o0, f32x16& o1, float& inv) {
    const int lane = F.lane, l31 = lane & 31, hl = lane >> 5;
    f32x16 S[5];
#pragma unroll
    for (int k5 = 0; k5 < 5; ++k5) {
        f32x16 acc = {};
        const LAS unsigned char* kp = F.lds + k_off + (32 * (kt0 + k5) + l31) * 144 + 16 * hl;
#pragma unroll
        for (int ks = 0; ks < 4; ++ks) { const bf16x8 a = *(const LAS bf16x8*)(kp + 32 * ks); acc = MFMA32(a, qf[ks], acc); }
        S[k5] = acc;
    }
    float mx = NEGBIG;
#pragma unroll
    for (int k5 = 0; k5 < 5; ++k5)
#pragma unroll
        for (int r = 0; r < 16; ++r) {
            const int cr = crow(r, hl), dist = 128 - 32 * k5 + l31 - cr, j = 32 * (kt0 + k5) + cr;
            const bool valid = (dist >= 0) && (dist < 128) && (!first_block || j >= 128);
            const float b = biasd[dist & 127];
            const float s = valid ? S[k5][r] + b : NEGBIG;
            S[k5][r] = s; mx = fmaxf(mx, s);
        }
    mx = fmaxf(mx, __shfl_xor(mx, 32));
    mx = fmaxf(mx, sink2);
    float sum = 0.f;
#pragma unroll
    for (int k5 = 0; k5 < 5; ++k5)
#pragma unroll
        for (int r = 0; r < 16; ++r) { const float p = __builtin_amdgcn_exp2f(S[k5][r] - mx); S[k5][r] = p; sum += p; }
    sum += __shfl_xor(sum, 32);
    inv = __builtin_amdgcn_rcpf(sum + __builtin_amdgcn_exp2f(sink2 - mx));
    o0 = (f32x16){}; o1 = (f32x16){};
#pragma unroll
    for (int k5 = 0; k5 < 5; ++k5)
#pragma unroll
        for (int sp = 0; sp < 2; ++sp) {
            const bf16x8 pf = pack_frag(S[k5], sp);
            const int kb = 32 * (kt0 + k5) + 16 * sp;
            const bf16x8 A0 = tr_frag(F.lds + v_off, 144, kb, 0, 8, lane), A1 = tr_frag(F.lds + v_off, 144, kb, 32, 8, lane);
            o0 = MFMA32(A0, pf, o0); o1 = MFMA32(A1, pf, o1);
        }
}
constexpr int L2_EP = 100352;
static_assert(L2_EP + 8 * 4608 <= LDS_CTL_OFF, "P2 epilogue LDS");
__device__ __forceinline__ void attn_store(Frame& F, const f32x16& o0, const f32x16& o1, float inv, const bf16* grow, bf16* yrow, int nrows) {
    const int lane = F.lane, l31 = lane & 31, hl = lane >> 5;
    LAS unsigned char* tile = F.lds + L2_EP + F.wave * 4608;
    const int rr = lane >> 3, ch = lane & 7;
    v4u gv[4];
#pragma unroll
    for (int i = 0; i < 4; ++i) { const int r = 8 * i + rr; gv[i] = (r < nrows) ? *(const v4u*)(grow + (size_t)r * N0 + ch * 8) : (v4u){0u, 0u, 0u, 0u}; }
#pragma unroll
    for (int i = 0; i < 4; ++i) *(LAS v4u*)(tile + (8 * i + rr) * 144 + ch * 16) = gv[i];
#pragma unroll
    for (int dt = 0; dt < 2; ++dt)
#pragma unroll
        for (int q4 = 0; q4 < 4; ++q4) {
            const int d = 32 * dt + 8 * q4 + 4 * hl;
            LAS v2u* p = (LAS v2u*)(tile + l31 * 144 + d * 2);
            const v2u gz = *p;
            const float g0 = bflo(gz.x), g1 = bfhi(gz.x), g2 = bflo(gz.y), g3 = bfhi(gz.y);
            const float a = (dt ? o1[4 * q4 + 0] : o0[4 * q4 + 0]) * inv, b = (dt ? o1[4 * q4 + 1] : o0[4 * q4 + 1]) * inv,
                        c = (dt ? o1[4 * q4 + 2] : o0[4 * q4 + 2]) * inv, e = (dt ? o1[4 * q4 + 3] : o0[4 * q4 + 3]) * inv;
            v2u o; o.x = pk2(a * silu(g0), b * silu(g1)); o.y = pk2(c * silu(g2), e * silu(g3));
            *p = o;
        }
#pragma unroll
    for (int i = 0; i < 4; ++i) { const int r = 8 * i + rr; const v4u yv = *(const LAS v4u*)(tile + r * 144 + ch * 16); if (r < nrows) *(v4u*)(yrow + (size_t)r * DM + ch * 8) = yv; }
}

__device__ __forceinline__ void attn_prompt_unit(Frame& F, int n, int hk) {
    const bf16* Z = WSP(bf16, WS_Z); bf16* Y = WSP(bf16, WS_Y);
    const int tid = F.tid, lane = F.lane, w = F.wave, l31 = lane & 31, hl = lane >> 5;
#pragma unroll
    for (int i = 0; i < 4; ++i) {
        const int item = tid + 512 * i, key = item >> 3, ch = item & 7, pos = 128 * (n - 1) + key;
        v4u kv = (v4u){0u, 0u, 0u, 0u}, vv = (v4u){0u, 0u, 0u, 0u};
        if (pos >= 0) { kv = *(const v4u*)(Z + (size_t)pos * N0 + C0_K + hk * 64 + ch * 8); vv = *(const v4u*)(Z + (size_t)pos * N0 + C0_V + hk * 64 + ch * 8); }
        *(LAS v4u*)(F.lds + L2_K + key * 144 + ch * 16) = kv;
        *(LAS v4u*)(F.lds + L2_VT + key * 144 + ch * 16) = vv;
    }
    __syncthreads();
    const int g = w >> 1, head = hk * 4 + g;
    const float sink2 = F.in[11][head] * LOG2E;
    const LAS float* biasd = LDSP(float, L2_BIAS) + head * 128;
    for (int qq = 0; qq < 2; ++qq) {
        const int qt = 2 * (w & 1) + qq;
        const int pos_q = 128 * n + 32 * qt + l31;
        const bf16* qrow = Z + (size_t)pos_q * N0 + C0_Q + head * 64 + 8 * hl;
        bf16x8 qf[4];
#pragma unroll
        for (int ks = 0; ks < 4; ++ks) qf[ks] = *(const bf16x8*)(qrow + 16 * ks);
        f32x16 o0, o1; float inv;
        attn_core(F, qf, L2_K, L2_VT, qt, biasd, sink2, n == 0, o0, o1, inv);
        attn_store(F, o0, o1, inv, Z + (size_t)(pos_q - l31) * N0 + C0_G + head * 64, Y + (size_t)(pos_q - l31) * DM + 1024 + head * 64, 32);
    }
    __syncthreads();
}

__device__ __forceinline__ void attn_sample_unit(Frame& F, int b, int hp) {
    const bf16* Z = WSP(bf16, WS_Z); bf16* Y = WSP(bf16, WS_Y);
    const int tid = F.tid, lane = F.lane, w = F.wave, l31 = lane & 31, hl = lane >> 5;
    const float* ck = F.in[3]; const float* cv = F.in[4];
    const int h2 = w >> 2, head = (2 * hp + h2) * 4 + (w & 3);
    const size_t m = MS0 + 4 * b + (l31 & 3);
    bf16x8 qf[4];
    { const bf16* qrow = Z + m * N0 + C0_Q + head * 64 + 8 * hl;
#pragma unroll
      for (int ks = 0; ks < 4; ++ks) qf[ks] = *(const bf16x8*)(qrow + 16 * ks); }
    f32x4 kf[4][2], vf[4][2]; v4u kz = (v4u){0u, 0u, 0u, 0u}, vz = (v4u){0u, 0u, 0u, 0u};
#pragma unroll
    for (int u = 0; u < 4; ++u) { const int item = tid + NTHR * u, hh2 = item >> 10, r = item & 1023, key = r >> 3, ch = r & 7;
        const size_t off = ((size_t)(b * 128 + key) * 4 + 2 * hp + hh2) * 64 + ch * 8;
        kf[u][0] = __builtin_nontemporal_load((const f32x4*)(ck + off)); kf[u][1] = __builtin_nontemporal_load((const f32x4*)(ck + off + 4)); vf[u][0] = __builtin_nontemporal_load((const f32x4*)(cv + off)); vf[u][1] = __builtin_nontemporal_load((const f32x4*)(cv + off + 4)); }
    if (tid < 64) { const int hh2 = tid >> 5, r = tid & 31, key = 128 + (r >> 3), ch = r & 7;
        const bf16* zr = Z + (size_t)(MS0 + 4 * b + (key - 128)) * N0 + (2 * hp + hh2) * 64 + ch * 8; kz = *(const v4u*)(zr + C0_K); vz = *(const v4u*)(zr + C0_V); }
#pragma unroll
    for (int u = 0; u < 4; ++u) { const int item = tid + NTHR * u, hh2 = item >> 10, r = item & 1023, key = r >> 3, ch = r & 7;
        v4u kv, vv;
        kv.x = pk2(kf[u][0][0], kf[u][0][1]); kv.y = pk2(kf[u][0][2], kf[u][0][3]); kv.z = pk2(kf[u][1][0], kf[u][1][1]); kv.w = pk2(kf[u][1][2], kf[u][1][3]);
        vv.x = pk2(vf[u][0][0], vf[u][0][1]); vv.y = pk2(vf[u][0][2], vf[u][0][3]); vv.z = pk2(vf[u][1][0], vf[u][1][1]); vv.w = pk2(vf[u][1][2], vf[u][1][3]);
        *(LAS v4u*)(F.lds + L2_SK + (hh2 * 160 + key) * 144 + ch * 16) = kv; *(LAS v4u*)(F.lds + L2_SVT + (hh2 * 160 + key) * 144 + ch * 16) = vv; }
    { const int hh2 = tid >> 8, r = tid & 255, key = 128 + (r >> 3), ch = r & 7;
      const bool isnew = key < 132;
      if (!isnew) { *(LAS v4u*)(F.lds + L2_SK + (hh2 * 160 + key) * 144 + ch * 16) = (v4u){0u, 0u, 0u, 0u}; *(LAS v4u*)(F.lds + L2_SVT + (hh2 * 160 + key) * 144 + ch * 16) = (v4u){0u, 0u, 0u, 0u}; } }
    if (tid < 64) { const int hh2 = tid >> 5, r = tid & 31, key = 128 + (r >> 3), ch = r & 7;
        *(LAS v4u*)(F.lds + L2_SK + (hh2 * 160 + key) * 144 + ch * 16) = kz; *(LAS v4u*)(F.lds + L2_SVT + (hh2 * 160 + key) * 144 + ch * 16) = vz; }
    __syncthreads();
    const float sink2 = F.in[11][head] * LOG2E;
    f32x16 o0, o1; float inv;
    attn_core(F, qf, L2_SK + h2 * 160 * 144, L2_SVT + h2 * 160 * 144, 0, LDSP(float, L2_BIAS) + head * 128, sink2, false, o0, o1, inv);
    attn_store(F, o0, o1, inv, Z + (size_t)(MS0 + 4 * b) * N0 + C0_G + head * 64, Y + (size_t)(MS0 + 4 * b) * DM + 1024 + head * 64, 4);
    __syncthreads();
}

__device__ __forceinline__ void p2_mixers0(Frame& F) {
    const bf16* Z = WSP(bf16, WS_Z); bf16* Y = WSP(bf16, WS_Y);
    for (int i = F.tid; i < 16 * 128; i += NTHR) { const int head = i >> 7, d = i & 127; LDSP(float, L2_BIAS)[i] = F.in[7][rel_bucket(d) * 16 + head] * LOG2E; }
    __syncthreads();
    pg8::StaticOrder So; So.init(SEQ, DM, F.G, F.bid); pg8::Unit uo; uo.pm = F.bid >> 3; uo.pn = F.bid & 7; (void)So.next(0, uo);
    attn_prompt_unit(F, 2 * uo.pm + (uo.pn >> 2), uo.pn & 3);
    __syncthreads();
    for (int u = F.bid; u < 256; u += F.G) attn_sample_unit(F, u >> 1, u & 1);
    const size_t gtid = (size_t)F.bid * NTHR + F.tid, gsz = (size_t)F.G * NTHR;
    const float* cw = F.in[10]; const float* sca = F.in[2];
#pragma unroll 1
    for (int kk = 0; kk < 3; ++kk) {
        if (kk == 2 && F.tid >= 64) break;
        const int it = (kk < 2) ? uo.pn * 1024 + F.tid + 512 * kk : F.bid * 64 + F.tid;
        const int m0 = (kk < 2) ? 256 * uo.pm + (it >> 7) * 4 : MS0 + (it >> 7) * 4, c0 = (it & 127) * 8;
        const bool samp = m0 >= MS0; const int b = (m0 - MS0) >> 2;
        const bf16* zr = Z + (size_t)m0 * N0;
        v4u vs[6], vt[4];
#pragma unroll
        for (int r = 0; r < 6; ++r) { const int mm = m0 - 2 + r;
            if (r >= 2 || (!samp && mm >= 0)) vs[r] = *(const v4u*)(Z + (size_t)mm * N0 + C0_S + c0); else vs[r] = (v4u){0u, 0u, 0u, 0u}; }
#pragma unroll
        for (int r = 0; r < 4; ++r) vt[r] = *(const v4u*)(zr + (size_t)r * N0 + C0_T + c0);
        float s[6][8];
#pragma unroll
        for (int r = 0; r < 6; ++r) { float* p = s[r]; UNPACK8(vs[r], p); }
        if (samp) {
#pragma unroll
            for (int i = 0; i < 8; ++i) { s[0][i] = sca[(size_t)(b * 2 + 0) * 1024 + c0 + i]; s[1][i] = sca[(size_t)(b * 2 + 1) * 1024 + c0 + i]; } }
        float w0[8], w1[8], w2[8];
#pragma unroll
        for (int i = 0; i < 8; ++i) { w0[i] = cw[c0 + i]; w1[i] = cw[1024 + c0 + i]; w2[i] = cw[2048 + c0 + i]; }
#pragma unroll
        for (int r = 0; r < 4; ++r) { float tg[8], y[8]; UNPACK8(vt[r], tg);
#pragma unroll
            for (int i = 0; i < 8; ++i) y[i] = tg[i] * (w0[i] * s[r][i] + w1[i] * s[r + 1][i] + w2[i] * s[r + 2][i]);
            *(v4u*)(Y + (size_t)(m0 + r) * DM + c0) = pack8(y); }
        if (!samp && m0 == SEQ - 4) {
#pragma unroll
            for (int i = 0; i < 8; ++i) { F.out[O_PCA + c0 + i] = s[4][i]; F.out[O_PCA + 1024 + c0 + i] = s[5][i]; } }
        if (samp) {
#pragma unroll
            for (int i = 0; i < 8; ++i) { F.out[O_SCA + (size_t)(b * 2) * 1024 + c0 + i] = s[4][i]; F.out[O_SCA + (size_t)(b * 2 + 1) * 1024 + c0 + i] = s[5][i]; } }
    }
    for (size_t it = gtid; it < 128ull * 32; it += gsz) {
        const int j = (int)(it >> 5), c0 = (int)(it & 31) * 8; const bf16* zr = Z + (size_t)(SEQ - 128 + j) * N0;
        float f[8]; { const v4u a = *(const v4u*)(zr + C0_K + c0); UNPACK8(a, f); }
#pragma unroll
        for (int i = 0; i < 8; ++i) F.out[O_PWK + (size_t)j * 256 + c0 + i] = f[i];
        { const v4u a = *(const v4u*)(zr + C0_V + c0); UNPACK8(a, f); }
#pragma unroll
        for (int i = 0; i < 8; ++i) F.out[O_PWV + (size_t)j * 256 + c0 + i] = f[i];
    }
    for (size_t it = gtid; it < 512ull * 32; it += gsz) {
        const int r = (int)(it >> 5), c0 = (int)(it & 31) * 8, b = r >> 2, t = r & 3; const bf16* zr = Z + (size_t)(MS0 + r) * N0;
        float f[8]; { const v4u a = *(const v4u*)(zr + C0_K + c0); UNPACK8(a, f); }
#pragma unroll
        for (int i = 0; i < 8; ++i) F.out[O_SWK + ((size_t)b * 128 + 124 + t) * 256 + c0 + i] = f[i];
        { const v4u a = *(const v4u*)(zr + C0_V + c0); UNPACK8(a, f); }
#pragma unroll
        for (int i = 0; i < 8; ++i) F.out[O_SWV + ((size_t)b * 128 + 124 + t) * 256 + c0 + i] = f[i];
    }
}

__device__ __forceinline__ void row_pass(Frame& F, bool layer0, const float* gpost, const float* gpre, bf16* H, int r0, int r1, int gwA, int ngwA, unsigned* ctrA, unsigned wantA,
                                         int r2, int r3, int gwB, int ngwB, unsigned* ctrB, unsigned wantB) {
    const bf16* Yo = WSP(bf16, WS_Z);
    int lane = F.lane; asm volatile("" : "+v"(lane));
    if (layer0) {
        const float* wdt = F.in[15] + C1_DT;
        f32x4 wv[16];
#pragma unroll
        for (int u = 0; u < 16; ++u) { const int it = F.tid + NTHR * u, k = it >> 2, c4 = it & 3; wv[u] = *(const f32x4*)(wdt + (size_t)k * N1 + 4 * c4); }
#pragma unroll
        for (int u = 0; u < 16; ++u) { const int it = F.tid + NTHR * u, k = it >> 2, c4 = it & 3, j = k >> 9, l = (k >> 3) & 63, i = k & 7;
            *(LAS f32x4*)(F.lds + ((((j * 8 + i) * 4 + c4) * 64 + l) << 4)) = wv[u]; }
        __syncthreads();
    }
#define ROW_LOAD(mm) do { _Pragma("unroll") for (int j = 0; j < 4; ++j) { if (rng == 0) yn[j] = *(const v4u*)(Yo + (size_t)(mm) * DM + 512 * j + 8 * lane); \
        if (layer0) { const float* xin_ = xrow_ptr(F, (mm)); xn[2 * j] = __builtin_nontemporal_load((const f32x4*)(xin_ + 512 * j + 8 * lane)); xn[2 * j + 1] = __builtin_nontemporal_load((const f32x4*)(xin_ + 512 * j + 8 * lane + 4)); } \
        else { xn[j] = __builtin_bit_cast(f32x4, *(const v4u*)(WSP(bf16, WS_H) + (size_t)(mm) * DM + 512 * j + 8 * lane)); } } } while (0)
#pragma unroll 1
    for (int rng = 0; rng < 2; ++rng) {
    const int gw = rng ? gwB : gwA, NGW = rng ? ngwB : ngwA;
    if (rng == 0) { if (ctrA != nullptr) group_wait(ctrA, wantA); } else { r0 = r2; r1 = r3; if (ctrB != nullptr) group_wait(ctrB, wantB); }
    v4u yn[4]; f32x4 xn[8];
    int m = r0 + gw;
    if (m < r1) { ROW_LOAD(m); }
#pragma unroll 1
    for (; m < r1; m += NGW) {
        asm volatile("" ::: "memory");
        float yv[32]; float ss = 0.f; f32x4 xc[8];
#pragma unroll
        for (int j = 0; j < 4; ++j) { float* f = yv + 8 * j;
            if (rng == 0) { UNPACK8(yn[j], f); }
            else { const float* p0 = WSP(float, WS_PT) + (size_t)(m - SEQ) * DM + 512 * j + 8 * lane;
                f32x4 a0 = *(const f32x4*)p0, a1 = *(const f32x4*)(p0 + 4);
#pragma unroll
                for (int q = 1; q < TSPLIT; ++q) { a0 += *(const f32x4*)(p0 + (size_t)q * 512 * DM); a1 += *(const f32x4*)(p0 + (size_t)q * 512 * DM + 4); }
#pragma unroll
                for (int i = 0; i < 4; ++i) { f[i] = a0[i]; f[4 + i] = a1[i]; } }
            if (layer0) { xc[2 * j] = xn[2 * j]; xc[2 * j + 1] = xn[2 * j + 1]; }
            else { const v4u xb = __builtin_bit_cast(v4u, xn[j]); xc[2 * j] = (f32x4){bflo(xb.x), bfhi(xb.x), bflo(xb.y), bfhi(xb.y)}; xc[2 * j + 1] = (f32x4){bflo(xb.z), bfhi(xb.z), bflo(xb.w), bfhi(xb.w)}; }
#pragma unroll
            for (int i = 0; i < 8; ++i) ss += f[i] * f[i]; }
        { const int mn = m + NGW;
          if (mn < r1) { ROW_LOAD(mn); } }
        const float rstd = rsqrtf(wave_sum(ss) * (1.f / DM) + EPS);
        float* xo = F.out + (size_t)m * DM;
        float s1 = 0.f;
#pragma unroll
        for (int j = 0; j < 4; ++j) {
            const int e = 512 * j + 8 * lane;
            f32x4 q0, q1; const f32x4 gp0 = *(const f32x4*)(gpost + e), gp1 = *(const f32x4*)(gpost + e + 4);
#pragma unroll
            for (int i = 0; i < 4; ++i) { q0[i] = xc[2 * j][i] + yv[8 * j + i] * rstd * gp0[i]; q1[i] = xc[2 * j + 1][i] + yv[8 * j + 4 + i] * rstd * gp1[i]; }
            if (layer0) { v4u o; o.x = pk2(q0[0], q0[1]); o.y = pk2(q0[2], q0[3]); o.z = pk2(q1[0], q1[1]); o.w = pk2(q1[2], q1[3]); *(v4u*)(H + (size_t)m * DM + e) = o; }
            else { __builtin_nontemporal_store(q0, (f32x4*)(xo + e)); __builtin_nontemporal_store(q1, (f32x4*)(xo + e + 4)); }
#pragma unroll
            for (int i = 0; i < 4; ++i) { yv[8 * j + i] = q0[i]; yv[8 * j + 4 + i] = q1[i]; s1 += q0[i] * q0[i] + q1[i] * q1[i]; }
        }
        if (layer0) {
            const float rs1 = rsqrtf(wave_sum(s1) * (1.f / DM) + EPS);
            f32x4 dta[4] = {};
#pragma unroll
            for (int j = 0; j < 4; ++j) { const int e = 512 * j + 8 * lane; const f32x4 g0 = *(const f32x4*)(gpre + e), g1 = *(const f32x4*)(gpre + e + 4);
                float f[8];
#pragma unroll
                for (int i = 0; i < 4; ++i) { f[i] = yv[8 * j + i] * rs1 * g0[i]; f[4 + i] = yv[8 * j + 4 + i] * rs1 * g1[i]; }
#pragma unroll
                for (int i = 0; i < 8; ++i) {
#pragma unroll
                    for (int c4 = 0; c4 < 4; ++c4) dta[c4] += f[i] * *(const LAS f32x4*)(F.lds + ((((j * 8 + i) * 4 + c4) * 64 + lane) << 4));
                    if (i & 1) asm volatile("" ::: "memory"); } }
            float mine = 0.f;
#pragma unroll
            for (int c = 0; c < 16; ++c) { const float t = wave_sum(dta[c >> 2][c & 3]); if (lane == c) mine = t; }
            if (lane < 16) WSP(float, WS_DTR)[(size_t)m * 16 + lane] = mine;
            if (lane == 0) WSP(float, WS_RS1)[m] = rs1;
        }
    }
    }
#undef ROW_LOAD
    if (layer0) __syncthreads();
}

__device__ __forceinline__ float softplus_f(float x) { return fmaxf(x, 0.f) + log1pf(__expf(-fabsf(x))); }

__device__ __forceinline__ void conv_act8(const bf16* Z, const float* cw, const float* cb, int row, int ch0, float* act) {
    float a[8];
#pragma unroll
    for (int i = 0; i < 8; ++i) a[i] = cb[ch0 + i];
#pragma unroll
    for (int j = 0; j < 4; ++j) {
        const int r = row - 3 + j;
        if (r >= 0) { const v4u v = *(const v4u*)(Z + (size_t)r * N1P + C1_X + ch0); float f[8]; UNPACK8(v, f);
#pragma unroll
            for (int i = 0; i < 8; ++i) a[i] += cw[j * 1536 + ch0 + i] * f[i]; }
    }
#pragma unroll
    for (int i = 0; i < 8; ++i) act[i] = silu(a[i]);
}

constexpr int LA_BT = 0;
constexpr int LA_XW = 34816;
constexpr int LA_ACS = LA_XW + 73728;
constexpr int LA_DT = LA_ACS + 2048;
constexpr int LA_SC = LA_DT + 2048;
static_assert(LA_SC + 2048 <= LDS_CTL_OFF, "P6a LDS");
__device__ __forceinline__ void p6a_unit(Frame& F, int c, int gi, int hq) {
    const bf16* Z = WSP(bf16, WS_Z); bf16* XA = WSP(bf16, WS_XA);
    const float* cw = F.in[20]; const float* cb = F.in[21];
    const int tid = F.tid, lane = F.lane, w = F.wave, T0 = 128 * c;
    if (w < 4) {
        const int hh = gi * 8 + hq * 4 + w;
        const float a = -__expf(F.in[23][hh]), bias = F.in[22][hh];
        const float d0 = softplus_f(WSP(float, WS_DTR)[(size_t)(T0 + 2 * lane) * 16 + hh] + bias), d1 = softplus_f(WSP(float, WS_DTR)[(size_t)(T0 + 2 * lane + 1) * 16 + hh] + bias);
        const float v0 = d0 * a, v1 = d1 * a;
        float inc = v0 + v1;
#pragma unroll
        for (int o = 1; o < 64; o <<= 1) { const float t = __shfl_up(inc, o); if (lane >= o) inc += t; }
        const float a1 = inc, a0 = inc - v1;
        const float total = __shfl(inc, 63);
        LDSP(float, LA_ACS)[w * 128 + 2 * lane] = a0; LDSP(float, LA_ACS)[w * 128 + 2 * lane + 1] = a1;
        LDSP(float, LA_DT)[w * 128 + 2 * lane] = d0; LDSP(float, LA_DT)[w * 128 + 2 * lane + 1] = d1;
        LDSP(float, LA_SC)[w * 128 + 2 * lane] = __expf(total - a0) * d0; LDSP(float, LA_SC)[w * 128 + 2 * lane + 1] = __expf(total - a1) * d1;
        WSP(float, WS_ACS)[(size_t)(T0 + 2 * lane) * 16 + hh] = a0; WSP(float, WS_ACS)[(size_t)(T0 + 2 * lane + 1) * 16 + hh] = a1;
        WSP(float, WS_DTV)[(size_t)(T0 + 2 * lane) * 16 + hh] = d0; WSP(float, WS_DTV)[(size_t)(T0 + 2 * lane + 1) * 16 + hh] = d1;
        if (lane == 0) WSP(float, WS_CD)[c * 16 + hh] = __expf(total);
    }
    __syncthreads();
#define CONV_ROWS(NR, ROW0, CH0, BODY) do { \
        float wj_[4][8], bj_[8]; v4u raw_[(NR) + 3]; \
        _Pragma("unroll") for (int j_ = 0; j_ < (NR) + 3; ++j_) { const int r_ = T0 + (ROW0) - 3 + j_; raw_[j_] = (r_ >= 0) ? *(const v4u*)(Z + (size_t)r_ * N1P + C1_X + (CH0)) : (v4u){0u, 0u, 0u, 0u}; } \
        _Pragma("unroll") for (int j_ = 0; j_ < 4; ++j_) { const f32x4 a_ = *(const f32x4*)(cw + j_ * 1536 + (CH0)), b_ = *(const f32x4*)(cw + j_ * 1536 + (CH0) + 4); \
            wj_[j_][0] = a_[0]; wj_[j_][1] = a_[1]; wj_[j_][2] = a_[2]; wj_[j_][3] = a_[3]; wj_[j_][4] = b_[0]; wj_[j_][5] = b_[1]; wj_[j_][6] = b_[2]; wj_[j_][7] = b_[3]; } \
        { const f32x4 a_ = *(const f32x4*)(cb + (CH0)), b_ = *(const f32x4*)(cb + (CH0) + 4); bj_[0] = a_[0]; bj_[1] = a_[1]; bj_[2] = a_[2]; bj_[3] = a_[3]; bj_[4] = b_[0]; bj_[5] = b_[1]; bj_[6] = b_[2]; bj_[7] = b_[3]; } \
        float f_[(NR) + 3][8]; \
        _Pragma("unroll") for (int j_ = 0; j_ < (NR) + 3; ++j_) { float* p_ = f_[j_]; UNPACK8(raw_[j_], p_); } \
        _Pragma("unroll") for (int r_ = 0; r_ < (NR); ++r_) { float act[8]; const int s = (ROW0) + r_; \
            _Pragma("unroll") for (int i_ = 0; i_ < 8; ++i_) act[i_] = silu(bj_[i_] + wj_[0][i_] * f_[r_][i_] + wj_[1][i_] * f_[r_ + 1][i_] + wj_[2][i_] * f_[r_ + 2][i_] + wj_[3][i_] * f_[r_ + 3][i_]); \
            BODY } } while (0)
    {
        const int ch8 = tid & 15, rg = tid >> 4, chB = 1024 + gi * 128 + ch8 * 8, chC = 1280 + gi * 128 + ch8 * 8;
        CONV_ROWS(4, 4 * rg, chB, { *(LAS v4u*)(F.lds + LA_BT + s * 272 + ch8 * 16) = pack8(act); if (hq == 0) *(v4u*)(XA + (size_t)(T0 + s) * 1536 + chB) = pack8(act); });
        if (hq == 1) CONV_ROWS(4, 4 * rg, chC, { *(v4u*)(XA + (size_t)(T0 + s) * 1536 + chC) = pack8(act); });
    }
    {
        const int ch = tid & 31, h4 = ch >> 3, p0 = (ch & 7) * 8, chan = (gi * 8 + hq * 4 + h4) * 64 + p0;
#pragma unroll 1
        for (int it = 0; it < 2; ++it) { const int rg = (tid >> 5) + 16 * it;
            CONV_ROWS(4, 4 * rg, chan, { *(v4u*)(XA + (size_t)(T0 + s) * 1536 + chan) = pack8(act); const float scl = LDSP(float, LA_SC)[h4 * 128 + s];
                float sx[8]; _Pragma("unroll") for (int k = 0; k < 8; ++k) sx[k] = act[k] * scl; *(LAS v4u*)(F.lds + LA_XW + (h4 * 128 + s) * 144 + p0 * 2) = pack8(sx); }); }
    }
#undef CONV_ROWS
    __syncthreads();
    {
        const int h4 = w >> 1, nh = w & 1, l31 = lane & 31, hl = lane >> 5, hh = gi * 8 + hq * 4 + h4;
        f32x16 acc[2][2] = {};
#pragma unroll
        for (int ks = 0; ks < 8; ++ks) {
            bf16x8 a[2], b[2];
#pragma unroll
            for (int pt = 0; pt < 2; ++pt) a[pt] = tr_frag_nat(F.lds + LA_XW + h4 * 128 * 144, 144, 16 * ks, 32 * pt, lane);
#pragma unroll
            for (int n2 = 0; n2 < 2; ++n2) b[n2] = tr_frag_nat(F.lds + LA_BT, 272, 16 * ks, 32 * (2 * nh + n2), lane);
#pragma unroll
            for (int pt = 0; pt < 2; ++pt)
#pragma unroll
                for (int n2 = 0; n2 < 2; ++n2) acc[pt][n2] = MFMA32(a[pt], b[n2], acc[pt][n2]);
        }
        float* cs = WSP(float, WS_CS) + ((size_t)(c * 16 + hh) * 64) * 128;
#pragma unroll
        for (int pt = 0; pt < 2; ++pt)
#pragma unroll
            for (int n2 = 0; n2 < 2; ++n2)
#pragma unroll
                for (int r = 0; r < 16; ++r) cs[(size_t)(32 * pt + crow(r, hl)) * 128 + 32 * (2 * nh + n2) + l31] = acc[pt][n2][r];
    }
    {
#pragma unroll
        for (int rr = 0; rr < 4; ++rr) {
            const int row = T0 + 32 * (2 * gi + hq) + 4 * w + rr;
            const bf16* vp = Z + (size_t)row * N1P + C1_V;
            float f[16]; { const v4u a = *(const v4u*)(vp + 8 * lane), b2 = *(const v4u*)(vp + 512 + 8 * lane); UNPACK8(a, f); float* f2 = f + 8; UNPACK8(b2, f2); }
            float s = 0.f;
#pragma unroll
            for (int i = 0; i < 16; ++i) s += f[i];
            const float mean = wave_sum(s) * (1.f / 1024.f);
            float q = 0.f;
#pragma unroll
            for (int i = 0; i < 16; ++i) { const float d = f[i] - mean; q += d * d; }
            const float rstd = rsqrtf(wave_sum(q) * (1.f / 1024.f) + EPS);
            if (lane == 0) { WSP(float, WS_VST)[2 * row] = mean; WSP(float, WS_VST)[2 * row + 1] = rstd; }
        }
    }
    __syncthreads();
}

__device__ __forceinline__ void p6b_scan(Frame& F) {
    const float* cs = WSP(float, WS_CS); const float* cd = WSP(float, WS_CD); bf16* hb = WSP(bf16, WS_HB);
    for (int e = F.bid * NTHR + F.tid; e < 131072; e += F.G * NTHR) {
        const int hh = e >> 13; float st = 0.f;
        float sn[8];
#pragma unroll
        for (int i = 0; i < 8; ++i) sn[i] = cs[(size_t)i * 131072 + e];
#pragma unroll 1
        for (int c0 = 0; c0 < 64; c0 += 8) {
            float s[8];
#pragma unroll
            for (int i = 0; i < 8; ++i) s[i] = sn[i];
            if (c0 + 8 < 64) {
#pragma unroll
                for (int i = 0; i < 8; ++i) sn[i] = cs[(size_t)(c0 + 8 + i) * 131072 + e]; }
#pragma unroll
            for (int i = 0; i < 8; ++i) { hb[(size_t)(c0 + i) * 131072 + e] = (bf16)f2bf(st); st = cd[(c0 + i) * 16 + hh] * st + s[i]; }
        }
        F.out[O_PSSM + e] = st;
    }
}

constexpr int LC_B = 0;
constexpr int LC_C = 34816;
constexpr int LC_X = LC_C + 17408;
constexpr int LC_ACS = LC_X + 65536;
constexpr int LC_DT = LC_ACS + 4096;
constexpr int LC_SSQ = LC_DT + 4096;
static_assert(LC_SSQ + 2048 <= LDS_CTL_OFF, "P6c LDS");
__device__ __forceinline__ void p6c_ssd_unit(Frame& F, int c, int gi, int th) {
    const bf16* Z = WSP(bf16, WS_Z); const bf16* XA = WSP(bf16, WS_XA); bf16* Y = WSP(bf16, WS_Y);
    const int tid = F.tid, lane = F.lane, w = F.wave, T0 = 128 * c, l31 = lane & 31, hl = lane >> 5, h4 = w >> 1;
    const int ns = (th == 0) ? 128 : 96;
#define TILE_OF(t2_) ((th == 0) ? 3 * (t2_) : 1 + (t2_))
    v4u vb[4], vc[2], vx[8]; float ta[2], td[2];
#pragma unroll
    for (int k = 0; k < 4; ++k) { const int item = tid + NTHR * k, s = item >> 4, ch = item & 15; if (s < ns) vb[k] = *(const v4u*)(XA + (size_t)(T0 + s) * 1536 + 1024 + gi * 128 + ch * 8); }
#pragma unroll
    for (int k = 0; k < 2; ++k) { const int item = tid + NTHR * k, r = item >> 4, ch = item & 15, t = 32 * TILE_OF(r >> 5) + (r & 31); vc[k] = *(const v4u*)(XA + (size_t)(T0 + t) * 1536 + 1280 + gi * 128 + ch * 8); }
#pragma unroll
    for (int k = 0; k < 2; ++k) { const int i = tid + NTHR * k, h8 = i >> 7, s = i & 127; ta[k] = WSP(float, WS_ACS)[(size_t)(T0 + s) * 16 + gi * 8 + h8]; td[k] = WSP(float, WS_DTV)[(size_t)(T0 + s) * 16 + gi * 8 + h8]; }
#pragma unroll
    for (int k = 0; k < 8; ++k) { const int item = tid + NTHR * k, s = item >> 5, ch = item & 31; if (s < ns) vx[k] = *(const v4u*)(XA + (size_t)(T0 + s) * 1536 + (gi * 8 + (ch >> 3)) * 64 + (ch & 7) * 8); }
    f32x16 acc[2][2]; v2u zz[2][4];
#define YOFF(ps_) do { const int t2_ = (w & 1) ^ (ps_), hh_ = gi * 8 + 4 * (ps_) + h4, tl_ = 32 * TILE_OF(t2_) + l31; \
        bf16x8 cf_[8]; \
        _Pragma("unroll") for (int ks = 0; ks < 8; ++ks) cf_[ks] = *(const bf16x8*)(XA + (size_t)(T0 + tl_) * 1536 + 1280 + gi * 128 + 16 * ks + 8 * hl); \
        const bf16* hprev_ = WSP(bf16, WS_HB) + ((size_t)(c * 16 + hh_) * 64) * 128; \
        _Pragma("unroll") for (int pt = 0; pt < 2; ++pt) { bf16x8 hf_[8]; acc[ps_][pt] = (f32x16){}; \
            _Pragma("unroll") for (int ks = 0; ks < 8; ++ks) hf_[ks] = *(const bf16x8*)(hprev_ + (size_t)(32 * pt + l31) * 128 + 16 * ks + 8 * hl); \
            _Pragma("unroll") for (int ks = 0; ks < 8; ++ks) acc[ps_][pt] = MFMA32(hf_[ks], cf_[ks], acc[ps_][pt]); } } while (0)
#define ZLOAD(ps_) do { const int t2_ = (w & 1) ^ (ps_), hh_ = gi * 8 + 4 * (ps_) + h4, tl_ = 32 * TILE_OF(t2_) + l31; const bf16* zrow_ = Z + (size_t)(T0 + tl_) * N1P + C1_Z + hh_ * 64; \
        _Pragma("unroll") for (int pt = 0; pt < 2; ++pt) _Pragma("unroll") for (int q4 = 0; q4 < 4; ++q4) zz[pt][q4] = *(const v2u*)(zrow_ + 32 * pt + 8 * q4 + 4 * hl); } while (0)
    YOFF(0);
#pragma unroll
    for (int k = 0; k < 4; ++k) { const int item = tid + NTHR * k, s = item >> 4, ch = item & 15; if (s < ns) *(LAS v4u*)(F.lds + LC_B + s * 272 + ch * 16) = vb[k]; }
#pragma unroll
    for (int k = 0; k < 2; ++k) { const int item = tid + NTHR * k, r = item >> 4, ch = item & 15; *(LAS v4u*)(F.lds + LC_C + r * 272 + ch * 16) = vc[k]; }
#pragma unroll
    for (int k = 0; k < 2; ++k) { const int i = tid + NTHR * k; LDSP(float, LC_ACS)[i] = ta[k]; LDSP(float, LC_DT)[i] = td[k]; }
#pragma unroll
    for (int k = 0; k < 8; ++k) { const int item = tid + NTHR * k, s = item >> 5, ch = item & 31; if (s < ns) *(LAS v4u*)(F.lds + LC_X + ((ch >> 3) * 128 + s) * 128 + (ch & 7) * 16) = vx[k]; }
    asm volatile("" ::: "memory");
    YOFF(1);
    ZLOAD(0);
#pragma unroll
    for (int k = 0; k < 8; ++k) { const int item = tid + NTHR * k, s = item >> 5, ch = item & 31; if (s < ns) vx[k] = *(const v4u*)(XA + (size_t)(T0 + s) * 1536 + (gi * 8 + 4 + (ch >> 3)) * 64 + (ch & 7) * 8); }
    __syncthreads();
    f32x16 G[2][2];
#pragma unroll
    for (int ps = 0; ps < 2; ++ps) {
        const int t2 = (w & 1) ^ ps, hh = gi * 8 + 4 * ps + h4;
        const int tt = TILE_OF(t2), tl = 32 * tt + l31;
        if (ps == 1) {
            __syncthreads();
#pragma unroll
            for (int k = 0; k < 8; ++k) { const int item = tid + NTHR * k, s = item >> 5, ch = item & 31; if (s < ns) *(LAS v4u*)(F.lds + LC_X + ((ch >> 3) * 128 + s) * 128 + (ch & 7) * 16) = vx[k]; }
            __syncthreads();
        }
        const LAS float* acsL = LDSP(float, LC_ACS) + (4 * ps + h4) * 128; const LAS float* dtL = LDSP(float, LC_DT) + (4 * ps + h4) * 128;
        const float acs_t = acsL[tl], dskip = F.in[24][hh];
        { const float ea = __expf(acs_t);
#pragma unroll
          for (int pt = 0; pt < 2; ++pt)
#pragma unroll
              for (int r = 0; r < 16; ++r) acc[ps][pt][r] *= ea; }
        const LAS unsigned char* cfp = F.lds + LC_C + (32 * t2 + l31) * 272 + 16 * hl;
        for (int st = 0; st <= tt; ++st) {
            f32x16 cb = {};
#pragma unroll
            for (int ks = 0; ks < 8; ++ks) { const bf16x8 b = *(const LAS bf16x8*)(F.lds + LC_B + (32 * st + l31) * 272 + 32 * ks + 16 * hl); const bf16x8 cfk = *(const LAS bf16x8*)(cfp + 32 * ks); cb = MFMA32(b, cfk, cb); }
#pragma unroll
            for (int q4 = 0; q4 < 4; ++q4) {
                const int sb = 32 * st + 8 * q4 + 4 * hl;
                const f32x4 as4 = *(const LAS f32x4*)(acsL + sb), dt4 = *(const LAS f32x4*)(dtL + sb);
#pragma unroll
                for (int i = 0; i < 4; ++i) {
                    const int s = sb + i;
                    float wv = cb[4 * q4 + i] * __expf(fminf(acs_t - as4[i], 0.f)) * dt4[i];
                    wv = (s <= tl) ? wv : 0.f;
                    wv += (s == tl) ? dskip : 0.f;
                    cb[4 * q4 + i] = wv;
                }
            }
#pragma unroll
            for (int sp = 0; sp < 2; ++sp) {
                const bf16x8 wf = pack_frag(cb, sp);
#pragma unroll
                for (int pt = 0; pt < 2; ++pt) { const bf16x8 A = tr_frag(F.lds + LC_X + h4 * 128 * 128, 128, 32 * st + 16 * sp, 32 * pt, 8, lane); acc[ps][pt] = MFMA32(A, wf, acc[ps][pt]); }
            }
        }
        float q = 0.f;
#pragma unroll
        for (int pt = 0; pt < 2; ++pt)
#pragma unroll
            for (int q4 = 0; q4 < 4; ++q4) {
                const float z0 = bflo(zz[pt][q4].x), z1 = bfhi(zz[pt][q4].x), z2 = bflo(zz[pt][q4].y), z3 = bfhi(zz[pt][q4].y);
                const float g0 = acc[ps][pt][4 * q4] * silu(z0), g1 = acc[ps][pt][4 * q4 + 1] * silu(z1), g2 = acc[ps][pt][4 * q4 + 2] * silu(z2), g3 = acc[ps][pt][4 * q4 + 3] * silu(z3);
                G[ps][pt][4 * q4] = g0; G[ps][pt][4 * q4 + 1] = g1; G[ps][pt][4 * q4 + 2] = g2; G[ps][pt][4 * q4 + 3] = g3;
                q += (g0 * g0 + g1 * g1) + (g2 * g2 + g3 * g3);
            }
        q += __shfl_xor(q, 32);
        if (hl == 0) LDSP(float, LC_SSQ)[(4 * ps + h4) * 64 + 32 * t2 + l31] = q;
        if (ps == 0) ZLOAD(1);
    }
    __syncthreads();
#pragma unroll
    for (int ps = 0; ps < 2; ++ps) {
        const int t2 = (w & 1) ^ ps, hh = gi * 8 + 4 * ps + h4;
        float tot = 0.f;
#pragma unroll
        for (int k = 0; k < 8; ++k) tot += LDSP(float, LC_SSQ)[k * 64 + 32 * t2 + l31];
        const float rstd = rsqrtf(tot * (1.f / 512.f) + EPS);
        const int tl = 32 * TILE_OF(t2) + l31;
        const float* gng = F.in[25] + hh * 64;
        bf16* yrow = Y + (size_t)(T0 + tl) * DM + 1024 + hh * 64;
#pragma unroll
        for (int pt = 0; pt < 2; ++pt)
#pragma unroll
            for (int q4 = 0; q4 < 4; ++q4) {
                const int p = 32 * pt + 8 * q4 + 4 * hl;
                const f32x4 gg = *(const f32x4*)(gng + p);
                v2u o; o.x = pk2(G[ps][pt][4 * q4] * rstd * gg[0], G[ps][pt][4 * q4 + 1] * rstd * gg[1]); o.y = pk2(G[ps][pt][4 * q4 + 2] * rstd * gg[2], G[ps][pt][4 * q4 + 3] * rstd * gg[3]);
                *(v2u*)(yrow + p) = o;
            }
    }
#undef TILE_OF
#undef YOFF
#undef ZLOAD
    __syncthreads();
}

constexpr int LM_VT = 0;
__device__ __forceinline__ void p6c_mlp_pair(Frame& F, int c0, int g0, int c1, int g1, bool two) {
    const bf16* Z = WSP(bf16, WS_Z); bf16* Y = WSP(bf16, WS_Y);
    const int tid = F.tid, lane = F.lane, w = F.wave, l31 = lane & 31, hl = lane >> 5, tt = w >> 1, t = 32 * tt + l31;
    const float* lng = F.in[16]; const float* lnb = F.in[17];
    v4u vv[2][4]; float mean[2][4], rstd[2][4];
#pragma unroll
    for (int p = 0; p < 2; ++p) { const int c = p ? c1 : c0, g = p ? g1 : g0;
        if (p == 0 || two) {
#pragma unroll
            for (int i = 0; i < 4; ++i) { const int item = tid + 512 * i, s = item >> 4, ch8 = item & 15, col = g * 128 + ch8 * 8;
                vv[p][i] = *(const v4u*)(Z + (size_t)(128 * c + s) * N1P + C1_V + col); mean[p][i] = WSP(float, WS_VST)[2 * (128 * c + s)]; rstd[p][i] = WSP(float, WS_VST)[2 * (128 * c + s) + 1]; } } }
    bf16x8 bfr[2][8]; v2u uu[2][2][4]; float bst[2];
#pragma unroll
    for (int p = 0; p < 2; ++p) { const int c = p ? c1 : c0, g = p ? g1 : g0;
        if (p == 0 || two) {
            const bf16* TR = WSP(bf16, WS_TRIL) + (size_t)g * 16384;
#pragma unroll
            for (int ks = 0; ks < 8; ++ks) if (ks < 2 * (tt + 1)) bfr[p][ks] = *(const bf16x8*)(TR + (size_t)t * 128 + 16 * ks + 8 * hl);
            bst[p] = F.in[19][g * 128 + t];
            const bf16* zr = Z + (size_t)(128 * c + t) * N1P;
#pragma unroll
            for (int w2 = 0; w2 < 2; ++w2)
#pragma unroll
                for (int q4 = 0; q4 < 4; ++q4) uu[p][w2][q4] = *(const v2u*)(zr + C1_UC + g * 128 + 32 * (2 * (w & 1) + w2) + 8 * q4 + 4 * hl); } }
#pragma unroll
    for (int p = 0; p < 2; ++p) { const int g = p ? g1 : g0;
        if (p == 0 || two) {
#pragma unroll
            for (int i = 0; i < 4; ++i) { const int item = tid + 512 * i, s = item >> 4, ch8 = item & 15, col = g * 128 + ch8 * 8;
                float f[8]; UNPACK8(vv[p][i], f); float vn[8];
#pragma unroll
                for (int k = 0; k < 8; ++k) vn[k] = (f[k] - mean[p][i]) * rstd[p][i] * lng[col + k] + lnb[col + k];
                *(LAS v4u*)(F.lds + LM_VT + p * 34816 + s * 272 + ch8 * 16) = pack8(vn); } } }
    __syncthreads();
#pragma unroll
    for (int p = 0; p < 2; ++p) { const int c = p ? c1 : c0, g = p ? g1 : g0;
        if (p == 0 || two) {
            f32x16 acc[2] = {};
#pragma unroll
            for (int ks = 0; ks < 8; ++ks) if (ks < 2 * (tt + 1)) {
#pragma unroll
                for (int w2 = 0; w2 < 2; ++w2) { const bf16x8 a = tr_frag_nat(F.lds + LM_VT + p * 34816, 272, 16 * ks, 32 * (2 * (w & 1) + w2), lane); acc[w2] = MFMA32(a, bfr[p][ks], acc[w2]); } }
            bf16* yr = Y + (size_t)(128 * c + t) * DM;
#pragma unroll
            for (int w2 = 0; w2 < 2; ++w2)
#pragma unroll
                for (int q4 = 0; q4 < 4; ++q4) {
                    const int col = g * 128 + 32 * (2 * (w & 1) + w2) + 8 * q4 + 4 * hl; const v2u u2 = uu[p][w2][q4];
                    const float y0 = bflo(u2.x) * (acc[w2][4 * q4] + bst[p]), y1 = bfhi(u2.x) * (acc[w2][4 * q4 + 1] + bst[p]), y2 = bflo(u2.y) * (acc[w2][4 * q4 + 2] + bst[p]), y3 = bfhi(u2.y) * (acc[w2][4 * q4 + 3] + bst[p]);
                    v2u o; o.x = pk2(y0, y1); o.y = pk2(y2, y3);
                    *(v2u*)(yr + col) = o;
                } } }
    __syncthreads();
}

constexpr int LS_W = 0, LS_W_STRIDE = 6144;
constexpr int LS_SSQ = 8 * LS_W_STRIDE;
__device__ __forceinline__ void p6c_sample_unit(Frame& F, int b, int gi) {
    const bf16* Z = WSP(bf16, WS_Z); bf16* Y = WSP(bf16, WS_Y);
    const float* cw = F.in[20]; const float* cb = F.in[21]; const float* scd = F.in[5];
    const int lane = F.lane, w = F.wave, hh = gi * 8 + w; const size_t m0 = MS0 + 4 * b;
    LAS float* xs = LDSP(float, LS_W + w * LS_W_STRIDE); LAS float* Bs = xs + 256; LAS float* Cs = Bs + 512; LAS float* ys = Cs + 512;
#pragma unroll
    for (int k = 0; k < 5; ++k) {
        const int ch = (k == 0) ? hh * 64 + lane : (k < 3 ? 1024 + gi * 128 + (k - 1) * 64 + lane : 1280 + gi * 128 + (k - 3) * 64 + lane);
        float full[7];
#pragma unroll
        for (int i = 0; i < 3; ++i) full[i] = scd[((size_t)b * 3 + i) * 1536 + ch];
#pragma unroll
        for (int t = 0; t < 4; ++t) full[3 + t] = bf1(Z[(m0 + t) * N1P + C1_X + ch]);
        const float w0 = cw[ch], w1 = cw[1536 + ch], w2 = cw[3072 + ch], w3 = cw[4608 + ch], bb = cb[ch];
#pragma unroll
        for (int t = 0; t < 4; ++t) {
            const float a = silu(w0 * full[t] + w1 * full[t + 1] + w2 * full[t + 2] + w3 * full[t + 3] + bb);
            if (k == 0) xs[t * 64 + lane] = a; else if (k < 3) Bs[t * 128 + (k - 1) * 64 + lane] = a; else Cs[t * 128 + (k - 3) * 64 + lane] = a;
        }
        if (k == 0 || w == 0) {
#pragma unroll
            for (int i = 0; i < 3; ++i) F.out[O_SCD + ((size_t)b * 3 + i) * 1536 + ch] = full[4 + i]; }
    }
    float dtv[4], dA[4];
    { const float a = -__expf(F.in[23][hh]), bias = F.in[22][hh];
#pragma unroll
      for (int t = 0; t < 4; ++t) { dtv[t] = softplus_f(WSP(float, WS_DTR)[(m0 + t) * 16 + hh] + bias); dA[t] = __expf(dtv[t] * a); } }
    const int plo = lane >> 4, n0 = 8 * (lane & 15);
    float Br[4][8], Cr[4][8];
#pragma unroll
    for (int t = 0; t < 4; ++t) { const f32x4 b0 = *(const LAS f32x4*)(Bs + t * 128 + n0), b1 = *(const LAS f32x4*)(Bs + t * 128 + n0 + 4), c0 = *(const LAS f32x4*)(Cs + t * 128 + n0), c1 = *(const LAS f32x4*)(Cs + t * 128 + n0 + 4);
#pragma unroll
        for (int i = 0; i < 4; ++i) { Br[t][i] = b0[i]; Br[t][4 + i] = b1[i]; Cr[t][i] = c0[i]; Cr[t][4 + i] = c1[i]; } }
    const float* sin_ = F.in[6] + ((size_t)(b * 16 + hh) * 64) * 128; float* sout = F.out + O_SSSM + ((size_t)(b * 16 + hh) * 64) * 128;
#pragma unroll 1
    for (int ph = 0; ph < 2; ++ph) {
        f32x4 hv[8][2];
#pragma unroll
        for (int k = 0; k < 8; ++k) { const int p = 4 * (8 * ph + k) + plo; hv[k][0] = __builtin_nontemporal_load((const f32x4*)(sin_ + (size_t)p * 128 + n0)); hv[k][1] = __builtin_nontemporal_load((const f32x4*)(sin_ + (size_t)p * 128 + n0 + 4)); }
#pragma unroll
        for (int k = 0; k < 8; ++k) {
            const int p = 4 * (8 * ph + k) + plo;
            float h[8];
#pragma unroll
            for (int i = 0; i < 4; ++i) { h[i] = hv[k][0][i]; h[4 + i] = hv[k][1][i]; }
            float yp[4];
#pragma unroll
            for (int t = 0; t < 4; ++t) {
                const float coef = dtv[t] * xs[t * 64 + p]; float acc = 0.f;
#pragma unroll
                for (int i = 0; i < 8; ++i) { h[i] = dA[t] * h[i] + coef * Br[t][i]; acc += h[i] * Cr[t][i]; }
                yp[t] = acc;
            }
            __builtin_nontemporal_store((f32x4){h[0], h[1], h[2], h[3]}, (f32x4*)(sout + (size_t)p * 128 + n0)); __builtin_nontemporal_store((f32x4){h[4], h[5], h[6], h[7]}, (f32x4*)(sout + (size_t)p * 128 + n0 + 4));
#pragma unroll
            for (int t = 0; t < 4; ++t) { const float v = row16_sum(yp[t]); if ((lane & 15) == 0) ys[t * 64 + p] = v; }
        }
    }
    float gv[4];
#pragma unroll
    for (int t = 0; t < 4; ++t) {
        const float yv = ys[t * 64 + lane] + F.in[24][hh] * xs[t * 64 + lane];
        const float z = bf1(Z[(m0 + t) * N1P + C1_Z + hh * 64 + lane]);
        gv[t] = yv * silu(z);
        const float q = wave_sum(gv[t] * gv[t]);
        if (lane == 0) LDSP(float, LS_SSQ)[w * 4 + t] = q;
    }
    __syncthreads();
#pragma unroll
    for (int t = 0; t < 4; ++t) {
        float tot = 0.f;
#pragma unroll
        for (int k = 0; k < 8; ++k) tot += LDSP(float, LS_SSQ)[k * 4 + t];
        const float rstd = rsqrtf(tot * (1.f / 512.f) + EPS);
        Y[(m0 + t) * DM + 1024 + hh * 64 + lane] = (bf16)f2bf(gv[t] * rstd * F.in[25][hh * 64 + lane]);
    }
    __syncthreads();
}

__device__ __forceinline__ void p6c_sample_mlp(Frame& F, int b) {
    const bf16* Z = WSP(bf16, WS_Z); bf16* Y = WSP(bf16, WS_Y);
    const int lane = F.lane, col = 16 * lane, g = lane >> 3; const size_t m0 = MS0 + 4 * b;
    const float* lng = F.in[16]; const float* lnb = F.in[17]; const float* ws = F.in[18] + (size_t)g * 16384; const float* bs = F.in[19] + g * 128;
    float vn[4][16];
#pragma unroll
    for (int t = 0; t < 4; ++t) {
        const bf16* vp = Z + (m0 + t) * N1P + C1_V + col;
        float* f = vn[t]; { const v4u a = *(const v4u*)vp, c = *(const v4u*)(vp + 8); UNPACK8(a, f); float* f2 = f + 8; UNPACK8(c, f2); }
        float s = 0.f;
#pragma unroll
        for (int i = 0; i < 16; ++i) s += f[i];
        const float mean = wave_sum(s) * (1.f / 1024.f); float q = 0.f;
#pragma unroll
        for (int i = 0; i < 16; ++i) { const float d = f[i] - mean; q += d * d; }
        const float rstd = rsqrtf(wave_sum(q) * (1.f / 1024.f) + EPS);
#pragma unroll
        for (int i = 0; i < 16; ++i) f[i] = (f[i] - mean) * rstd * lng[col + i] + lnb[col + i];
        float* o = F.out + O_SCV + ((size_t)b * 4 + t) * 1024 + col;
#pragma unroll
        for (int i = 0; i < 4; ++i) *(f32x4*)(o + 4 * i) = (f32x4){f[4 * i], f[4 * i + 1], f[4 * i + 2], f[4 * i + 3]};
    }
#pragma unroll
    for (int t = 0; t < 4; ++t) {
        const bf16* zr = Z + (m0 + t) * N1P;
        float uu[16];
        { const v4u a = *(const v4u*)(zr + C1_UC + col), c = *(const v4u*)(zr + C1_UC + col + 8); UNPACK8(a, uu); float* u2 = uu + 8; UNPACK8(c, u2); }
        float y[16];
#pragma unroll
        for (int i = 0; i < 16; ++i) {
            float mix = bs[t];
#pragma unroll
            for (int s = 0; s < 4; ++s) if (s <= t) mix += ws[t * 128 + s] * vn[s][i];
            y[i] = uu[i] * mix;
        }
        *(v4u*)(Y + (m0 + t) * DM + col) = pack8(y); *(v4u*)(Y + (m0 + t) * DM + col + 8) = pack8(y + 8);
    }
}

#ifndef USE_CG_SYNC
#define USE_CG_SYNC 0
#endif
__global__ void __launch_bounds__(NTHR, 2) hybrid_fwd(Args args) {
    extern __shared__ __attribute__((aligned(16))) unsigned char lds[];
    cg::grid_group grid = cg::this_grid();
    Frame F;
    F.lds = (LAS unsigned char*)lds;
    F.tid = threadIdx.x; F.lane = F.tid & 63; F.wave = __builtin_amdgcn_readfirstlane(F.tid >> 6);
    F.G = gridDim.x; F.bid = blockIdx.x;
#pragma unroll
    for (int i = 0; i < 28; ++i) F.in[i] = args.in[i];
    F.out = args.out; F.ws = args.ws;
    for (int u = F.tid; u < (LDS_BYTES - LDS_CTL_OFF) / 4; u += NTHR) ((LAS unsigned*)(F.lds + LDS_CTL_OFF))[u] = 0u;
    __syncthreads();
    XcdBarrier bar = xcd_barrier_post((unsigned*)(F.ws + WS_CTL) + CW_BAR, (volatile LAS unsigned*)(F.lds + LDS_CTL_OFF) + 8);
    const int lo = args.ph_lo, hi = args.ph_hi;
    if (hi > 64) grid.sync();
#ifndef PHASE_MASK
#define PHASE_MASK 0x1fff
#endif
#ifndef REP_MASK
#define REP_MASK 0
#endif
#define REPS(k) _Pragma("unroll") for (int rep_ = 0; rep_ < ((((REP_MASK) >> (k)) & 1) ? 2 : 1); ++rep_)
#define IN(k) (((PHASE_MASK >> (k)) & 1) && lo <= (k) && (k) < hi)
#ifdef DELAY_MASK
#define STAMP(k) do { if (F.bid == 0 && F.tid == 0) ((volatile LAS unsigned long long*)(F.lds + LDS_CTL_OFF + 64))[(k)] = __builtin_amdgcn_s_memrealtime(); } while (0)
#define DELAY(k) do { if (((DELAY_MASK) >> (k)) & 1) { if (F.bid == 0 && F.tid == 0) { volatile LAS unsigned long long* T_ = (volatile LAS unsigned long long*)(F.lds + LDS_CTL_OFF + 64); \
        const unsigned long long t1_ = T_[(k) + 1], d_ = t1_ - T_[(k)]; while (__builtin_amdgcn_s_memrealtime() < t1_ + d_) __builtin_amdgcn_s_sleep(8); } xcd_barrier(bar); } } while (0)
#else
#define STAMP(k) do { } while (0)
#define DELAY(k) do { } while (0)
#endif
#ifdef DOUBLE_BAR
#define SEAM(k) do { if (IN(k) && IN((k) + 1)) { if (USE_CG_SYNC) grid.sync(); else xcd_barrier(bar); xcd_barrier(bar); } STAMP((k) + 1); DELAY(k); } while (0)
#else
#define SEAM(k) do { if (IN(k) && IN((k) + 1)) { if (USE_CG_SYNC) grid.sync(); else xcd_barrier(bar); } STAMP((k) + 1); DELAY(k); } while (0)
#endif

    STAMP(0);
    if (IN(0)) REPS(0) { p0_prologue(F); }
    SEAM(0);
    if (IN(1)) REPS(1) {
        pg8::Gemm g{WSP(bf16, WS_H), WSP(bf16, WS_WT0), MROWS, N0, DM}; pg8::StaticOrder S; S.init(MROWS, N0, F.G, F.bid);
        pg8::EpiL0 E{WSP(bf16, WS_Z), N0};
        pg8::gemm_phase<pg8::EpiL0, pg8::StaticOrder, true, true>(F.lds, g, S, E);
        filler_loop(F);
    }
    SEAM(1);
    if (IN(2)) REPS(2) { p2_mixers0(F); }
    SEAM(2);
    if (IN(3)) {
        pg8::StaticOrder S; S.init(SEQ, DM, F.G, F.bid); pg8::Unit u; u.pm = 0; u.pn = 0; (void)S.next(0, u);
        { pg8::Gemm g{WSP(bf16, WS_Y), WSP(bf16, WS_WO0), SEQ, DM, DM}; pg8::EpiStore E{WSP(bf16, WS_Z), DM, nullptr, -1};
          pg8::gemm_phase<pg8::EpiStore, pg8::StaticOrder, false, true>(F.lds, g, S, E); }
        group_arrive((unsigned*)(F.ws + WS_CTL) + CW_PANEL0 + 64 * u.pm);
        static_assert(16 * TSPLIT == SEQ / 256, "one tail item per prompt panel: the panel's pn = 0 workgroup carries it");
        const bool tailwg = (u.pn == 0);
        if (tailwg) { const int kq = u.pm >> 4;
            pg8::Gemm g{WSP(bf16, WS_Y) + (size_t)SEQ * DM + kq * (DM / TSPLIT), WSP(bf16, WS_WO0) + kq * (DM / TSPLIT), MROWS - SEQ, DM, DM / TSPLIT, DM}; pg8::StaticOrder S2; S2.init(MROWS - SEQ, DM, F.G, u.pm & 15);
            pg8::EpiF32 E{WSP(float, WS_PT) + (size_t)kq * 512 * DM, DM};
            pg8::gemm_phase<pg8::EpiF32, pg8::StaticOrder, false, true>(F.lds, g, S2, E); group_arrive((unsigned*)(F.ws + WS_CTL) + CW_TAIL0); }
        row_pass(F, true, F.in[13], F.in[14], WSP(bf16, WS_H), 256 * u.pm, !tailwg ? 256 * u.pm + 256 : 256 * u.pm, (tailwg ? 0 : u.pn - 1) * NWAVES + F.wave, 7 * NWAVES, (unsigned*)(F.ws + WS_CTL) + CW_PANEL0 + 64 * u.pm, 8u,
                 SEQ, MROWS, F.bid * NWAVES + F.wave, F.G * NWAVES, (unsigned*)(F.ws + WS_CTL) + CW_TAIL0, 16u * TSPLIT);
    }
    SEAM(3); STAMP(5); STAMP(6);
    if (IN(6)) REPS(6) {
        pg8::Gemm g{WSP(bf16, WS_H), WSP(bf16, WS_WT1), MROWS, N1P, DM}; pg8::StaticOrder S; S.init(MROWS, N1P, F.G, F.bid);
        pg8::EpiL1 E{WSP(bf16, WS_Z), N1P, WSP(float, WS_RS1)};
        pg8::gemm_phase<pg8::EpiL1, pg8::StaticOrder, true, true>(F.lds, g, S, E);
    }
    SEAM(6);
    if (IN(7)) REPS(7) { for (int u = F.bid; u < 256; u += F.G) p6a_unit(F, u >> 2, (u >> 1) & 1, u & 1); }
    SEAM(7);
    if (IN(8)) { p6b_scan(F); }
    SEAM(8);
    if (IN(9)) {
        if (F.bid & 1) { REPS(15) for (int u = F.bid; u < 256; u += F.G) p6c_sample_unit(F, u >> 1, u & 1); }
        pg8::StaticOrder So; So.init(SEQ, DM, F.G, F.bid); pg8::Unit uo; uo.pm = F.bid >> 3; uo.pn = F.bid & 7; (void)So.next(0, uo);
        REPS(13) p6c_ssd_unit(F, 2 * uo.pm + (uo.pn >> 2), (uo.pn >> 1) & 1, uo.pn & 1);
        REPS(14) p6c_mlp_pair(F, 2 * uo.pm + (uo.pn >> 2), 2 * (uo.pn & 3), 2 * uo.pm + (uo.pn >> 2), 2 * (uo.pn & 3) + 1, true);
        if (!(F.bid & 1)) { REPS(15) for (int u = F.bid; u < 256; u += F.G) p6c_sample_unit(F, u >> 1, u & 1); }
        for (int u = F.wave * F.G + F.bid; u < 128; u += NWAVES * F.G) p6c_sample_mlp(F, u);
        if (F.bid == F.G - 1) { const bf16* Z = WSP(bf16, WS_Z);
            for (int i = F.tid; i < 3 * 1536; i += NTHR) { const int r = i / 1536, ch = i % 1536; F.out[O_PCD + i] = bf1(Z[(size_t)(SEQ - 3 + r) * N1P + C1_X + ch]); } }
    }
    SEAM(9);
    if (IN(10)) {
        pg8::StaticOrder S; S.init(SEQ, DM, F.G, F.bid); pg8::Unit u; u.pm = 0; u.pn = 0; (void)S.next(0, u);
        { pg8::Gemm g{WSP(bf16, WS_Y), WSP(bf16, WS_WO1), SEQ, DM, DM}; pg8::EpiStore E{WSP(bf16, WS_Z), DM, nullptr, -1};
          pg8::gemm_phase<pg8::EpiStore, pg8::StaticOrder, false, true>(F.lds, g, S, E); }
        group_arrive((unsigned*)(F.ws + WS_CTL) + CW_PANEL1 + 64 * u.pm);
        static_assert(16 * TSPLIT == SEQ / 256, "one tail item per prompt panel: the panel's pn = 0 workgroup carries it");
        const bool tailwg = (u.pn == 0);
        if (tailwg) { const int kq = u.pm >> 4;
            pg8::Gemm g{WSP(bf16, WS_Y) + (size_t)SEQ * DM + kq * (DM / TSPLIT), WSP(bf16, WS_WO1) + kq * (DM / TSPLIT), MROWS - SEQ, DM, DM / TSPLIT, DM}; pg8::StaticOrder S2; S2.init(MROWS - SEQ, DM, F.G, u.pm & 15);
            pg8::EpiF32 E{WSP(float, WS_PT) + (size_t)kq * 512 * DM, DM};
            pg8::gemm_phase<pg8::EpiF32, pg8::StaticOrder, false, true>(F.lds, g, S2, E); group_arrive((unsigned*)(F.ws + WS_CTL) + CW_TAIL1); }
        row_pass(F, false, F.in[27], nullptr, nullptr, 256 * u.pm, !tailwg ? 256 * u.pm + 256 : 256 * u.pm, (tailwg ? 0 : u.pn - 1) * NWAVES + F.wave, 7 * NWAVES, (unsigned*)(F.ws + WS_CTL) + CW_PANEL1 + 64 * u.pm, 8u,
                 SEQ, MROWS, F.bid * NWAVES + F.wave, F.G * NWAVES, (unsigned*)(F.ws + WS_CTL) + CW_TAIL1, 16u * TSPLIT);
    }
#ifdef DELAY_MASK
    xcd_barrier(bar); STAMP(11); DELAY(10);
#endif
#undef IN
#undef SEAM
}

extern "C" void kernel_launch(void* const* d_in, const int* in_sizes, int n_in, void* d_out, int out_size, void* d_ws, size_t ws_size, hipStream_t stream) {
    static int grid = 0;
    if (grid == 0) {
        int dev = 0, cus = 0, per_cu = 0;
        if (n_in != 28 || (size_t)out_size != O_END || ws_size < WS_END) { fprintf(stderr, "kernel_launch: unexpected shapes n_in %d out %d ws %zu\n", n_in, out_size, ws_size); grid = -1; return; }
        (void)hipGetDevice(&dev); (void)hipDeviceGetAttribute(&cus, hipDeviceAttributeMultiprocessorCount, dev);
        (void)hipFuncSetAttribute((const void*)hybrid_fwd, hipFuncAttributeMaxDynamicSharedMemorySize, LDS_BYTES);
        (void)hipOccupancyMaxActiveBlocksPerMultiprocessor(&per_cu, (const void*)hybrid_fwd, NTHR, LDS_BYTES);
        (void)hipGetLastError();
        if (per_cu < 1) { fprintf(stderr, "kernel_launch: occupancy query says %d blocks per CU\n", per_cu); grid = -1; return; }
        if (cus != 256) { fprintf(stderr, "kernel_launch: built for a 256-CU device (the out-projection phases give one tile to each of 256 workgroups); found %d CUs\n", cus); grid = -1; return; }
        grid = cus;
    }
    if (grid < 0) return;
    (void)hipMemsetAsync((char*)d_ws + WS_CTL, 0, CTL_ZERO_BYTES, stream);
    Args a{};
    for (int i = 0; i < 28; ++i) a.in[i] = (const float*)d_in[i];
    a.out = (float*)d_out; a.ws = (unsigned char*)d_ws;
    a.ph_lo = 0; a.ph_hi = 13;
    void* params[] = {&a};
    hipError_t e = hipLaunchCooperativeKernel((const void*)hybrid_fwd, dim3(grid), dim3(NTHR), params, LDS_BYTES, stream);
    if (e != hipSuccess) fprintf(stderr, "cooperative launch failed: %s (grid %d)\n", hipGetErrorString(e), grid);
}
```

```cpp
#include <hip/hip_runtime.h>
#include <hip/hip_cooperative_groups.h>
#include <cstdio>
#include <cstdint>
namespace cg = cooperative_groups;

namespace pg8 {
#define PG8_LAS __attribute__((address_space(3)))
typedef unsigned short bf16_t;
typedef short bf16x8 __attribute__((ext_vector_type(8)));
typedef float f32x4 __attribute__((ext_vector_type(4)));
typedef unsigned u32x4 __attribute__((ext_vector_type(4)));
constexpr int BM = 256, BK = 64, HALF = 128, HTB = HALF * BK * 2  , STAGE_BYTES = 8 * HTB, NXCD = 8, WGM = 4;

__host__ __device__ __forceinline__ int lds_byte(int r, int c) { const int st = (r >> 4) * 2 + (c >> 5), rr = r & 15, cc = c & 31, ob = rr * 64 + cc * 2; return st * 1024 + (ob ^ (((ob >> 9) & 1) << 5)); }
__host__ __device__ __forceinline__ void stage_rc(int b, int& R, int& C) { const int st = b / 1024, sb = b % 1024, swz = sb ^ (((sb >> 9) & 1) << 5); R = (st >> 1) * 16 + swz / 64; C = (st & 1) * 32 + (swz % 64) / 2; }
__host__ __device__ __forceinline__ int perm32(int rho) { const int n = rho >> 4, i = rho & 15; return 8 * (i >> 2) + 4 * n + (i & 3); }

struct Unit { int pm, pn; };
struct Gemm { const bf16_t* A; const bf16_t* Bt; int M, N, K; int ld = 0; };

struct StaticOrder {
    int nM, nN, nwg, G, c;
    __host__ __device__ __forceinline__ void init(int M, int N, int G_, int c_) { nM = M / BM; nN = N / BM; nwg = nM * nN; G = G_; c = c_; }
    __host__ __device__ __forceinline__ bool next(int i, Unit& u) const {
        const long L = (long)i * G + c; if (L >= nwg) return false;
        int wgid = (int)L; { const int q = nwg / NXCD, r = nwg % NXCD, xcd = wgid % NXCD, off = wgid / NXCD; wgid = (xcd < r ? xcd * (q + 1) : r * (q + 1) + (xcd - r) * q) + off; }
        const int nig = WGM * nN, gid = wgid / nig, fm = gid * WGM, gsz = (nM - fm) < WGM ? (nM - fm) : WGM;
        u.pm = fm + ((wgid % nig) % gsz); u.pn = (wgid % nig) / gsz; return true;
    }
    __device__ __forceinline__ void a_ready(const Unit&) const {}
    __device__ __forceinline__ void done(const Unit&) const {}
};

__device__ __forceinline__ unsigned cvt_pk_bf16(float lo, float hi) { unsigned r; asm volatile("v_cvt_pk_bf16_f32 %0, %1, %2" : "=v"(r) : "v"(lo), "v"(hi)); return r; }
struct EpiStore {
    static constexpr bool PERM = true, AFTER_DRAIN = false;
    bf16_t* O; int ldc; float* dt_out; int dt_tile;
    __device__ __forceinline__ void operator()(const f32x4 (&acc)[2][2][4][2], const Unit& u, int wr, int wc, int fr, int fq) const {
        const int row0 = u.pm * BM + wr * 64 + fr; const int col0 = u.pn * BM + wc * 32 + 8 * fq;
#pragma unroll
        for (int ai = 0; ai < 2; ++ai)
#pragma unroll
            for (int m = 0; m < 4; ++m) { bf16_t* rowp = O + (size_t)(row0 + ai * HALF + m * 16) * ldc + col0;
#pragma unroll
                for (int bj = 0; bj < 2; ++bj) { const f32x4 v0 = acc[ai][bj][m][0], v1 = acc[ai][bj][m][1];
                    u32x4 w; w.x = cvt_pk_bf16(v0[0], v0[1]); w.y = cvt_pk_bf16(v0[2], v0[3]); w.z = cvt_pk_bf16(v1[0], v1[1]); w.w = cvt_pk_bf16(v1[2], v1[3]);
                    *(u32x4*)(rowp + bj * HALF) = w; } }
        if (dt_out != nullptr && u.pn == dt_tile && wc == 0 && fq < 2) {
#pragma unroll
            for (int ai = 0; ai < 2; ++ai)
#pragma unroll
                for (int m = 0; m < 4; ++m) { float* p = dt_out + (size_t)(row0 + ai * HALF + m * 16) * 16 + 8 * fq;
                    *(f32x4*)(p) = acc[ai][0][m][0]; *(f32x4*)(p + 4) = acc[ai][0][m][1]; }
        }
    }
};
__device__ __forceinline__ void st16_wt(void* p, u32x4 v) { asm volatile("global_store_dwordx4 %0, %1, off sc1\n\ts_nop 1" :: "v"(p), "v"(v) : "memory"); }
struct EpiStoreWT {
    static constexpr bool PERM = true, AFTER_DRAIN = false;
    bf16_t* O; int ldc;
    __device__ __forceinline__ void operator()(const f32x4 (&acc)[2][2][4][2], const Unit& u, int wr, int wc, int fr, int fq) const {
        const int row0 = u.pm * BM + wr * 64 + fr; const int col0 = u.pn * BM + wc * 32 + 8 * fq;
#pragma unroll
        for (int ai = 0; ai < 2; ++ai)
#pragma unroll
            for (int m = 0; m < 4; ++m) { bf16_t* rowp = O + (size_t)(row0 + ai * HALF + m * 16) * ldc + col0;
#pragma unroll
                for (int bj = 0; bj < 2; ++bj) { const f32x4 v0 = acc[ai][bj][m][0], v1 = acc[ai][bj][m][1];
                    u32x4 w; w.x = cvt_pk_bf16(v0[0], v0[1]); w.y = cvt_pk_bf16(v0[2], v0[3]); w.z = cvt_pk_bf16(v1[0], v1[1]); w.w = cvt_pk_bf16(v1[2], v1[3]);
                    st16_wt(rowp + bj * HALF, w); } }
    }
};
__device__ __forceinline__ float silu_f(float x) { return x * __builtin_amdgcn_rcpf(1.f + __expf(-x)); }
struct EpiL0 {
    static constexpr bool PERM = true, AFTER_DRAIN = false;
    bf16_t* O; int ldc; const float* rs;
    __device__ __forceinline__ void operator()(const f32x4 (&acc_)[2][2][4][2], const Unit& u, int wr, int wc, int fr, int fq) const {
        const int row0 = u.pm * BM + wr * 64 + fr;
        f32x4 acc[2][2][4][2];
#pragma unroll
        for (int ai = 0; ai < 2; ++ai)
#pragma unroll
            for (int m = 0; m < 4; ++m) { const float r = rs[row0 + ai * HALF + m * 16];
#pragma unroll
                for (int bj = 0; bj < 2; ++bj)
#pragma unroll
                    for (int n = 0; n < 2; ++n) acc[ai][bj][m][n] = acc_[ai][bj][m][n] * r; }
        if (u.pn >= 16) {
            const int col0 = u.pn * BM + wc * 32 + 8 * fq;
#pragma unroll
            for (int ai = 0; ai < 2; ++ai)
#pragma unroll
                for (int m = 0; m < 4; ++m) { bf16_t* rowp = O + (size_t)(row0 + ai * HALF + m * 16) * ldc + col0;
#pragma unroll
                    for (int bj = 0; bj < 2; ++bj) { const f32x4 v0 = acc[ai][bj][m][0], v1 = acc[ai][bj][m][1];
                        u32x4 w; w.x = cvt_pk_bf16(v0[0], v0[1]); w.y = cvt_pk_bf16(v0[2], v0[3]); w.z = cvt_pk_bf16(v1[0], v1[1]); w.w = cvt_pk_bf16(v1[2], v1[3]);
                        *(u32x4*)(rowp + bj * HALF) = w; } }
        } else {
            const int col = ((wc >> 1) ? 1024 : 0) + u.pn * 64 + (wc & 1) * 32 + 8 * fq;
#pragma unroll
            for (int ai = 0; ai < 2; ++ai)
#pragma unroll
                for (int m = 0; m < 4; ++m) {
                    f32x4 r0, r1;
                    if (wc < 2) { r0 = acc[ai][0][m][0] * acc[ai][1][m][0]; r1 = acc[ai][0][m][1] * acc[ai][1][m][1]; }
                    else {
#pragma unroll
                        for (int i = 0; i < 4; ++i) { r0[i] = acc[ai][0][m][0][i] * silu_f(acc[ai][1][m][0][i]); r1[i] = acc[ai][0][m][1][i] * silu_f(acc[ai][1][m][1][i]); } }
                    u32x4 w; w.x = cvt_pk_bf16(r0[0], r0[1]); w.y = cvt_pk_bf16(r0[2], r0[3]); w.z = cvt_pk_bf16(r1[0], r1[1]); w.w = cvt_pk_bf16(r1[2], r1[3]);
                    *(u32x4*)(O + (size_t)(row0 + ai * HALF + m * 16) * ldc + col) = w; }
        }
    }
};
struct EpiL1 {
    static constexpr bool PERM = true, AFTER_DRAIN = false;
    bf16_t* O; int ldc; const float* rs; float* vsp;
    __device__ __forceinline__ void operator()(const f32x4 (&acc_)[2][2][4][2], const Unit& u, int wr, int wc, int fr, int fq) const {
        const int row0 = u.pm * BM + wr * 64 + fr;
        f32x4 acc[2][2][4][2];
#pragma unroll
        for (int ai = 0; ai < 2; ++ai)
#pragma unroll
            for (int m = 0; m < 4; ++m) { const float r = rs[row0 + ai * HALF + m * 16];
#pragma unroll
                for (int bj = 0; bj < 2; ++bj)
#pragma unroll
                    for (int n = 0; n < 2; ++n) acc[ai][bj][m][n] = acc_[ai][bj][m][n] * r; }
        if (u.pn >= 8 && u.pn < 12) {
#pragma unroll
            for (int ai = 0; ai < 2; ++ai)
#pragma unroll
                for (int m = 0; m < 4; ++m) { float s1 = 0.f, s2 = 0.f;
#pragma unroll
                    for (int bj = 0; bj < 2; ++bj)
#pragma unroll
                        for (int n = 0; n < 2; ++n)
#pragma unroll
                            for (int i = 0; i < 4; ++i) { const float x = acc[ai][bj][m][n][i]; s1 += x; s2 += x * x; }
                    { auto r = __builtin_amdgcn_permlane16_swap(__float_as_uint(s1), __float_as_uint(s1), false, false); s1 = __uint_as_float(r[0]) + __uint_as_float(r[1]); }
                    { auto r = __builtin_amdgcn_permlane32_swap(__float_as_uint(s1), __float_as_uint(s1), false, false); s1 = __uint_as_float(r[0]) + __uint_as_float(r[1]); }
                    { auto r = __builtin_amdgcn_permlane16_swap(__float_as_uint(s2), __float_as_uint(s2), false, false); s2 = __uint_as_float(r[0]) + __uint_as_float(r[1]); }
                    { auto r = __builtin_amdgcn_permlane32_swap(__float_as_uint(s2), __float_as_uint(s2), false, false); s2 = __uint_as_float(r[0]) + __uint_as_float(r[1]); }
                    if (fq == 0) { float* p = vsp + ((size_t)(row0 + ai * HALF + m * 16) * 16 + (u.pn - 8) * 4 + wc) * 2; p[0] = s1; p[1] = s2; } }
        }
        if (u.pn >= 8) {
            const int col0 = (u.pn < 12 ? 1024 + (u.pn - 8) * BM : u.pn * BM) + wc * 32 + 8 * fq;
#pragma unroll
            for (int ai = 0; ai < 2; ++ai)
#pragma unroll
                for (int m = 0; m < 4; ++m) { bf16_t* rowp = O + (size_t)(row0 + ai * HALF + m * 16) * ldc + col0;
#pragma unroll
                    for (int bj = 0; bj < 2; ++bj) { const f32x4 v0 = acc[ai][bj][m][0], v1 = acc[ai][bj][m][1];
                        u32x4 w; w.x = cvt_pk_bf16(v0[0], v0[1]); w.y = cvt_pk_bf16(v0[2], v0[3]); w.z = cvt_pk_bf16(v1[0], v1[1]); w.w = cvt_pk_bf16(v1[2], v1[3]);
                        *(u32x4*)(rowp + bj * HALF) = w; } }
        } else {
            const int col = u.pn * 128 + wc * 32 + 8 * fq;
#pragma unroll
            for (int ai = 0; ai < 2; ++ai)
#pragma unroll
                for (int m = 0; m < 4; ++m) {
                    f32x4 r0, r1;
#pragma unroll
                    for (int i = 0; i < 4; ++i) { r0[i] = acc[ai][0][m][0][i] * silu_f(acc[ai][1][m][0][i]); r1[i] = acc[ai][0][m][1][i] * silu_f(acc[ai][1][m][1][i]); }
                    u32x4 w; w.x = cvt_pk_bf16(r0[0], r0[1]); w.y = cvt_pk_bf16(r0[2], r0[3]); w.z = cvt_pk_bf16(r1[0], r1[1]); w.w = cvt_pk_bf16(r1[2], r1[3]);
                    *(u32x4*)(O + (size_t)(row0 + ai * HALF + m * 16) * ldc + col) = w; }
        }
    }
};
struct EpiF32 {
    static constexpr bool PERM = true, AFTER_DRAIN = false;
    float* P; int ldc;
    __device__ __forceinline__ void operator()(const f32x4 (&acc)[2][2][4][2], const Unit& u, int wr, int wc, int fr, int fq) const {
        const int row0 = u.pm * BM + wr * 64 + fr; const int col0 = u.pn * BM + wc * 32 + 8 * fq;
#pragma unroll
        for (int ai = 0; ai < 2; ++ai)
#pragma unroll
            for (int m = 0; m < 4; ++m) { float* rowp = P + (size_t)(row0 + ai * HALF + m * 16) * ldc + col0;
#pragma unroll
                for (int bj = 0; bj < 2; ++bj) { *(f32x4*)(rowp + bj * HALF) = acc[ai][bj][m][0]; *(f32x4*)(rowp + bj * HALF + 4) = acc[ai][bj][m][1]; } }
    }
};

template <class Epi, class Sched, bool ALIGN_EPI = false, bool SP2 = false>
__device__ __forceinline__ void gemm_phase(PG8_LAS unsigned char* lds, const Gemm g, const Sched& S, const Epi& E) {
    const int tid = threadIdx.x, wid = __builtin_amdgcn_readfirstlane(tid >> 6), lane = tid & 63, wr = wid >> 2, wc = wid & 3, fr = lane & 15, fq = lane >> 4;
    const int K = g.ld ? g.ld : g.K, nt = g.K / BK;
    unsigned voffA[2], voffB[2];
#pragma unroll
    for (int i = 0; i < 2; ++i) { int R, C; stage_rc(tid * 16 + i * 8192, R, C); const int Rb = Epi::PERM ? ((R & ~31) + perm32(R & 31)) : R;
        voffA[i] = (unsigned)(R * K + C) * 2u; voffB[i] = (unsigned)(Rb * K + C) * 2u; }
    const size_t kstep = (size_t)(BK * 2);
    const size_t hstep = (size_t)HALF * K * 2;
    const size_t tstep = 2 * hstep;
    const unsigned ldsw = (unsigned)wid * 1024u;
    const int aoff = lds_byte(wr * 64 + fr, fq * 8), boff = lds_byte(wc * 32 + fr, fq * 8);
#define PG8_SA(b, h) (((b) * 2 + (h)) * HTB)
#define PG8_SB(b, h) ((4 + (b) * 2 + (h)) * HTB)
#define PG8_STAGE(bufoff, gbase, voff) do { _Pragma("unroll") for (int _i = 0; _i < 2; ++_i) \
        __builtin_amdgcn_global_load_lds((const unsigned*)((const char*)(gbase) + (voff)[_i]), (PG8_LAS unsigned*)(lds + (bufoff) + ldsw + _i * 8192), 16, 0, 0); } while (0)
#define PG8_LDA(dst, b, h) do { _Pragma("unroll") for (int m = 0; m < 4; ++m) _Pragma("unroll") for (int k = 0; k < 2; ++k) dst[m][k] = *(const PG8_LAS bf16x8*)(lds + PG8_SA(b, h) + aoff + m * 2048 + k * 1024); } while (0)
#define PG8_LDB(dst, b, h) do { _Pragma("unroll") for (int n = 0; n < 2; ++n) _Pragma("unroll") for (int k = 0; k < 2; ++k) dst[n][k] = *(const PG8_LAS bf16x8*)(lds + PG8_SB(b, h) + boff + n * 2048 + k * 1024); } while (0)
#define PG8_MMA(ai, bj, At, Bt) do { __builtin_amdgcn_s_setprio(1); _Pragma("unroll") for (int m = 0; m < 4; ++m) _Pragma("unroll") for (int n = 0; n < 2; ++n) _Pragma("unroll") for (int k = 0; k < 2; ++k) \
        acc[ai][bj][m][n] = __builtin_amdgcn_mfma_f32_16x16x32_bf16(Bt[n][k], At[m][k], acc[ai][bj][m][n], 0, 0, 0); __builtin_amdgcn_s_setprio(0); } while (0)
#define PG8_WAIT_V(n) asm volatile("s_waitcnt vmcnt(" #n ")" ::: "memory")
#define PG8_WAIT_L(n) asm volatile("s_waitcnt lgkmcnt(" #n ")" ::: "memory")
#define PG8_BAR __builtin_amdgcn_s_barrier()
#define PG8_SCHED __builtin_amdgcn_sched_barrier(0)
    Unit cur, nxt; int ui = 0;
    if (!S.next(0, cur)) return;
    f32x4 acc[2][2][4][2];
#pragma unroll
    for (int a = 0; a < 2; ++a)
#pragma unroll
        for (int b = 0; b < 2; ++b)
#pragma unroll
            for (int m = 0; m < 4; ++m)
#pragma unroll
                for (int n = 0; n < 2; ++n) acc[a][b][m][n] = (f32x4){0.f, 0.f, 0.f, 0.f};
    bf16x8 At[4][2], B0[2][2], B1[2][2];
    const char* cA = (const char*)g.A + (size_t)cur.pm * tstep; const char* cB = (const char*)g.Bt + (size_t)cur.pn * tstep;
    S.a_ready(cur);
    if constexpr (SP2) {
        PG8_STAGE(PG8_SB(0, 0), cB, voffB); PG8_STAGE(PG8_SB(0, 1), cB + hstep, voffB); PG8_STAGE(PG8_SA(0, 0), cA, voffA); PG8_STAGE(PG8_SA(0, 1), cA + hstep, voffA);
        if (wr == 1) PG8_BAR;
        PG8_WAIT_V(2); PG8_BAR;
        PG8_STAGE(PG8_SB(1, 0), cB + kstep, voffB); PG8_STAGE(PG8_SA(1, 0), cA + kstep, voffA); PG8_STAGE(PG8_SB(1, 1), cB + hstep + kstep, voffB);
        PG8_WAIT_V(6); PG8_BAR;
    } else {
        PG8_STAGE(PG8_SB(0, 0), cB, voffB); PG8_STAGE(PG8_SA(0, 0), cA, voffA); PG8_STAGE(PG8_SB(0, 1), cB + hstep, voffB); PG8_STAGE(PG8_SA(0, 1), cA + hstep, voffA);
        if (wr == 1) PG8_BAR;
        PG8_WAIT_V(4); PG8_BAR;
        PG8_STAGE(PG8_SB(1, 0), cB + kstep, voffB); PG8_STAGE(PG8_SA(1, 0), cA + kstep, voffA); PG8_STAGE(PG8_SB(1, 1), cB + hstep + kstep, voffB);
        PG8_WAIT_V(6); PG8_BAR;
    }
    for (;;) {
        const bool has_next = S.next(ui + 1, nxt);
        const char* nA = has_next ? (const char*)g.A + (size_t)nxt.pm * tstep : cA; const char* nB = has_next ? (const char*)g.Bt + (size_t)nxt.pn * tstep : cB;
        for (int t = 0; t < nt; t += 2) {
            const bool last = (t == nt - 2);
            const char* a1 = cA + (size_t)(t + 1) * kstep;
            const char* a2 = last ? nA : cA + (size_t)(t + 2) * kstep; const char* b2 = last ? nB : cB + (size_t)(t + 2) * kstep;
            const char* a3 = a2 + kstep; const char* b3 = b2 + kstep;
            if (last && has_next) S.a_ready(nxt);
            if constexpr (SP2) {
            PG8_LDB(B0, 0, 0); PG8_LDB(B1, 0, 1); PG8_SCHED; PG8_LDA(At, 0, 0); PG8_STAGE(PG8_SA(1, 1), a1 + hstep, voffA);
            PG8_WAIT_V(8); PG8_WAIT_L(0); PG8_BAR; PG8_MMA(0, 0, At, B0); PG8_MMA(0, 1, At, B1); PG8_BAR; PG8_SCHED;
            PG8_LDA(At, 0, 1); PG8_STAGE(PG8_SB(0, 0), b2, voffB); PG8_STAGE(PG8_SB(0, 1), b2 + hstep, voffB); PG8_STAGE(PG8_SA(0, 0), a2, voffA);
            PG8_WAIT_V(8); PG8_WAIT_L(0); PG8_BAR; PG8_MMA(1, 0, At, B0); PG8_MMA(1, 1, At, B1); PG8_BAR; PG8_SCHED;
            PG8_LDB(B0, 1, 0); PG8_LDB(B1, 1, 1); PG8_SCHED; PG8_LDA(At, 1, 0); PG8_STAGE(PG8_SA(0, 1), a2 + hstep, voffA);
            PG8_WAIT_V(8); PG8_WAIT_L(0); PG8_BAR; PG8_MMA(0, 0, At, B0); PG8_MMA(0, 1, At, B1); PG8_BAR; PG8_SCHED;
            PG8_LDA(At, 1, 1); PG8_STAGE(PG8_SB(1, 0), b3, voffB); PG8_STAGE(PG8_SB(1, 1), b3 + hstep, voffB); PG8_STAGE(PG8_SA(1, 0), a3, voffA);
            PG8_WAIT_V(8); PG8_WAIT_L(0); PG8_BAR; PG8_MMA(1, 0, At, B0); PG8_MMA(1, 1, At, B1); PG8_BAR; PG8_SCHED;
            } else {
            PG8_LDB(B0, 0, 0); PG8_SCHED; PG8_LDA(At, 0, 0); PG8_STAGE(PG8_SA(1, 1), a1 + hstep, voffA);
            PG8_WAIT_L(8); PG8_BAR; PG8_WAIT_L(0); PG8_MMA(0, 0, At, B0); PG8_BAR; PG8_SCHED;
            PG8_LDB(B1, 0, 1); PG8_STAGE(PG8_SB(0, 0), b2, voffB);
            PG8_BAR; PG8_WAIT_L(0); PG8_MMA(0, 1, At, B1); PG8_BAR;
            PG8_LDA(At, 0, 1); PG8_STAGE(PG8_SA(0, 0), a2, voffA);
            PG8_BAR; PG8_WAIT_L(0); PG8_MMA(1, 0, At, B0); PG8_BAR; PG8_SCHED;
            PG8_STAGE(PG8_SB(0, 1), b2 + hstep, voffB);
            PG8_WAIT_V(6); PG8_BAR; PG8_MMA(1, 1, At, B1); PG8_BAR;
            PG8_LDB(B0, 1, 0); PG8_SCHED; PG8_LDA(At, 1, 0); PG8_STAGE(PG8_SA(0, 1), a2 + hstep, voffA);
            PG8_WAIT_L(8); PG8_BAR; PG8_WAIT_L(0); PG8_MMA(0, 0, At, B0); PG8_BAR; PG8_SCHED;
            PG8_LDB(B1, 1, 1); PG8_STAGE(PG8_SB(1, 0), b3, voffB);
            PG8_BAR; PG8_WAIT_L(0); PG8_MMA(0, 1, At, B1); PG8_BAR;
            PG8_LDA(At, 1, 1); PG8_STAGE(PG8_SA(1, 0), a3, voffA);
            PG8_BAR; PG8_WAIT_L(0); PG8_MMA(1, 0, At, B0); PG8_BAR; PG8_SCHED;
            PG8_STAGE(PG8_SB(1, 1), b3 + hstep, voffB);
            PG8_WAIT_V(6); PG8_BAR; PG8_MMA(1, 1, At, B1); PG8_BAR;
            }
        }
        if constexpr (ALIGN_EPI) { if (wr == 0) PG8_BAR; }
        if constexpr (!Epi::AFTER_DRAIN) { E(acc, cur, wr, wc, fr, fq); S.done(cur); }
        if (!has_next) break;
#pragma unroll
        for (int a = 0; a < 2; ++a)
#pragma unroll
            for (int b = 0; b < 2; ++b)
#pragma unroll
                for (int m = 0; m < 4; ++m)
#pragma unroll
                    for (int n = 0; n < 2; ++n) acc[a][b][m][n] = (f32x4){0.f, 0.f, 0.f, 0.f};
        cur = nxt; cA = nA; cB = nB; ++ui;
        if constexpr (ALIGN_EPI) { if (wr == 1) PG8_BAR; }
    }
    PG8_WAIT_V(0);
    if constexpr (!ALIGN_EPI) { if (wr == 0) PG8_BAR; }
    PG8_BAR;
    if constexpr (Epi::AFTER_DRAIN) { E.fused(acc, cur, wr, wc, fr, fq, lds, wid, lane); S.done(cur); }
#undef PG8_SA
#undef PG8_SB
#undef PG8_STAGE
#undef PG8_LDA
#undef PG8_LDB
#undef PG8_MMA
#undef PG8_WAIT_V
#undef PG8_WAIT_L
#undef PG8_BAR
#undef PG8_SCHED
}
}

#define GAS __attribute__((address_space(1)))
#define LAS __attribute__((address_space(3)))
typedef unsigned short bf16;
typedef unsigned v4u __attribute__((ext_vector_type(4)));
typedef unsigned v2u __attribute__((ext_vector_type(2)));
typedef float f32x4 __attribute__((ext_vector_type(4)));
typedef float f32x16 __attribute__((ext_vector_type(16)));
typedef short bf16x8 __attribute__((ext_vector_type(8)));
typedef short s16x4 __attribute__((ext_vector_type(4)));

constexpr int NWAVES = 8, NTHR = 512;
constexpr int DM = 2048, SEQ = 8192, NB = 128, NT = 4, MROWS = 8704, MS0 = 8192;
constexpr int N0 = 6656, N1 = 5648, N1P = 5632;
constexpr int W0_AB = 0, W0_AC = 1024, W0_AH = 2048, W0_AG = 3072;
constexpr int C0_S = 0, C0_T = 1024, C0_Q = 4096, C0_K = 5120, C0_V = 5376, C0_G = 5632;
constexpr int W1_U = 0, W1_V = 1024, W1_CG = 2048;
constexpr int C1_UC = 0, C1_V = 1024, C1_Z = 3072, C1_X = 4096, C1_B = 5120, C1_C = 5376, C1_DT = 5632;
constexpr float EPS = 1e-6f, LOG2E = 1.4426950408889634f, QSCALE = 0.125f * 1.4426950408889634f, NEGBIG = -1e30f;
constexpr size_t O_YP = 0, O_YS = O_YP + 8192ull * 2048, O_PCA = O_YS + 512ull * 2048, O_SCA = O_PCA + 2048, O_PWK = O_SCA + 128ull * 2048,
                 O_PWV = O_PWK + 128ull * 256, O_SWK = O_PWV + 128ull * 256, O_SWV = O_SWK + 128ull * 128 * 256, O_SCV = O_SWV + 128ull * 128 * 256,
                 O_PCD = O_SCV + 128ull * 4 * 1024, O_SCD = O_PCD + 3 * 1536, O_PSSM = O_SCD + 128ull * 3 * 1536, O_SSSM = O_PSSM + 131072, O_END = O_SSSM + 128ull * 131072;
static_assert(O_END == 44571136ull, "output size");
constexpr size_t MiB = 1u << 20;
constexpr size_t WS_CTL = 0, CTL_ZERO_BYTES = 64 * 1024;
constexpr size_t WS_WT0 = 1 * MiB;
constexpr size_t WS_HB = WS_WT0;
constexpr size_t WS_WO0 = WS_WT0 + (size_t)N0 * DM * 2;
constexpr size_t WS_WT1 = WS_WO0 + (size_t)DM * DM * 2;
constexpr size_t WS_WO1 = WS_WT1 + (size_t)N1P * DM * 2;
constexpr size_t WS_TRIL = WS_WO1 + (size_t)DM * DM * 2;
constexpr size_t WS_H = WS_TRIL + 8 * 128 * 128 * 2;
constexpr size_t WS_Z = WS_H + (size_t)MROWS * DM * 2;
constexpr size_t WS_Y = WS_Z + (size_t)MROWS * N0 * 2;
constexpr size_t WS_CS = WS_Y;
constexpr size_t WS_XA = WS_Y + (size_t)MROWS * DM * 2;
constexpr size_t WS_DTR = WS_XA + (size_t)SEQ * 1536 * 2;
constexpr size_t WS_ACS = WS_DTR + (size_t)MROWS * 16 * 4;
constexpr size_t WS_DTV = WS_ACS + (size_t)SEQ * 16 * 4;
constexpr size_t WS_CD = WS_DTV + (size_t)SEQ * 16 * 4;
constexpr size_t WS_VST = WS_CD + 64 * 16 * 4;
constexpr size_t WS_RS0 = WS_ACS;
constexpr size_t WS_RS1 = WS_VST + (size_t)SEQ * 2 * 4;
constexpr size_t WS_PT = WS_RS1 + (size_t)MROWS * 4 + 192;
constexpr size_t WS_WDT = WS_XA;
constexpr size_t WS_BIAST = WS_WDT + 128 * 1024;
constexpr size_t WS_PS = WS_ACS;
constexpr size_t WS_VSP = WS_PT;
constexpr int TSPLIT = 4;
constexpr size_t WS_END = WS_PT + (size_t)TSPLIT * 512 * 2048 * 4;
static_assert(WS_END <= 290ull * MiB, "workspace map");
static_assert((size_t)64 * 16 * 64 * 128 * 4 <= (size_t)MROWS * DM * 2, "CS fits in Y");
constexpr int CW_BAR = 4096, CW_FILL = 8192, CW_TAIL0 = 8256, CW_TAIL1 = 8320, CW_PANEL0 = 8448, CW_PANEL1 = CW_PANEL0 + 64 * 32;
static_assert((CW_PANEL1 + 64 * 32) * 4 <= (int)CTL_ZERO_BYTES && (CW_BAR + 3456) * 4 <= (int)CTL_ZERO_BYTES, "control words inside the zeroed region");
constexpr int LDS_BYTES = 147456, LDS_CTL_OFF = 147200;

#define RLX_AGENT __ATOMIC_RELAXED, __HIP_MEMORY_SCOPE_AGENT
__device__ __forceinline__ unsigned f2bf(float f) { unsigned u = __builtin_bit_cast(unsigned, f); return (u + 0x7fffu + ((u >> 16) & 1u)) >> 16; }
typedef float f32x2_t __attribute__((ext_vector_type(2))); typedef __bf16 bf16x2_t __attribute__((ext_vector_type(2)));
__device__ __forceinline__ unsigned pk2(float lo, float hi) { f32x2_t v = {lo, hi}; bf16x2_t b = __builtin_convertvector(v, bf16x2_t); return __builtin_bit_cast(unsigned, b); }
__device__ __forceinline__ float bflo(unsigned w) { return __uint_as_float(w << 16); }
__device__ __forceinline__ float bfhi(unsigned w) { return __uint_as_float(w & 0xffff0000u); }
__device__ __forceinline__ float bf1(bf16 b) { return __uint_as_float((unsigned)b << 16); }
#define UNPACK8(v, f) do { f[0] = bflo(v.x); f[1] = bfhi(v.x); f[2] = bflo(v.y); f[3] = bfhi(v.y); f[4] = bflo(v.z); f[5] = bfhi(v.z); f[6] = bflo(v.w); f[7] = bfhi(v.w); } while (0)
__device__ __forceinline__ v4u pack8(const float* f) { v4u o; o.x = pk2(f[0], f[1]); o.y = pk2(f[2], f[3]); o.z = pk2(f[4], f[5]); o.w = pk2(f[6], f[7]); return o; }
__device__ __forceinline__ float silu(float x) { return x * __builtin_amdgcn_rcpf(1.f + __expf(-x)); }
#define DPPF(v, ctrl) __builtin_bit_cast(float, __builtin_amdgcn_update_dpp(0, __builtin_bit_cast(int, (v)), (ctrl), 0xf, 0xf, true))
__device__ __forceinline__ float row16_sum(float v) { v += DPPF(v, 0xB1); v += DPPF(v, 0x4E); v += DPPF(v, 0x141); v += DPPF(v, 0x140); return v; }
__device__ __forceinline__ float row16_max(float v) { v = fmaxf(v, DPPF(v, 0xB1)); v = fmaxf(v, DPPF(v, 0x4E)); v = fmaxf(v, DPPF(v, 0x141)); v = fmaxf(v, DPPF(v, 0x140)); return v; }
__device__ __forceinline__ float wave_sum(float v) { v = row16_sum(v);
    { auto r = __builtin_amdgcn_permlane16_swap(__float_as_uint(v), __float_as_uint(v), false, false); v = __uint_as_float(r[0]) + __uint_as_float(r[1]); }
    { auto r = __builtin_amdgcn_permlane32_swap(__float_as_uint(v), __float_as_uint(v), false, false); v = __uint_as_float(r[0]) + __uint_as_float(r[1]); }
    return v; }
__device__ __forceinline__ float wave_max(float v) { v = row16_max(v);
    { auto r = __builtin_amdgcn_permlane16_swap(__float_as_uint(v), __float_as_uint(v), false, false); v = fmaxf(__uint_as_float(r[0]), __uint_as_float(r[1])); }
    { auto r = __builtin_amdgcn_permlane32_swap(__float_as_uint(v), __float_as_uint(v), false, false); v = fmaxf(__uint_as_float(r[0]), __uint_as_float(r[1])); }
    return v; }
__device__ __forceinline__ float half_sum(float v) { auto r = __builtin_amdgcn_permlane32_swap(__float_as_uint(v), __float_as_uint(v), false, false); return __uint_as_float(r[0]) + __uint_as_float(r[1]); }
__device__ __forceinline__ float half_max(float v) { auto r = __builtin_amdgcn_permlane32_swap(__float_as_uint(v), __float_as_uint(v), false, false); return fmaxf(__uint_as_float(r[0]), __uint_as_float(r[1])); }
__device__ __forceinline__ int crow(int r, int hi) { return (r & 3) + 8 * (r >> 2) + 4 * hi; }
#define MFMA32(a, b, c) __builtin_amdgcn_mfma_f32_32x32x16_bf16((a), (b), (c), 0, 0, 0)
__device__ __forceinline__ bf16x8 pack_frag(const f32x16& x, int s) {
    v4u p; p.x = pk2(x[8 * s + 0], x[8 * s + 1]); p.y = pk2(x[8 * s + 2], x[8 * s + 3]); p.z = pk2(x[8 * s + 4], x[8 * s + 5]); p.w = pk2(x[8 * s + 6], x[8 * s + 7]);
    return __builtin_bit_cast(bf16x8, p);
}
__device__ __forceinline__ bf16x8 frag_from_f32(const float* p) {
    const f32x4 a = *(const f32x4*)p, b = *(const f32x4*)(p + 4);
    v4u o; o.x = pk2(a[0], a[1]); o.y = pk2(a[2], a[3]); o.z = pk2(b[0], b[1]); o.w = pk2(b[2], b[3]);
    return __builtin_bit_cast(bf16x8, o);
}

typedef short v4i16_t __attribute__((ext_vector_type(4)));
__device__ __forceinline__ bf16x8 tr_frag(const LAS unsigned char* base, int pitch, int row0, int col0, int rstep, int lane) {
    const int h = lane >> 5, q = (lane & 15) >> 2, pp = lane & 3, cg = (lane >> 4) & 1;
    const LAS unsigned char* p = base + (row0 + 4 * h + q) * pitch + (col0 + 16 * cg + 4 * pp) * 2;
    const s16x4 a = __builtin_bit_cast(s16x4, __builtin_amdgcn_ds_read_tr16_b64_v4i16((LAS v4i16_t*)p));
    const s16x4 b = __builtin_bit_cast(s16x4, __builtin_amdgcn_ds_read_tr16_b64_v4i16((LAS v4i16_t*)(p + rstep * pitch)));
    return (bf16x8){a[0], a[1], a[2], a[3], b[0], b[1], b[2], b[3]};
}
__device__ __forceinline__ bf16x8 tr_frag_nat(const LAS unsigned char* base, int pitch, int row0, int col0, int lane) {
    return tr_frag(base, pitch, row0 + 4 * (lane >> 5), col0, 4, lane);
}

#define XB_TMO      128
#define XB_XCNT(j)  (256  + 64 * (j))
#define XB_XSUB(j)  (1280 + 64 * (j))
#define XB_XGEN(j)  (2304 + 64 * (j))
#define XB_TOP      3328
#define XB_TOPGEN   3392
#define XCD_BAR_WORDS 3456
#define XB_SPIN_CAP (1u << 18)
__device__ __forceinline__ unsigned xb_ld(unsigned* p)              { return __hip_atomic_load(p, __ATOMIC_RELAXED, __HIP_MEMORY_SCOPE_AGENT); }
__device__ __forceinline__ unsigned xb_add(unsigned* p, unsigned v) { return __hip_atomic_fetch_add(p, v, __ATOMIC_RELAXED, __HIP_MEMORY_SCOPE_AGENT); }
__device__ __forceinline__ unsigned xb_xcc_id() { return (unsigned)__builtin_amdgcn_s_getreg((3 << 11) | 20) & 0xFu; }
#define XB_SPIN(cond, bar) do { unsigned _sp = 0; while (cond) { __builtin_amdgcn_s_sleep(1); \
    if ((++_sp & 255u) == 0u) { if (xb_ld(&(bar)[XB_TMO])) break; if (_sp > XB_SPIN_CAP) { atomicAdd(&(bar)[XB_TMO], 1u); break; } } } } while (0)
struct XcdBarrier { unsigned* bar; unsigned x; volatile LAS unsigned* st; };
__device__ __forceinline__ XcdBarrier xcd_barrier_post(unsigned* bar, volatile LAS unsigned* st) {
    XcdBarrier b; b.bar = bar; b.x = xb_xcc_id(); b.st = st;
    if (threadIdx.x == 0) (void)xb_add(&bar[XB_XCNT(b.x)], 1u);
    return b;
}
__device__ __forceinline__ void xcd_barrier_complete(unsigned* bar, unsigned x, unsigned& nloc, unsigned& nx) {
    const unsigned G = gridDim.x * gridDim.y * gridDim.z;
    unsigned sum, cnt, mine, sp = 0u;
    for (;;) {
        sum = 0u; cnt = 0u; mine = 0u;
#pragma unroll
        for (unsigned j = 0; j < 16; ++j) { const unsigned c = xb_ld(&bar[XB_XCNT(j)]); sum += c; cnt += (c > 0u) ? 1u : 0u; mine = (j == x) ? c : mine; }
        if (sum == G) break;
        __builtin_amdgcn_s_sleep(1);
        if ((++sp & 255u) == 0u) { if (xb_ld(&bar[XB_TMO])) break; if (sp > XB_SPIN_CAP) { atomicAdd(&bar[XB_TMO], 1u); break; } }
    }
    nloc = mine > 0u ? mine : 1u; nx = cnt > 0u ? cnt : 1u;
}
__device__ __forceinline__ void xcd_barrier(const XcdBarrier& b) {
    asm volatile("s_waitcnt vmcnt(0)" ::: "memory");
    __syncthreads();
    if (threadIdx.x == 0) {
        unsigned* bar = b.bar;
        __builtin_amdgcn_s_waitcnt(0);
        unsigned nloc = b.st[0], nx = b.st[1];
        if (nloc == 0u) { xcd_barrier_complete(bar, b.x, nloc, nx); b.st[0] = nloc; b.st[1] = nx; }
        const unsigned old = xb_add(&bar[XB_XSUB(b.x)], 1u);
        const unsigned gen = old / nloc;
        if (old + 1u == (gen + 1u) * nloc) {
            __builtin_amdgcn_fence(__ATOMIC_RELEASE, "agent");
            asm volatile("s_waitcnt vmcnt(0)" ::: "memory");
            const unsigned og = xb_add(&bar[XB_TOP], 1u);
            const unsigned tg = og / nx;
            if (og + 1u == (tg + 1u) * nx) xb_add(&bar[XB_TOPGEN], 1u);
            else XB_SPIN(xb_ld(&bar[XB_TOPGEN]) == tg, bar);
            __builtin_amdgcn_fence(__ATOMIC_ACQUIRE, "agent");
            xb_add(&bar[XB_XGEN(b.x)], 1u);
            asm volatile("s_waitcnt vmcnt(0)" ::: "memory");
        } else {
            XB_SPIN(xb_ld(&bar[XB_XGEN(b.x)]) == gen, bar);
            __builtin_amdgcn_fence(__ATOMIC_ACQUIRE, "agent");
            asm volatile("s_waitcnt vmcnt(0)" ::: "memory");
        }
    }
    __syncthreads();
}

__device__ __forceinline__ void group_arrive(unsigned* ctr) {
    asm volatile("s_waitcnt vmcnt(0)" ::: "memory");
    __syncthreads();
    if (threadIdx.x == 0) { __builtin_amdgcn_fence(__ATOMIC_RELEASE, "agent"); asm volatile("s_waitcnt vmcnt(0)" ::: "memory"); (void)xb_add(ctr, 1u); }
}
__device__ __forceinline__ void group_arrive_wt(unsigned* ctr) {
    asm volatile("s_waitcnt vmcnt(0)" ::: "memory");
    __syncthreads();
    if (threadIdx.x == 0) (void)xb_add(ctr, 1u);
}
__device__ __forceinline__ v4u ld16_sc1(const void* p) {
    const unsigned long long* q = (const unsigned long long*)p;
    const unsigned long long a = __hip_atomic_load(q, __ATOMIC_RELAXED, __HIP_MEMORY_SCOPE_AGENT), b = __hip_atomic_load(q + 1, __ATOMIC_RELAXED, __HIP_MEMORY_SCOPE_AGENT);
    v4u r; r.x = (unsigned)a; r.y = (unsigned)(a >> 32); r.z = (unsigned)b; r.w = (unsigned)(b >> 32); return r;
}
__device__ __forceinline__ void group_wait_na(unsigned* ctr, unsigned want) {
    if (threadIdx.x == 0) { unsigned sp = 0; while (xb_ld(ctr) < want) { __builtin_amdgcn_s_sleep(2); if (++sp > (1u << 22)) break; } }
    __syncthreads();
}
__device__ __forceinline__ void group_wait(unsigned* ctr, unsigned want) {
    if (threadIdx.x == 0) { unsigned sp = 0; while (xb_ld(ctr) < want) { __builtin_amdgcn_s_sleep(2); if (++sp > (1u << 22)) break; }
        __builtin_amdgcn_fence(__ATOMIC_ACQUIRE, "agent"); asm volatile("s_waitcnt vmcnt(0)" ::: "memory"); }
    __syncthreads();
}

#ifdef DELAY_REG
#define REG_BEGIN(id) unsigned long long t0_##id = 0; if ((id) == DELAY_REG && blockIdx.x == DELAY_WG && threadIdx.x == 0) t0_##id = __builtin_amdgcn_s_memrealtime();
#define REG_END(id) if ((id) == DELAY_REG && blockIdx.x == DELAY_WG && threadIdx.x == 0) { const unsigned long long t1_ = __builtin_amdgcn_s_memrealtime(), d_ = t1_ - t0_##id; while (__builtin_amdgcn_s_memrealtime() < t1_ + d_) __builtin_amdgcn_s_sleep(8); }
#else
#define REG_BEGIN(id)
#define REG_END(id)
#endif
struct Args { const float* in[28]; float* out; unsigned char* ws; int ph_lo, ph_hi; };

struct Frame {
    LAS unsigned char* lds;
    int tid, lane, wave, G, bid;
    const float* in[28];
    float* out; unsigned char* ws;
};
#define WSP(T, off) ((T*)(F.ws + (off)))
#define LDSP(T, off) ((LAS T*)(F.lds + (off)))

__device__ __forceinline__ void tile64_load(const float* W, int N, int k0, int n0, int lane, f32x4 (&v)[16]) {
    const int kr = lane >> 4, nc = 4 * (lane & 15);
#pragma unroll
    for (int i = 0; i < 16; ++i) v[i] = __builtin_nontemporal_load((const f32x4*)(W + (size_t)(k0 + 4 * i + kr) * N + n0 + nc));
}
__device__ __forceinline__ void tile64_finish(const f32x4 (&v)[16], bf16* WT, LAS float* scr, int k0, int n0, int d0, int lane, int sc_lo, int sc_hi, float sc, const float* kg = nullptr) {
    const int kr = lane >> 4, nc = 4 * (lane & 15);
#pragma unroll
    for (int i = 0; i < 16; ++i) *(LAS f32x4*)(scr + (4 * i + kr) * 68 + nc) = v[i];
    asm volatile("s_waitcnt lgkmcnt(0)" ::: "memory");
    const int n = n0 + lane; const float mul = (n >= sc_lo && n < sc_hi) ? sc : 1.f;
#pragma unroll
    for (int c = 0; c < 8; ++c) { float f[8];
#pragma unroll
        for (int i = 0; i < 8; ++i) f[i] = scr[(8 * c + i) * 68 + lane] * mul;
        if (kg != nullptr) { const f32x4 g0 = *(const f32x4*)(kg + k0 + 8 * c), g1 = *(const f32x4*)(kg + k0 + 8 * c + 4);
#pragma unroll
            for (int i = 0; i < 4; ++i) { f[i] *= g0[i]; f[4 + i] *= g1[i]; } }
        *(v4u*)(WT + (size_t)(d0 + lane) * DM + k0 + 8 * c) = pack8(f); }
    asm volatile("s_waitcnt lgkmcnt(0)" ::: "memory");
}
__device__ __forceinline__ void transpose_tile64(const float* W, int N, bf16* WT, LAS float* scr, int k0, int n0, int d0, int lane, int sc_lo, int sc_hi, float sc, const float* kg = nullptr) {
    f32x4 v[16]; tile64_load(W, N, k0, n0, lane, v); tile64_finish(v, WT, scr, k0, n0, d0, lane, sc_lo, sc_hi, sc, kg);
}
__device__ __forceinline__ void rms_row_load(const float* xrow, int lane, f32x4 (&v)[8]) {
#pragma unroll
    for (int j = 0; j < 4; ++j) { v[2 * j] = __builtin_nontemporal_load((const f32x4*)(xrow + 512 * j + 8 * lane)); v[2 * j + 1] = __builtin_nontemporal_load((const f32x4*)(xrow + 512 * j + 8 * lane + 4)); }
}
__device__ __forceinline__ void rms_row_finish(const f32x4 (&v)[8], float* rs_out, bf16* orow, int lane) {
    float s = 0.f;
#pragma unroll
    for (int j = 0; j < 8; ++j) s += (v[j][0] * v[j][0] + v[j][1] * v[j][1]) + (v[j][2] * v[j][2] + v[j][3] * v[j][3]);
    const float rstd = rsqrtf(wave_sum(s) * (1.f / DM) + EPS);
#pragma unroll
    for (int j = 0; j < 4; ++j) { const f32x4 a = v[2 * j], b = v[2 * j + 1];
        v4u o; o.x = pk2(a[0], a[1]); o.y = pk2(a[2], a[3]); o.z = pk2(b[0], b[1]); o.w = pk2(b[2], b[3]);
        *(v4u*)(orow + 512 * j + 8 * lane) = o; }
    if (lane == 0) *rs_out = rstd;
}
__device__ __forceinline__ const float* xrow_ptr(const Frame& F, int m) { return m < MS0 ? F.in[0] + (size_t)m * DM : F.in[1] + (size_t)(m - MS0) * DM; }

__device__ __forceinline__ void w0_tile_coords(int it, int& k0, int& src, int& dst) {
    const int db = it % (N0 / 64), j = db >> 2, q = db & 3;
    k0 = 64 * (it / (N0 / 64)); dst = 64 * db; src = db < 64 ? (q == 0 ? W0_AC : q == 1 ? W0_AB : q == 2 ? W0_AH : W0_AG) + 64 * j : 64 * db;
}
__device__ __forceinline__ int rel_bucket(int d);
__device__ __forceinline__ void p0_prologue(Frame& F) {
    LAS float* scr = LDSP(float, F.wave * 17408);
    const int gw = F.bid * NWAVES + F.wave, NGW = F.G * NWAVES, lane = F.lane;
    constexpr int NTILE = 32 * (N0 / 64);
    f32x4 tv[16], rv[8];
    const int ti = F.bid * NTHR + F.tid; float trv = 0.f; if (ti < 8 * 128 * 128) trv = F.in[18][ti];
    float bv = 0.f; if (ti >= 8192 && ti < 8192 + 2048) { const int i = ti - 8192; bv = F.in[7][rel_bucket(i & 127) * 16 + (i >> 7)]; }
    f32x4 wdv = (f32x4){0.f, 0.f, 0.f, 0.f}; if (ti < 8192) wdv = *(const f32x4*)(F.in[15] + C1_DT + (size_t)(ti >> 2) * N1 + 4 * (ti & 3));
    int it = gw, r = NGW - 1 - gw, k0 = 0, src = 0, dst = 0;
    if (it < NTILE) { w0_tile_coords(it, k0, src, dst); tile64_load(F.in[9], N0, k0, src, lane, tv); }
    if (r < MROWS) rms_row_load(xrow_ptr(F, r), lane, rv);
    while (it < NTILE) {
        f32x4 cur[16];
#pragma unroll
        for (int i = 0; i < 16; ++i) cur[i] = tv[i];
        const int ck0 = k0, csrc = src, cdst = dst;
        it += NGW;
        if (it < NTILE) { w0_tile_coords(it, k0, src, dst); tile64_load(F.in[9], N0, k0, src, lane, tv); }
        tile64_finish(cur, WSP(bf16, WS_WT0), scr, ck0, csrc, cdst, lane, C0_Q, C0_K, QSCALE, F.in[8]);
    }
    while (r < MROWS) {
        f32x4 cur[8];
#pragma unroll
        for (int i = 0; i < 8; ++i) cur[i] = rv[i];
        const int cr = r; r += NGW;
        if (r < MROWS) rms_row_load(xrow_ptr(F, r), lane, rv);
        rms_row_finish(cur, WSP(float, WS_RS0) + cr, WSP(bf16, WS_H) + (size_t)cr * DM, lane);
    }
    if (ti >= 8192 && ti < 8192 + 2048) WSP(float, WS_BIAST)[ti - 8192] = bv * LOG2E;
    if (ti < 8192) { const int k = ti >> 2, c4 = ti & 3, j = k >> 9, l = (k >> 3) & 63, i = k & 7; *(f32x4*)(WSP(float, WS_WDT) + 4 * ((((j * 8 + i) * 4 + c4) * 64) + l)) = wdv; }
    if (ti < 8 * 128 * 128) { const int t = (ti >> 7) & 127, s = ti & 127; WSP(bf16, WS_TRIL)[ti] = (bf16)f2bf(s <= t ? trv : 0.f); }
    for (int i = ti + F.G * NTHR; i < 8 * 128 * 128; i += F.G * NTHR) { const int t = (i >> 7) & 127, s = i & 127; WSP(bf16, WS_TRIL)[i] = (bf16)f2bf(s <= t ? F.in[18][i] : 0.f); }
}
constexpr int FI_WO0 = 0, FI_WT1 = FI_WO0 + 32 * 32 / 8, FI_WO1 = FI_WT1 + 32 * (N1P / 64) / 8, FI_CACHE = FI_WO1 + 32 * 32 / 8, FI_TRIL = FI_CACHE + 0, FI_END = FI_TRIL;
__device__ __forceinline__ void filler_item(Frame& F, int idx) {
    LAS float* scr = LDSP(float, F.wave * 17408);
    if (idx < FI_WT1) { const int t = (idx - FI_WO0) * 8 + F.wave; transpose_tile64(F.in[12], DM, WSP(bf16, WS_WO0), scr, 64 * (t / 32), 64 * (t % 32), 64 * (t % 32), F.lane, 0, 0, 1.f); }
    else if (idx < FI_WO1) { const int t = (idx - FI_WT1) * 8 + F.wave; const int db = t % (N1P / 64);
        const int src = db < 32 ? ((db & 2) ? W1_CG : W1_U) + 128 * (db >> 2) + 64 * (db & 1) : db < 48 ? W1_V + 64 * (db - 32) : 64 * db;
        transpose_tile64(F.in[15], N1, WSP(bf16, WS_WT1), scr, 64 * (t / (N1P / 64)), src, 64 * db, F.lane, 0, 0, 1.f, F.in[14]); }
    else if (idx < FI_CACHE) { const int t = (idx - FI_WO1) * 8 + F.wave; transpose_tile64(F.in[26], DM, WSP(bf16, WS_WO1), scr, 64 * (t / 32), 64 * (t % 32), 64 * (t % 32), F.lane, 0, 0, 1.f); }
    else if (idx < FI_TRIL) {
        const int c = idx - FI_CACHE, b = c >> 1; const f32x4* src = (const f32x4*)((c & 1) ? F.in[4] : F.in[3]) + (size_t)b * 128 * 64 + 4 * 64; f32x4* dst = (f32x4*)(F.out + ((c & 1) ? O_SWV : O_SWK)) + (size_t)b * 128 * 64;
#pragma unroll 4
        for (int i = F.tid; i < 124 * 64; i += NTHR) __builtin_nontemporal_store(__builtin_nontemporal_load(src + i), dst + i);
    }
}
__device__ __forceinline__ void filler_loop(Frame& F) {
    volatile LAS int* flag = (volatile LAS int*)(F.lds + LDS_CTL_OFF + 192);
    for (;;) {
        if (F.tid == 0) *flag = (int)__hip_atomic_fetch_add((unsigned*)(F.ws + WS_CTL) + CW_FILL, 1u, __ATOMIC_RELAXED, __HIP_MEMORY_SCOPE_AGENT);
        __syncthreads();
        const int idx = *flag;
        __syncthreads();
#ifdef PROBE_FILL2
        if (idx >= 2 * FI_END) break;
        filler_item(F, idx >= FI_END ? idx - FI_END : idx);
#else
        if (idx >= FI_END) break;
        filler_item(F, idx);
#endif
    }
}

__device__ __forceinline__ int rel_bucket(int d) {
    if (d < 16) return d;
    const int large = 16 + (int)(logf((float)d * (1.f / 16.f)) / logf(8.f) * 16.f);
    return large < 31 ? large : 31;
}
constexpr int L2_BIAS = 0;
constexpr int L2_K = 8192;
constexpr int L2_VT = L2_K + 256 * 144;
constexpr int L2_SK = 8192;
constexpr int L2_SVT = L2_SK + 2 * 160 * 144;
static_assert(L2_VT + 256 * 144 <= LDS_CTL_OFF && L2_SVT + 2 * 160 * 144 <= LDS_CTL_OFF, "P2 LDS");

__device__ __forceinline__ void attn_core(Frame& F, const bf16x8 (&qf)[4], int k_off, int v_off, int kt0, const LAS float* biasd, float sink2, bool first_block,
                                          f32x16& o0, f32x16& o1, float& inv) {
    const int lane = F.lane, l31 = lane & 31, hl = lane >> 5;
    f32x16 S[5];
#pragma unroll
    for (int k5 = 0; k5 < 5; ++k5) {
        f32x16 acc = {};
        const LAS unsigned char* kp = F.lds + k_off + (32 * (kt0 + k5) + l31) * 144 + 16 * hl;
#pragma unroll
        for (int ks = 0; ks < 4; ++ks) { const bf16x8 a = *(const LAS bf16x8*)(kp + 32 * ks); acc = MFMA32(a, qf[ks], acc); }
        S[k5] = acc;
    }
    float mx = NEGBIG;
#pragma unroll
    for (int k5 = 0; k5 < 5; ++k5)
#pragma unroll
        for (int r = 0; r < 16; ++r) {
            const int cr = crow(r, hl), dist = 128 - 32 * k5 + l31 - cr, j = 32 * (kt0 + k5) + cr;
            const bool valid = (dist >= 0) && (dist < 128) && (!first_block || j >= 128);
            const float b = biasd[dist & 127];
            const float s = valid ? S[k5][r] + b : NEGBIG;
            S[k5][r] = s; mx = fmaxf(mx, s);
        }
    mx = half_max(mx);
    mx = fmaxf(mx, sink2);
    float sum = 0.f;
#pragma unroll
    for (int k5 = 0; k5 < 5; ++k5)
#pragma unroll
        for (int r = 0; r < 16; ++r) { const float p = __builtin_amdgcn_exp2f(S[k5][r] - mx); S[k5][r] = p; sum += p; }
    sum = half_sum(sum);
    inv = __builtin_amdgcn_rcpf(sum + __builtin_amdgcn_exp2f(sink2 - mx));
    o0 = (f32x16){}; o1 = (f32x16){};
#pragma unroll
    for (int k5 = 0; k5 < 5; ++k5)
#pragma unroll
        for (int sp = 0; sp < 2; ++sp) {
            const bf16x8 pf = pack_frag(S[k5], sp);
            const int kb = 32 * (kt0 + k5) + 16 * sp;
            const bf16x8 A0 = tr_frag(F.lds + v_off, 144, kb, 0, 8, lane), A1 = tr_frag(F.lds + v_off, 144, kb, 32, 8, lane);
            o0 = MFMA32(A0, pf, o0); o1 = MFMA32(A1, pf, o1);
        }
}
constexpr int L2_EP = 100352;
static_assert(L2_EP + 8 * 4608 <= LDS_CTL_OFF, "P2 epilogue LDS");
__device__ __forceinline__ void attn_store(Frame& F, const f32x16& o0, const f32x16& o1, float inv, const bf16* grow, bf16* yrow, int nrows) {
    const int lane = F.lane, l31 = lane & 31, hl = lane >> 5;
    LAS unsigned char* tile = F.lds + L2_EP + F.wave * 4608;
    const int rr = lane >> 3, ch = lane & 7;
    v4u gv[4];
#pragma unroll
    for (int i = 0; i < 4; ++i) { const int r = 8 * i + rr; gv[i] = (r < nrows) ? *(const v4u*)(grow + (size_t)r * N0 + ch * 8) : (v4u){0u, 0u, 0u, 0u}; }
#pragma unroll
    for (int i = 0; i < 4; ++i) *(LAS v4u*)(tile + (8 * i + rr) * 144 + ch * 16) = gv[i];
#pragma unroll
    for (int dt = 0; dt < 2; ++dt)
#pragma unroll
        for (int q4 = 0; q4 < 4; ++q4) {
            const int d = 32 * dt + 8 * q4 + 4 * hl;
            LAS v2u* p = (LAS v2u*)(tile + l31 * 144 + d * 2);
            const v2u gz = *p;
            const float g0 = bflo(gz.x), g1 = bfhi(gz.x), g2 = bflo(gz.y), g3 = bfhi(gz.y);
            const float a = (dt ? o1[4 * q4 + 0] : o0[4 * q4 + 0]) * inv, b = (dt ? o1[4 * q4 + 1] : o0[4 * q4 + 1]) * inv,
                        c = (dt ? o1[4 * q4 + 2] : o0[4 * q4 + 2]) * inv, e = (dt ? o1[4 * q4 + 3] : o0[4 * q4 + 3]) * inv;
            v2u o; o.x = pk2(a * silu(g0), b * silu(g1)); o.y = pk2(c * silu(g2), e * silu(g3));
            *p = o;
        }
#pragma unroll
    for (int i = 0; i < 4; ++i) { const int r = 8 * i + rr; const v4u yv = *(const LAS v4u*)(tile + r * 144 + ch * 16); if (r < nrows) *(v4u*)(yrow + (size_t)r * DM + ch * 8) = yv; }
}

__device__ __forceinline__ void attn_prompt_unit(Frame& F, int n, int hk) {
    const bf16* Z = WSP(bf16, WS_Z); bf16* Y = WSP(bf16, WS_Y);
    const int tid = F.tid, lane = F.lane, w = F.wave, l31 = lane & 31, hl = lane >> 5;
#pragma unroll
    for (int i = 0; i < 4; ++i) {
        const int item = tid + 512 * i, key = item >> 3, ch = item & 7, pos = 128 * (n - 1) + key;
        v4u kv = (v4u){0u, 0u, 0u, 0u}, vv = (v4u){0u, 0u, 0u, 0u};
        if (pos >= 0) { kv = *(const v4u*)(Z + (size_t)pos * N0 + C0_K + hk * 64 + ch * 8); vv = *(const v4u*)(Z + (size_t)pos * N0 + C0_V + hk * 64 + ch * 8); }
        *(LAS v4u*)(F.lds + L2_K + key * 144 + ch * 16) = kv;
        *(LAS v4u*)(F.lds + L2_VT + key * 144 + ch * 16) = vv;
    }
    __syncthreads();
    const int g = w >> 1, head = hk * 4 + g;
    const float sink2 = F.in[11][head] * LOG2E;
    const LAS float* biasd = LDSP(float, L2_BIAS) + head * 128;
    for (int qq = 0; qq < 2; ++qq) {
        const int qt = 2 * (w & 1) + qq;
        const int pos_q = 128 * n + 32 * qt + l31;
        const bf16* qrow = Z + (size_t)pos_q * N0 + C0_Q + head * 64 + 8 * hl;
        bf16x8 qf[4];
#pragma unroll
        for (int ks = 0; ks < 4; ++ks) qf[ks] = *(const bf16x8*)(qrow + 16 * ks);
        f32x16 o0, o1; float inv;
        attn_core(F, qf, L2_K, L2_VT, qt, biasd, sink2, n == 0, o0, o1, inv);
        attn_store(F, o0, o1, inv, Z + (size_t)(pos_q - l31) * N0 + C0_G + head * 64, Y + (size_t)(pos_q - l31) * DM + 1024 + head * 64, 32);
    }
    __syncthreads();
}

__device__ __forceinline__ void attn_sample_unit(Frame& F, int b, int hp) {
    const bf16* Z = WSP(bf16, WS_Z); bf16* Y = WSP(bf16, WS_Y);
    const int tid = F.tid, lane = F.lane, w = F.wave, l31 = lane & 31, hl = lane >> 5;
    const float* ck = F.in[3]; const float* cv = F.in[4];
    const int h2 = w >> 2, head = (2 * hp + h2) * 4 + (w & 3);
    const size_t m = MS0 + 4 * b + (l31 & 3);
    bf16x8 qf[4];
    { const bf16* qrow = Z + m * N0 + C0_Q + head * 64 + 8 * hl;
#pragma unroll
      for (int ks = 0; ks < 4; ++ks) qf[ks] = *(const bf16x8*)(qrow + 16 * ks); }
    f32x4 kf[4][2], vf[4][2]; v4u kz = (v4u){0u, 0u, 0u, 0u}, vz = (v4u){0u, 0u, 0u, 0u};
#pragma unroll
    for (int u = 0; u < 4; ++u) { const int item = tid + NTHR * u, hh2 = item >> 10, r = item & 1023, key = r >> 3, ch = r & 7;
        const size_t off = ((size_t)(b * 128 + key) * 4 + 2 * hp + hh2) * 64 + ch * 8;
        kf[u][0] = __builtin_nontemporal_load((const f32x4*)(ck + off)); kf[u][1] = __builtin_nontemporal_load((const f32x4*)(ck + off + 4)); vf[u][0] = __builtin_nontemporal_load((const f32x4*)(cv + off)); vf[u][1] = __builtin_nontemporal_load((const f32x4*)(cv + off + 4)); }
    if (tid < 64) { const int hh2 = tid >> 5, r = tid & 31, key = 128 + (r >> 3), ch = r & 7;
        const bf16* zr = Z + (size_t)(MS0 + 4 * b + (key - 128)) * N0 + (2 * hp + hh2) * 64 + ch * 8; kz = *(const v4u*)(zr + C0_K); vz = *(const v4u*)(zr + C0_V); }
#pragma unroll
    for (int u = 0; u < 4; ++u) { const int item = tid + NTHR * u, hh2 = item >> 10, r = item & 1023, key = r >> 3, ch = r & 7;
        v4u kv, vv;
        kv.x = pk2(kf[u][0][0], kf[u][0][1]); kv.y = pk2(kf[u][0][2], kf[u][0][3]); kv.z = pk2(kf[u][1][0], kf[u][1][1]); kv.w = pk2(kf[u][1][2], kf[u][1][3]);
        vv.x = pk2(vf[u][0][0], vf[u][0][1]); vv.y = pk2(vf[u][0][2], vf[u][0][3]); vv.z = pk2(vf[u][1][0], vf[u][1][1]); vv.w = pk2(vf[u][1][2], vf[u][1][3]);
        *(LAS v4u*)(F.lds + L2_SK + (hh2 * 160 + key) * 144 + ch * 16) = kv; *(LAS v4u*)(F.lds + L2_SVT + (hh2 * 160 + key) * 144 + ch * 16) = vv; }
    { const int hh2 = tid >> 8, r = tid & 255, key = 128 + (r >> 3), ch = r & 7;
      const bool isnew = key < 132;
      if (!isnew) { *(LAS v4u*)(F.lds + L2_SK + (hh2 * 160 + key) * 144 + ch * 16) = (v4u){0u, 0u, 0u, 0u}; *(LAS v4u*)(F.lds + L2_SVT + (hh2 * 160 + key) * 144 + ch * 16) = (v4u){0u, 0u, 0u, 0u}; } }
    if (tid < 64) { const int hh2 = tid >> 5, r = tid & 31, key = 128 + (r >> 3), ch = r & 7;
        *(LAS v4u*)(F.lds + L2_SK + (hh2 * 160 + key) * 144 + ch * 16) = kz; *(LAS v4u*)(F.lds + L2_SVT + (hh2 * 160 + key) * 144 + ch * 16) = vz; }
#pragma unroll
    for (int u = 0; u < 4; ++u) { const int item = tid + NTHR * u, hh2 = item >> 10, r = item & 1023, key = r >> 3, ch = r & 7;
        if (key >= 4) { const size_t off = ((size_t)(b * 128 + key - 4) * 4 + 2 * hp + hh2) * 64 + ch * 8;
            __builtin_nontemporal_store(kf[u][0], (f32x4*)(F.out + O_SWK + off)); __builtin_nontemporal_store(kf[u][1], (f32x4*)(F.out + O_SWK + off + 4));
            __builtin_nontemporal_store(vf[u][0], (f32x4*)(F.out + O_SWV + off)); __builtin_nontemporal_store(vf[u][1], (f32x4*)(F.out + O_SWV + off + 4)); } }
    __syncthreads();
    const float sink2 = F.in[11][head] * LOG2E;
    f32x16 o0, o1; float inv;
    attn_core(F, qf, L2_SK + h2 * 160 * 144, L2_SVT + h2 * 160 * 144, 0, LDSP(float, L2_BIAS) + head * 128, sink2, false, o0, o1, inv);
    attn_store(F, o0, o1, inv, Z + (size_t)(MS0 + 4 * b) * N0 + C0_G + head * 64, Y + (size_t)(MS0 + 4 * b) * DM + 1024 + head * 64, 4);
    __syncthreads();
}

__device__ __forceinline__ void p2_mixers0(Frame& F) {
    const bf16* Z = WSP(bf16, WS_Z); bf16* Y = WSP(bf16, WS_Y);
    *(LAS f32x4*)(F.lds + L2_BIAS + 16 * F.tid) = ((const f32x4*)WSP(float, WS_BIAST))[F.tid];
    __syncthreads();
    pg8::StaticOrder So; So.init(SEQ, DM, F.G, F.bid); pg8::Unit uo; uo.pm = F.bid >> 3; uo.pn = F.bid & 7; (void)So.next(0, uo);
    attn_prompt_unit(F, 2 * uo.pm + (uo.pn >> 2), uo.pn & 3);
    __syncthreads();
    for (int u = F.bid; u < 256; u += F.G) attn_sample_unit(F, u >> 1, u & 1);
    const size_t gtid = (size_t)F.bid * NTHR + F.tid, gsz = (size_t)F.G * NTHR;
    const float* cw = F.in[10]; const float* sca = F.in[2];
#define CG_COORDS(kk) const int it = ((kk) < 2) ? uo.pn * 1024 + F.tid + 512 * (kk) : F.bid * 64 + F.tid; \
        const int m0 = ((kk) < 2) ? 256 * uo.pm + (it >> 7) * 4 : MS0 + (it >> 7) * 4, c0 = (it & 127) * 8; const bool samp = m0 >= MS0; const int b = (m0 - MS0) >> 2; (void)b;
#define CG_LOAD(kk, vs, vt) do { CG_COORDS(kk) \
        _Pragma("unroll") for (int r = 0; r < 6; ++r) { const int mm = m0 - 2 + r; \
            if (r >= 2 || (!samp && mm >= 0)) vs[r] = *(const v4u*)(Z + (size_t)mm * N0 + C0_S + c0); else vs[r] = (v4u){0u, 0u, 0u, 0u}; } \
        _Pragma("unroll") for (int r = 0; r < 4; ++r) vt[r] = *(const v4u*)(Z + (size_t)(m0 + r) * N0 + C0_T + c0); } while (0)
#define CG_DO(kk, vs, vt) do { CG_COORDS(kk) \
        float s[6][8]; \
        _Pragma("unroll") for (int r = 0; r < 6; ++r) { float* p = s[r]; UNPACK8(vs[r], p); } \
        if (samp) { _Pragma("unroll") for (int i = 0; i < 8; ++i) { s[0][i] = sca[(size_t)(b * 2 + 0) * 1024 + c0 + i]; s[1][i] = sca[(size_t)(b * 2 + 1) * 1024 + c0 + i]; } } \
        float w0[8], w1[8], w2[8]; \
        _Pragma("unroll") for (int i = 0; i < 8; ++i) { w0[i] = cw[c0 + i]; w1[i] = cw[1024 + c0 + i]; w2[i] = cw[2048 + c0 + i]; } \
        _Pragma("unroll") for (int r = 0; r < 4; ++r) { float tg[8], y[8]; UNPACK8(vt[r], tg); \
            _Pragma("unroll") for (int i = 0; i < 8; ++i) y[i] = tg[i] * (w0[i] * s[r][i] + w1[i] * s[r + 1][i] + w2[i] * s[r + 2][i]); \
            *(v4u*)(Y + (size_t)(m0 + r) * DM + c0) = pack8(y); } \
        if (!samp && m0 == SEQ - 4) { _Pragma("unroll") for (int i = 0; i < 8; ++i) { F.out[O_PCA + c0 + i] = s[4][i]; F.out[O_PCA + 1024 + c0 + i] = s[5][i]; } } \
        if (samp) { _Pragma("unroll") for (int i = 0; i < 8; ++i) { F.out[O_SCA + (size_t)(b * 2) * 1024 + c0 + i] = s[4][i]; F.out[O_SCA + (size_t)(b * 2 + 1) * 1024 + c0 + i] = s[5][i]; } } } while (0)
    {
        v4u vsA[6], vtA[4], vsB[6], vtB[4];
        CG_LOAD(0, vsA, vtA); CG_LOAD(1, vsB, vtB);
        CG_DO(0, vsA, vtA);
        if (F.tid < 64) CG_LOAD(2, vsA, vtA);
        CG_DO(1, vsB, vtB);
        if (F.tid < 64) CG_DO(2, vsA, vtA);
    }
#undef CG_DO
#undef CG_LOAD
#undef CG_COORDS
    for (size_t it = gtid; it < 128ull * 32; it += gsz) {
        const int j = (int)(it >> 5), c0 = (int)(it & 31) * 8; const bf16* zr = Z + (size_t)(SEQ - 128 + j) * N0;
        float f[8]; { const v4u a = *(const v4u*)(zr + C0_K + c0); UNPACK8(a, f); }
#pragma unroll
        for (int i = 0; i < 8; ++i) F.out[O_PWK + (size_t)j * 256 + c0 + i] = f[i];
        { const v4u a = *(const v4u*)(zr + C0_V + c0); UNPACK8(a, f); }
#pragma unroll
        for (int i = 0; i < 8; ++i) F.out[O_PWV + (size_t)j * 256 + c0 + i] = f[i];
    }
    for (size_t it = gtid; it < 512ull * 32; it += gsz) {
        const int r = (int)(it >> 5), c0 = (int)(it & 31) * 8, b = r >> 2, t = r & 3; const bf16* zr = Z + (size_t)(MS0 + r) * N0;
        float f[8]; { const v4u a = *(const v4u*)(zr + C0_K + c0); UNPACK8(a, f); }
#pragma unroll
        for (int i = 0; i < 8; ++i) F.out[O_SWK + ((size_t)b * 128 + 124 + t) * 256 + c0 + i] = f[i];
        { const v4u a = *(const v4u*)(zr + C0_V + c0); UNPACK8(a, f); }
#pragma unroll
        for (int i = 0; i < 8; ++i) F.out[O_SWV + ((size_t)b * 128 + 124 + t) * 256 + c0 + i] = f[i];
    }
}

__device__ __forceinline__ void row_pass(Frame& F, bool layer0, const float* gpost, const float* gpre, bf16* H, int r0, int r1, int gwA, int ngwA, unsigned* ctrA, unsigned wantA,
                                         int r2, int r3, int gwB, int ngwB, unsigned* ctrB, unsigned wantB) {
    const bf16* Yo = WSP(bf16, WS_Z);
    int lane = F.lane; asm volatile("" : "+v"(lane));
    if (layer0) {
        const f32x4* wsrc = (const f32x4*)WSP(float, WS_WDT);
        f32x4 wv[16];
#pragma unroll
        for (int u = 0; u < 16; ++u) wv[u] = wsrc[F.tid + NTHR * u];
#pragma unroll
        for (int u = 0; u < 16; ++u) *(LAS f32x4*)(F.lds + ((F.tid + NTHR * u) << 4)) = wv[u];
        __syncthreads();
    }
#define ROW_LOAD(mm) do { _Pragma("unroll") for (int j = 0; j < 4; ++j) { if (rng == 0) yn[j] = ld16_sc1(Yo + (size_t)(mm) * DM + 512 * j + 8 * lane); \
        { xn[j] = __builtin_bit_cast(f32x4, *(const v4u*)(WSP(bf16, WS_H) + (size_t)(mm) * DM + 512 * j + 8 * lane)); } } } while (0)
#pragma unroll 1
    for (int rng = 0; rng < 2; ++rng) {
    const int gw = rng ? gwB : gwA, NGW = rng ? ngwB : ngwA;
    v4u yn[4]; f32x4 xn[4];
    { const int m0 = (rng ? r2 : r0) + gw;
      if (m0 < (rng ? r3 : r1)) {
#pragma unroll
          for (int j = 0; j < 4; ++j) xn[j] = __builtin_bit_cast(f32x4, *(const v4u*)(WSP(bf16, WS_H) + (size_t)m0 * DM + 512 * j + 8 * lane)); } }
    if (rng == 0) { if (ctrA != nullptr) group_wait_na(ctrA, wantA); } else { r0 = r2; r1 = r3; if (ctrB != nullptr) group_wait_na(ctrB, wantB); }
    int m = r0 + gw;
    if (m < r1 && rng == 0) {
#pragma unroll
        for (int j = 0; j < 4; ++j) yn[j] = ld16_sc1(Yo + (size_t)m * DM + 512 * j + 8 * lane); }
#pragma unroll 1
    for (; m < r1; m += NGW) {
        asm volatile("" ::: "memory");
        float yv[32]; float ss = 0.f; f32x4 xc[8];
#pragma unroll
        for (int j = 0; j < 4; ++j) { float* f = yv + 8 * j;
            if (rng == 0) { UNPACK8(yn[j], f); }
            else { const bf16* p0 = WSP(bf16, WS_PT) + (size_t)(m - SEQ) * DM + 512 * j + 8 * lane;
                { const v4u a = ld16_sc1(p0); UNPACK8(a, f); }
#pragma unroll
                for (int q = 1; q < TSPLIT; ++q) { const v4u a = ld16_sc1(p0 + (size_t)q * 512 * DM); float g8[8]; UNPACK8(a, g8);
#pragma unroll
                    for (int i = 0; i < 8; ++i) f[i] += g8[i]; } }
            { const v4u xb = __builtin_bit_cast(v4u, xn[j]); xc[2 * j] = (f32x4){bflo(xb.x), bfhi(xb.x), bflo(xb.y), bfhi(xb.y)}; xc[2 * j + 1] = (f32x4){bflo(xb.z), bfhi(xb.z), bflo(xb.w), bfhi(xb.w)}; }
#pragma unroll
            for (int i = 0; i < 8; ++i) ss += f[i] * f[i]; }
        { const int mn = m + NGW;
          if (mn < r1) { ROW_LOAD(mn); } }
        const float rstd = rsqrtf(wave_sum(ss) * (1.f / DM) + EPS);
        float* xo = F.out + (size_t)m * DM;
        float s1 = 0.f;
#pragma unroll
        for (int j = 0; j < 4; ++j) {
            const int e = 512 * j + 8 * lane;
            f32x4 q0, q1; const f32x4 gp0 = *(const f32x4*)(gpost + e), gp1 = *(const f32x4*)(gpost + e + 4);
#pragma unroll
            for (int i = 0; i < 4; ++i) { q0[i] = xc[2 * j][i] + yv[8 * j + i] * rstd * gp0[i]; q1[i] = xc[2 * j + 1][i] + yv[8 * j + 4 + i] * rstd * gp1[i]; }
            if (layer0) { v4u o; o.x = pk2(q0[0], q0[1]); o.y = pk2(q0[2], q0[3]); o.z = pk2(q1[0], q1[1]); o.w = pk2(q1[2], q1[3]); *(v4u*)(H + (size_t)m * DM + e) = o; }
            else { __builtin_nontemporal_store(q0, (f32x4*)(xo + e)); __builtin_nontemporal_store(q1, (f32x4*)(xo + e + 4)); }
#pragma unroll
            for (int i = 0; i < 4; ++i) { yv[8 * j + i] = q0[i]; yv[8 * j + 4 + i] = q1[i]; s1 += q0[i] * q0[i] + q1[i] * q1[i]; }
        }
        if (layer0) {
            const float rs1 = rsqrtf(wave_sum(s1) * (1.f / DM) + EPS);
            f32x4 dta[4] = {};
#pragma unroll
            for (int j = 0; j < 4; ++j) { const int e = 512 * j + 8 * lane; const f32x4 g0 = *(const f32x4*)(gpre + e), g1 = *(const f32x4*)(gpre + e + 4);
                float f[8];
#pragma unroll
                for (int i = 0; i < 4; ++i) { f[i] = yv[8 * j + i] * rs1 * g0[i]; f[4 + i] = yv[8 * j + 4 + i] * rs1 * g1[i]; }
#pragma unroll
                for (int i = 0; i < 8; ++i) {
#pragma unroll
                    for (int c4 = 0; c4 < 4; ++c4) dta[c4] += f[i] * *(const LAS f32x4*)(F.lds + ((((j * 8 + i) * 4 + c4) * 64 + lane) << 4));
                    if (i & 1) asm volatile("" ::: "memory"); } }
            float mine = 0.f;
#pragma unroll
            for (int c = 0; c < 16; ++c) { const float t = wave_sum(dta[c >> 2][c & 3]); if (lane == c) mine = t; }
            if (lane < 16) WSP(float, WS_DTR)[(size_t)m * 16 + lane] = mine;
            if (lane == 0) WSP(float, WS_RS1)[m] = rs1;
        }
    }
    }
#undef ROW_LOAD
    if (layer0) __syncthreads();
}

__device__ __forceinline__ float softplus_f(float x) { return fmaxf(x, 0.f) + log1pf(__expf(-fabsf(x))); }

__device__ __forceinline__ void conv_act8(const bf16* Z, const float* cw, const float* cb, int row, int ch0, float* act) {
    float a[8];
#pragma unroll
    for (int i = 0; i < 8; ++i) a[i] = cb[ch0 + i];
#pragma unroll
    for (int j = 0; j < 4; ++j) {
        const int r = row - 3 + j;
        if (r >= 0) { const v4u v = *(const v4u*)(Z + (size_t)r * N1P + C1_X + ch0); float f[8]; UNPACK8(v, f);
#pragma unroll
            for (int i = 0; i < 8; ++i) a[i] += cw[j * 1536 + ch0 + i] * f[i]; }
    }
#pragma unroll
    for (int i = 0; i < 8; ++i) act[i] = silu(a[i]);
}

constexpr int LA_BT = 0;
constexpr int LA_XW = 34816;
constexpr int LA_ACS = LA_XW + 73728;
constexpr int LA_DT = LA_ACS + 2048;
constexpr int LA_SC = LA_DT + 2048;
static_assert(LA_SC + 2048 <= LDS_CTL_OFF, "P6a LDS");
__device__ __forceinline__ void p6a_unit(Frame& F, int c, int gi, int hq) {
    const bf16* Z = WSP(bf16, WS_Z); bf16* XA = WSP(bf16, WS_XA);
    const float* cw = F.in[20]; const float* cb = F.in[21];
    const int tid = F.tid, lane = F.lane, w = F.wave, T0 = 128 * c;
#define CONV_LOAD(NR, ROW0, CH0, raw_) do { \
        _Pragma("unroll") for (int j_ = 0; j_ < (NR) + 3; ++j_) { const int r_ = T0 + (ROW0) - 3 + j_; raw_[j_] = (r_ >= 0) ? *(const v4u*)(Z + (size_t)r_ * N1P + C1_X + (CH0)) : (v4u){0u, 0u, 0u, 0u}; } } while (0)
#define CONV_DO(NR, ROW0, CH0, raw_, BODY) do { \
        float wj_[4][8], bj_[8]; \
        _Pragma("unroll") for (int j_ = 0; j_ < 4; ++j_) { const f32x4 a_ = *(const f32x4*)(cw + j_ * 1536 + (CH0)), b_ = *(const f32x4*)(cw + j_ * 1536 + (CH0) + 4); \
            wj_[j_][0] = a_[0]; wj_[j_][1] = a_[1]; wj_[j_][2] = a_[2]; wj_[j_][3] = a_[3]; wj_[j_][4] = b_[0]; wj_[j_][5] = b_[1]; wj_[j_][6] = b_[2]; wj_[j_][7] = b_[3]; } \
        { const f32x4 a_ = *(const f32x4*)(cb + (CH0)), b_ = *(const f32x4*)(cb + (CH0) + 4); bj_[0] = a_[0]; bj_[1] = a_[1]; bj_[2] = a_[2]; bj_[3] = a_[3]; bj_[4] = b_[0]; bj_[5] = b_[1]; bj_[6] = b_[2]; bj_[7] = b_[3]; } \
        float f_[(NR) + 3][8]; \
        _Pragma("unroll") for (int j_ = 0; j_ < (NR) + 3; ++j_) { float* p_ = f_[j_]; UNPACK8(raw_[j_], p_); } \
        _Pragma("unroll") for (int r_ = 0; r_ < (NR); ++r_) { float act[8]; const int s = (ROW0) + r_; \
            _Pragma("unroll") for (int i_ = 0; i_ < 8; ++i_) act[i_] = silu(bj_[i_] + wj_[0][i_] * f_[r_][i_] + wj_[1][i_] * f_[r_ + 1][i_] + wj_[2][i_] * f_[r_ + 2][i_] + wj_[3][i_] * f_[r_ + 3][i_]); \
            BODY } } while (0)
#define CONV_ROWS(NR, ROW0, CH0, BODY) do { v4u raw__[(NR) + 3]; CONV_LOAD(NR, ROW0, CH0, raw__); CONV_DO(NR, ROW0, CH0, raw__, BODY); } while (0)
    const int ch8 = tid & 15, rgB = tid >> 4, chB = 1024 + gi * 128 + ch8 * 8, chC = 1280 + gi * 128 + ch8 * 8;
    v4u rawB[7]; CONV_LOAD(4, 4 * rgB, chB, rawB);
    if (w < 4) {
        const int hh = gi * 8 + hq * 4 + w;
        const float a = -__expf(F.in[23][hh]), bias = F.in[22][hh];
        const float d0 = softplus_f(WSP(float, WS_DTR)[(size_t)(T0 + 2 * lane) * 16 + hh] + bias), d1 = softplus_f(WSP(float, WS_DTR)[(size_t)(T0 + 2 * lane + 1) * 16 + hh] + bias);
        const float v0 = d0 * a, v1 = d1 * a;
        float inc = v0 + v1;
#pragma unroll
        for (int o = 1; o < 64; o <<= 1) { const float t = __shfl_up(inc, o); if (lane >= o) inc += t; }
        const float a1 = inc, a0 = inc - v1;
        const float total = __shfl(inc, 63);
        LDSP(float, LA_ACS)[w * 128 + 2 * lane] = a0; LDSP(float, LA_ACS)[w * 128 + 2 * lane + 1] = a1;
        LDSP(float, LA_DT)[w * 128 + 2 * lane] = d0; LDSP(float, LA_DT)[w * 128 + 2 * lane + 1] = d1;
        LDSP(float, LA_SC)[w * 128 + 2 * lane] = __expf(total - a0) * d0; LDSP(float, LA_SC)[w * 128 + 2 * lane + 1] = __expf(total - a1) * d1;
        WSP(float, WS_ACS)[(size_t)(T0 + 2 * lane) * 16 + hh] = a0; WSP(float, WS_ACS)[(size_t)(T0 + 2 * lane + 1) * 16 + hh] = a1;
        WSP(float, WS_DTV)[(size_t)(T0 + 2 * lane) * 16 + hh] = d0; WSP(float, WS_DTV)[(size_t)(T0 + 2 * lane + 1) * 16 + hh] = d1;
        if (lane == 0) WSP(float, WS_CD)[c * 16 + hh] = __expf(total);
    } else {
        const int row0 = T0 + 32 * (2 * gi + hq) + 8 * (w - 4);
#pragma unroll
        for (int h2 = 0; h2 < 2; ++h2) { const int row = row0 + 4 * h2 + (lane >> 4);
            const float2 pr = *(const float2*)(WSP(float, WS_VSP) + ((size_t)row * 16 + (lane & 15)) * 2);
            const float s1 = row16_sum(pr.x), s2 = row16_sum(pr.y);
            const float mean = s1 * (1.f / 1024.f), var = fmaxf(s2 * (1.f / 1024.f) - mean * mean, 0.f);
            if ((lane & 15) == 0) { WSP(float, WS_VST)[2 * row] = mean; WSP(float, WS_VST)[2 * row + 1] = rsqrtf(var + EPS); } }
    }
    __syncthreads();
    {
        const int rg = rgB;
        const int ch = tid & 31, h4 = ch >> 3, p0 = (ch & 7) * 8, chan = (gi * 8 + hq * 4 + h4) * 64 + p0, rg0 = tid >> 5, rg1 = rg0 + 16;
        v4u rawC[7];
        if (hq == 1) CONV_LOAD(4, 4 * rg, chC, rawC);
        CONV_DO(4, 4 * rg, chB, rawB, { *(LAS v4u*)(F.lds + LA_BT + s * 272 + ch8 * 16) = pack8(act); if (hq == 0) *(v4u*)(XA + (size_t)(T0 + s) * 1536 + chB) = pack8(act); });
        if (hq == 1) CONV_DO(4, 4 * rg, chC, rawC, { *(v4u*)(XA + (size_t)(T0 + s) * 1536 + chC) = pack8(act); });
#define XBODY { *(v4u*)(XA + (size_t)(T0 + s) * 1536 + chan) = pack8(act); const float scl = LDSP(float, LA_SC)[h4 * 128 + s]; \
                float sx[8]; _Pragma("unroll") for (int k = 0; k < 8; ++k) sx[k] = act[k] * scl; *(LAS v4u*)(F.lds + LA_XW + (h4 * 128 + s) * 144 + p0 * 2) = pack8(sx); }
#pragma unroll 1
        for (int it = 0; it < 2; ++it) { const int rgx = rg0 + 16 * it; CONV_ROWS(4, 4 * rgx, chan, XBODY); }
#undef XBODY
    }
#undef CONV_ROWS
#undef CONV_DO
#undef CONV_LOAD
    __syncthreads();
    {
        const int h4 = w >> 1, nh = w & 1, l31 = lane & 31, hl = lane >> 5, hh = gi * 8 + hq * 4 + h4;
        f32x16 acc[2][2] = {};
#pragma unroll
        for (int ks = 0; ks < 8; ++ks) {
            bf16x8 a[2], b[2];
#pragma unroll
            for (int pt = 0; pt < 2; ++pt) a[pt] = tr_frag_nat(F.lds + LA_XW + h4 * 128 * 144, 144, 16 * ks, 32 * pt, lane);
#pragma unroll
            for (int n2 = 0; n2 < 2; ++n2) b[n2] = tr_frag_nat(F.lds + LA_BT, 272, 16 * ks, 32 * (2 * nh + n2), lane);
#pragma unroll
            for (int pt = 0; pt < 2; ++pt)
#pragma unroll
                for (int n2 = 0; n2 < 2; ++n2) acc[pt][n2] = MFMA32(a[pt], b[n2], acc[pt][n2]);
        }
        bf16* cs = WSP(bf16, WS_CS) + ((size_t)(c * 16 + hh) * 64) * 128;
        const int odd = lane & 1;
#pragma unroll
        for (int pt = 0; pt < 2; ++pt)
#pragma unroll
            for (int n2 = 0; n2 < 2; ++n2)
#pragma unroll
                for (int k = 0; k < 8; ++k) { const float a = acc[pt][n2][2 * k], b = acc[pt][n2][2 * k + 1], na = DPPF(a, 0xB1), nb = DPPF(b, 0xB1);
                    const unsigned o = pk2(odd ? nb : a, odd ? b : na);
                    *(unsigned*)(cs + (size_t)(32 * pt + crow(2 * k + odd, hl)) * 128 + 32 * (2 * nh + n2) + (l31 & ~1)) = o; }
    }
    __syncthreads();
}

__device__ __forceinline__ void p6b_scan(Frame& F) {
    const bf16* cs = WSP(bf16, WS_CS); const float* cd = WSP(float, WS_CD); bf16* hb = WSP(bf16, WS_HB);
    for (int e = F.bid * NTHR + F.tid; e < 131072; e += F.G * NTHR) {
        const int hh = e >> 13; float st = 0.f;
        float sn[8];
#pragma unroll
        for (int i = 0; i < 8; ++i) sn[i] = bf1(cs[(size_t)i * 131072 + e]);
#pragma unroll 1
        for (int c0 = 0; c0 < 64; c0 += 8) {
            float s[8];
#pragma unroll
            for (int i = 0; i < 8; ++i) s[i] = sn[i];
            if (c0 + 8 < 64) {
#pragma unroll
                for (int i = 0; i < 8; ++i) sn[i] = bf1(cs[(size_t)(c0 + 8 + i) * 131072 + e]); }
#pragma unroll
            for (int i = 0; i < 8; ++i) { hb[(size_t)(c0 + i) * 131072 + e] = (bf16)f2bf(st); st = cd[(c0 + i) * 16 + hh] * st + s[i]; }
        }
        F.out[O_PSSM + e] = st;
    }
}

constexpr int LC_B = 0;
constexpr int LC_C = 34816;
constexpr int LC_X = LC_C + 17408;
constexpr int LC_ACS = LC_X + 65536;
constexpr int LC_DT = LC_ACS + 4096;
constexpr int LC_SSQ = LC_DT + 4096;
static_assert(LC_SSQ + 2048 <= LDS_CTL_OFF, "P6c LDS");
__device__ __forceinline__ void p6c_ssd_unit(Frame& F, int c, int gi, int th) {
    const bf16* Z = WSP(bf16, WS_Z); const bf16* XA = WSP(bf16, WS_XA); bf16* Y = WSP(bf16, WS_Y);
    const int tid = F.tid, lane = F.lane, w = F.wave, T0 = 128 * c, l31 = lane & 31, hl = lane >> 5, h4 = w >> 1;
    const int ns = (th == 0) ? 128 : 96;
#define TILE_OF(t2_) ((th == 0) ? 3 * (t2_) : 1 + (t2_))
    v4u vb[4], vc[2], vx[8]; float ta[2], td[2];
#pragma unroll
    for (int k = 0; k < 4; ++k) { const int item = tid + NTHR * k, s = item >> 4, ch = item & 15; if (s < ns) vb[k] = *(const v4u*)(XA + (size_t)(T0 + s) * 1536 + 1024 + gi * 128 + ch * 8); }
#pragma unroll
    for (int k = 0; k < 2; ++k) { const int item = tid + NTHR * k, r = item >> 4, ch = item & 15, t = 32 * TILE_OF(r >> 5) + (r & 31); vc[k] = *(const v4u*)(XA + (size_t)(T0 + t) * 1536 + 1280 + gi * 128 + ch * 8); }
#pragma unroll
    for (int k = 0; k < 2; ++k) { const int i = tid + NTHR * k, h8 = i >> 7, s = i & 127; ta[k] = WSP(float, WS_ACS)[(size_t)(T0 + s) * 16 + gi * 8 + h8]; td[k] = WSP(float, WS_DTV)[(size_t)(T0 + s) * 16 + gi * 8 + h8]; }
#pragma unroll
    for (int k = 0; k < 8; ++k) { const int item = tid + NTHR * k, s = item >> 5, ch = item & 31; if (s < ns) vx[k] = *(const v4u*)(XA + (size_t)(T0 + s) * 1536 + (gi * 8 + (ch >> 3)) * 64 + (ch & 7) * 8); }
    f32x16 acc[2][2]; v2u zz[2][4];
#define YOFF(ps_) do { const int t2_ = (w & 1) ^ (ps_), hh_ = gi * 8 + 4 * (ps_) + h4, tl_ = 32 * TILE_OF(t2_) + l31; \
        bf16x8 cf_[8]; \
        _Pragma("unroll") for (int ks = 0; ks < 8; ++ks) cf_[ks] = *(const bf16x8*)(XA + (size_t)(T0 + tl_) * 1536 + 1280 + gi * 128 + 16 * ks + 8 * hl); \
        const bf16* hprev_ = WSP(bf16, WS_HB) + ((size_t)(c * 16 + hh_) * 64) * 128; \
        _Pragma("unroll") for (int pt = 0; pt < 2; ++pt) { bf16x8 hf_[8]; acc[ps_][pt] = (f32x16){}; \
            _Pragma("unroll") for (int ks = 0; ks < 8; ++ks) hf_[ks] = *(const bf16x8*)(hprev_ + (size_t)(32 * pt + l31) * 128 + 16 * ks + 8 * hl); \
            _Pragma("unroll") for (int ks = 0; ks < 8; ++ks) acc[ps_][pt] = MFMA32(hf_[ks], cf_[ks], acc[ps_][pt]); } } while (0)
#define ZLOAD(ps_) do { const int t2_ = (w & 1) ^ (ps_), hh_ = gi * 8 + 4 * (ps_) + h4, tl_ = 32 * TILE_OF(t2_) + l31; const bf16* zrow_ = Z + (size_t)(T0 + tl_) * N1P + C1_Z + hh_ * 64; \
        _Pragma("unroll") for (int pt = 0; pt < 2; ++pt) _Pragma("unroll") for (int q4 = 0; q4 < 4; ++q4) zz[pt][q4] = *(const v2u*)(zrow_ + 32 * pt + 8 * q4 + 4 * hl); } while (0)
    YOFF(0);
#pragma unroll
    for (int k = 0; k < 4; ++k) { const int item = tid + NTHR * k, s = item >> 4, ch = item & 15; if (s < ns) *(LAS v4u*)(F.lds + LC_B + s * 272 + ch * 16) = vb[k]; }
#pragma unroll
    for (int k = 0; k < 2; ++k) { const int item = tid + NTHR * k, r = item >> 4, ch = item & 15; *(LAS v4u*)(F.lds + LC_C + r * 272 + ch * 16) = vc[k]; }
#pragma unroll
    for (int k = 0; k < 2; ++k) { const int i = tid + NTHR * k; LDSP(float, LC_ACS)[i] = ta[k]; LDSP(float, LC_DT)[i] = td[k]; }
#pragma unroll
    for (int k = 0; k < 8; ++k) { const int item = tid + NTHR * k, s = item >> 5, ch = item & 31; if (s < ns) *(LAS v4u*)(F.lds + LC_X + ((ch >> 3) * 128 + s) * 128 + (ch & 7) * 16) = vx[k]; }
    asm volatile("" ::: "memory");
    YOFF(1);
    ZLOAD(0);
#pragma unroll
    for (int k = 0; k < 8; ++k) { const int item = tid + NTHR * k, s = item >> 5, ch = item & 31; if (s < ns) vx[k] = *(const v4u*)(XA + (size_t)(T0 + s) * 1536 + (gi * 8 + 4 + (ch >> 3)) * 64 + (ch & 7) * 8); }
    __syncthreads();
    f32x16 G[2][2];
#pragma unroll
    for (int ps = 0; ps < 2; ++ps) {
        const int t2 = (w & 1) ^ ps, hh = gi * 8 + 4 * ps + h4;
        const int tt = TILE_OF(t2), tl = 32 * tt + l31;
        if (ps == 1) {
            __syncthreads();
#pragma unroll
            for (int k = 0; k < 8; ++k) { const int item = tid + NTHR * k, s = item >> 5, ch = item & 31; if (s < ns) *(LAS v4u*)(F.lds + LC_X + ((ch >> 3) * 128 + s) * 128 + (ch & 7) * 16) = vx[k]; }
            __syncthreads();
        }
        const LAS float* acsL = LDSP(float, LC_ACS) + (4 * ps + h4) * 128; const LAS float* dtL = LDSP(float, LC_DT) + (4 * ps + h4) * 128;
        const float acs_t = acsL[tl], dskip = F.in[24][hh];
        { const float ea = __expf(acs_t);
#pragma unroll
          for (int pt = 0; pt < 2; ++pt)
#pragma unroll
              for (int r = 0; r < 16; ++r) acc[ps][pt][r] *= ea; }
        const LAS unsigned char* cfp = F.lds + LC_C + (32 * t2 + l31) * 272 + 16 * hl;
        for (int st = 0; st <= tt; ++st) {
            f32x16 cb = {};
#pragma unroll
            for (int ks = 0; ks < 8; ++ks) { const bf16x8 b = *(const LAS bf16x8*)(F.lds + LC_B + (32 * st + l31) * 272 + 32 * ks + 16 * hl); const bf16x8 cfk = *(const LAS bf16x8*)(cfp + 32 * ks); cb = MFMA32(b, cfk, cb); }
#pragma unroll
            for (int q4 = 0; q4 < 4; ++q4) {
                const int sb = 32 * st + 8 * q4 + 4 * hl;
                const f32x4 as4 = *(const LAS f32x4*)(acsL + sb), dt4 = *(const LAS f32x4*)(dtL + sb);
#pragma unroll
                for (int i = 0; i < 4; ++i) {
                    const int s = sb + i;
                    float wv = cb[4 * q4 + i] * __expf(fminf(acs_t - as4[i], 0.f)) * dt4[i];
                    wv = (s <= tl) ? wv : 0.f;
                    wv += (s == tl) ? dskip : 0.f;
                    cb[4 * q4 + i] = wv;
                }
            }
#pragma unroll
            for (int sp = 0; sp < 2; ++sp) {
                const bf16x8 wf = pack_frag(cb, sp);
#pragma unroll
                for (int pt = 0; pt < 2; ++pt) { const bf16x8 A = tr_frag(F.lds + LC_X + h4 * 128 * 128, 128, 32 * st + 16 * sp, 32 * pt, 8, lane); acc[ps][pt] = MFMA32(A, wf, acc[ps][pt]); }
            }
        }
        float q = 0.f;
#pragma unroll
        for (int pt = 0; pt < 2; ++pt)
#pragma unroll
            for (int q4 = 0; q4 < 4; ++q4) {
                const float z0 = bflo(zz[pt][q4].x), z1 = bfhi(zz[pt][q4].x), z2 = bflo(zz[pt][q4].y), z3 = bfhi(zz[pt][q4].y);
                const float g0 = acc[ps][pt][4 * q4] * silu(z0), g1 = acc[ps][pt][4 * q4 + 1] * silu(z1), g2 = acc[ps][pt][4 * q4 + 2] * silu(z2), g3 = acc[ps][pt][4 * q4 + 3] * silu(z3);
                G[ps][pt][4 * q4] = g0; G[ps][pt][4 * q4 + 1] = g1; G[ps][pt][4 * q4 + 2] = g2; G[ps][pt][4 * q4 + 3] = g3;
                q += (g0 * g0 + g1 * g1) + (g2 * g2 + g3 * g3);
            }
        q = half_sum(q);
        if (hl == 0) LDSP(float, LC_SSQ)[(4 * ps + h4) * 64 + 32 * t2 + l31] = q;
        if (ps == 0) ZLOAD(1);
    }
    __syncthreads();
#pragma unroll
    for (int ps = 0; ps < 2; ++ps) {
        const int t2 = (w & 1) ^ ps, hh = gi * 8 + 4 * ps + h4;
        float tot = 0.f;
#pragma unroll
        for (int k = 0; k < 8; ++k) tot += LDSP(float, LC_SSQ)[k * 64 + 32 * t2 + l31];
        const float rstd = rsqrtf(tot * (1.f / 512.f) + EPS);
        const int tl = 32 * TILE_OF(t2) + l31;
        const float* gng = F.in[25] + hh * 64;
        bf16* yrow = Y + (size_t)(T0 + tl) * DM + 1024 + hh * 64;
#pragma unroll
        for (int pt = 0; pt < 2; ++pt)
#pragma unroll
            for (int q4 = 0; q4 < 4; ++q4) {
                const int p = 32 * pt + 8 * q4 + 4 * hl;
                const f32x4 gg = *(const f32x4*)(gng + p);
                v2u o; o.x = pk2(G[ps][pt][4 * q4] * rstd * gg[0], G[ps][pt][4 * q4 + 1] * rstd * gg[1]); o.y = pk2(G[ps][pt][4 * q4 + 2] * rstd * gg[2], G[ps][pt][4 * q4 + 3] * rstd * gg[3]);
                *(v2u*)(yrow + p) = o;
            }
    }
#undef TILE_OF
#undef YOFF
#undef ZLOAD
    __syncthreads();
}

constexpr int LM_VT = 0;
__device__ __forceinline__ void p6c_mlp_pair(Frame& F, int c0, int g0, int c1, int g1, bool two) {
    const bf16* Z = WSP(bf16, WS_Z); bf16* Y = WSP(bf16, WS_Y);
    const int tid = F.tid, lane = F.lane, w = F.wave, l31 = lane & 31, hl = lane >> 5, tt = w >> 1, t = 32 * tt + l31;
    const float* lng = F.in[16]; const float* lnb = F.in[17];
    v4u vv[2][4]; float mean[2][4], rstd[2][4];
#pragma unroll
    for (int p = 0; p < 2; ++p) { const int c = p ? c1 : c0, g = p ? g1 : g0;
        if (p == 0 || two) {
#pragma unroll
            for (int i = 0; i < 4; ++i) { const int item = tid + 512 * i, s = item >> 4, ch8 = item & 15, col = g * 128 + ch8 * 8;
                vv[p][i] = *(const v4u*)(Z + (size_t)(128 * c + s) * N1P + C1_V + col); mean[p][i] = WSP(float, WS_VST)[2 * (128 * c + s)]; rstd[p][i] = WSP(float, WS_VST)[2 * (128 * c + s) + 1]; } } }
    bf16x8 bfr[2][8]; v2u uu[2][2][4]; float bst[2];
#pragma unroll
    for (int p = 0; p < 2; ++p) { const int c = p ? c1 : c0, g = p ? g1 : g0;
        if (p == 0 || two) {
            const bf16* TR = WSP(bf16, WS_TRIL) + (size_t)g * 16384;
#pragma unroll
            for (int ks = 0; ks < 8; ++ks) if (ks < 2 * (tt + 1)) bfr[p][ks] = *(const bf16x8*)(TR + (size_t)t * 128 + 16 * ks + 8 * hl);
            bst[p] = F.in[19][g * 128 + t];
            const bf16* zr = Z + (size_t)(128 * c + t) * N1P;
#pragma unroll
            for (int w2 = 0; w2 < 2; ++w2)
#pragma unroll
                for (int q4 = 0; q4 < 4; ++q4) uu[p][w2][q4] = *(const v2u*)(zr + C1_UC + g * 128 + 32 * (2 * (w & 1) + w2) + 8 * q4 + 4 * hl); } }
#pragma unroll
    for (int p = 0; p < 2; ++p) { const int g = p ? g1 : g0;
        if (p == 0 || two) {
#pragma unroll
            for (int i = 0; i < 4; ++i) { const int item = tid + 512 * i, s = item >> 4, ch8 = item & 15, col = g * 128 + ch8 * 8;
                float f[8]; UNPACK8(vv[p][i], f); float vn[8];
#pragma unroll
                for (int k = 0; k < 8; ++k) vn[k] = (f[k] - mean[p][i]) * rstd[p][i] * lng[col + k] + lnb[col + k];
                *(LAS v4u*)(F.lds + LM_VT + p * 34816 + s * 272 + ch8 * 16) = pack8(vn); } } }
    __syncthreads();
#pragma unroll
    for (int p = 0; p < 2; ++p) { const int c = p ? c1 : c0, g = p ? g1 : g0;
        if (p == 0 || two) {
            f32x16 acc[2] = {};
#pragma unroll
            for (int ks = 0; ks < 8; ++ks) if (ks < 2 * (tt + 1)) {
#pragma unroll
                for (int w2 = 0; w2 < 2; ++w2) { const bf16x8 a = tr_frag_nat(F.lds + LM_VT + p * 34816, 272, 16 * ks, 32 * (2 * (w & 1) + w2), lane); acc[w2] = MFMA32(a, bfr[p][ks], acc[w2]); } }
            bf16* yr = Y + (size_t)(128 * c + t) * DM;
#pragma unroll
            for (int w2 = 0; w2 < 2; ++w2)
#pragma unroll
                for (int q4 = 0; q4 < 4; ++q4) {
                    const int col = g * 128 + 32 * (2 * (w & 1) + w2) + 8 * q4 + 4 * hl; const v2u u2 = uu[p][w2][q4];
                    const float y0 = bflo(u2.x) * (acc[w2][4 * q4] + bst[p]), y1 = bfhi(u2.x) * (acc[w2][4 * q4 + 1] + bst[p]), y2 = bflo(u2.y) * (acc[w2][4 * q4 + 2] + bst[p]), y3 = bfhi(u2.y) * (acc[w2][4 * q4 + 3] + bst[p]);
                    v2u o; o.x = pk2(y0, y1); o.y = pk2(y2, y3);
                    *(v2u*)(yr + col) = o;
                } } }
    __syncthreads();
}

constexpr int LS_W = 0, LS_W_STRIDE = 6144;
constexpr int LS_SSQ = 8 * LS_W_STRIDE;
__device__ __forceinline__ void p6c_sample_unit(Frame& F, int b, int gi) {
    const bf16* Z = WSP(bf16, WS_Z); bf16* Y = WSP(bf16, WS_Y);
    const float* cw = F.in[20]; const float* cb = F.in[21]; const float* scd = F.in[5];
    const int lane = F.lane, w = F.wave, hh = gi * 8 + w; const size_t m0 = MS0 + 4 * b;
    LAS float* xs = LDSP(float, LS_W + w * LS_W_STRIDE); LAS float* Bs = xs + 256; LAS float* Cs = Bs + 512; LAS float* ys = Cs + 512;
    const int plo = lane >> 4, n0 = 8 * (lane & 15);
    const float* sin_ = F.in[6] + ((size_t)(b * 16 + hh) * 64) * 128; float* sout = F.out + O_SSSM + ((size_t)(b * 16 + hh) * 64) * 128;
#define ST_LOAD(q, hv) do { _Pragma("unroll") for (int k = 0; k < 4; ++k) { const int p = 4 * (4 * (q) + k) + plo; \
        hv[k][0] = __builtin_nontemporal_load((const f32x4*)(sin_ + (size_t)p * 128 + n0)); hv[k][1] = __builtin_nontemporal_load((const f32x4*)(sin_ + (size_t)p * 128 + n0 + 4)); } } while (0)
    f32x4 hvA[4][2], hvB[4][2];
    ST_LOAD(0, hvA);
#pragma unroll
    for (int k = 0; k < 5; ++k) {
        const int ch = (k == 0) ? hh * 64 + lane : (k < 3 ? 1024 + gi * 128 + (k - 1) * 64 + lane : 1280 + gi * 128 + (k - 3) * 64 + lane);
        float full[7];
#pragma unroll
        for (int i = 0; i < 3; ++i) full[i] = scd[((size_t)b * 3 + i) * 1536 + ch];
#pragma unroll
        for (int t = 0; t < 4; ++t) full[3 + t] = bf1(Z[(m0 + t) * N1P + C1_X + ch]);
        const float w0 = cw[ch], w1 = cw[1536 + ch], w2 = cw[3072 + ch], w3 = cw[4608 + ch], bb = cb[ch];
#pragma unroll
        for (int t = 0; t < 4; ++t) {
            const float a = silu(w0 * full[t] + w1 * full[t + 1] + w2 * full[t + 2] + w3 * full[t + 3] + bb);
            if (k == 0) xs[t * 64 + lane] = a; else if (k < 3) Bs[t * 128 + (k - 1) * 64 + lane] = a; else Cs[t * 128 + (k - 3) * 64 + lane] = a;
        }
        if (k == 0 || w == 0) {
#pragma unroll
            for (int i = 0; i < 3; ++i) F.out[O_SCD + ((size_t)b * 3 + i) * 1536 + ch] = full[4 + i]; }
    }
    float dtv[4], dA[4];
    { const float a = -__expf(F.in[23][hh]), bias = F.in[22][hh];
#pragma unroll
      for (int t = 0; t < 4; ++t) { dtv[t] = softplus_f(WSP(float, WS_DTR)[(m0 + t) * 16 + hh] + bias); dA[t] = __expf(dtv[t] * a); } }
    float Br[4][8], Cr[4][8];
#pragma unroll
    for (int t = 0; t < 4; ++t) { const f32x4 b0 = *(const LAS f32x4*)(Bs + t * 128 + n0), b1 = *(const LAS f32x4*)(Bs + t * 128 + n0 + 4), c0 = *(const LAS f32x4*)(Cs + t * 128 + n0), c1 = *(const LAS f32x4*)(Cs + t * 128 + n0 + 4);
#pragma unroll
        for (int i = 0; i < 4; ++i) { Br[t][i] = b0[i]; Br[t][4 + i] = b1[i]; Cr[t][i] = c0[i]; Cr[t][4 + i] = c1[i]; } }
#define ST_DO(q, hv) do { _Pragma("unroll") for (int k = 0; k < 4; ++k) { const int p = 4 * (4 * (q) + k) + plo; \
            float h[8]; _Pragma("unroll") for (int i = 0; i < 4; ++i) { h[i] = hv[k][0][i]; h[4 + i] = hv[k][1][i]; } \
            float yp[4]; \
            _Pragma("unroll") for (int t = 0; t < 4; ++t) { const float coef = dtv[t] * xs[t * 64 + p]; float acc = 0.f; \
                _Pragma("unroll") for (int i = 0; i < 8; ++i) { h[i] = dA[t] * h[i] + coef * Br[t][i]; acc += h[i] * Cr[t][i]; } \
                yp[t] = acc; } \
            __builtin_nontemporal_store((f32x4){h[0], h[1], h[2], h[3]}, (f32x4*)(sout + (size_t)p * 128 + n0)); __builtin_nontemporal_store((f32x4){h[4], h[5], h[6], h[7]}, (f32x4*)(sout + (size_t)p * 128 + n0 + 4)); \
            _Pragma("unroll") for (int t = 0; t < 4; ++t) { const float v = row16_sum(yp[t]); if ((lane & 15) == 0) ys[t * 64 + p] = v; } } } while (0)
    ST_LOAD(1, hvB); ST_DO(0, hvA);
    ST_LOAD(2, hvA); ST_DO(1, hvB);
    ST_LOAD(3, hvB); ST_DO(2, hvA);
    ST_DO(3, hvB);
#undef ST_DO
#undef ST_LOAD
    float gv[4];
#pragma unroll
    for (int t = 0; t < 4; ++t) {
        const float yv = ys[t * 64 + lane] + F.in[24][hh] * xs[t * 64 + lane];
        const float z = bf1(Z[(m0 + t) * N1P + C1_Z + hh * 64 + lane]);
        gv[t] = yv * silu(z);
        const float q = wave_sum(gv[t] * gv[t]);
        if (lane == 0) LDSP(float, LS_SSQ)[w * 4 + t] = q;
    }
    __syncthreads();
#pragma unroll
    for (int t = 0; t < 4; ++t) {
        float tot = 0.f;
#pragma unroll
        for (int k = 0; k < 8; ++k) tot += LDSP(float, LS_SSQ)[k * 4 + t];
        const float rstd = rsqrtf(tot * (1.f / 512.f) + EPS);
        Y[(m0 + t) * DM + 1024 + hh * 64 + lane] = (bf16)f2bf(gv[t] * rstd * F.in[25][hh * 64 + lane]);
    }
    __syncthreads();
}

__device__ __forceinline__ void p6c_sample_mlp(Frame& F, int b) {
    const bf16* Z = WSP(bf16, WS_Z); bf16* Y = WSP(bf16, WS_Y);
    const int lane = F.lane, col = 16 * lane, g = lane >> 3, t = F.wave; const size_t m0 = MS0 + 4 * b;
    const float* lng = F.in[16]; const float* lnb = F.in[17]; const float* ws = F.in[18] + (size_t)g * 16384; const float* bs = F.in[19] + g * 128;
    float uu[16];
    if (t < 4) {
        const bf16* zr = Z + (m0 + t) * N1P;
        const v4u a = *(const v4u*)(zr + C1_V + col), c = *(const v4u*)(zr + C1_V + col + 8), ua = *(const v4u*)(zr + C1_UC + col), uc = *(const v4u*)(zr + C1_UC + col + 8);
        float f[16]; { UNPACK8(a, f); float* f2 = f + 8; UNPACK8(c, f2); }
        { UNPACK8(ua, uu); float* u2 = uu + 8; UNPACK8(uc, u2); }
        float s = 0.f;
#pragma unroll
        for (int i = 0; i < 16; ++i) s += f[i];
        const float mean = wave_sum(s) * (1.f / 1024.f); float q = 0.f;
#pragma unroll
        for (int i = 0; i < 16; ++i) { const float d = f[i] - mean; q += d * d; }
        const float rstd = rsqrtf(wave_sum(q) * (1.f / 1024.f) + EPS);
#pragma unroll
        for (int i = 0; i < 16; ++i) f[i] = (f[i] - mean) * rstd * lng[col + i] + lnb[col + i];
        float* o = F.out + O_SCV + ((size_t)b * 4 + t) * 1024 + col;
#pragma unroll
        for (int i = 0; i < 4; ++i) { const f32x4 v = (f32x4){f[4 * i], f[4 * i + 1], f[4 * i + 2], f[4 * i + 3]}; *(f32x4*)(o + 4 * i) = v; *(LAS f32x4*)(F.lds + ((t * 1024 + col + 4 * i) << 2)) = v; }
    }
    __syncthreads();
    if (t < 4) {
        float y[16];
#pragma unroll
        for (int i = 0; i < 16; ++i) y[i] = bs[t];
        for (int s = 0; s <= t; ++s) { const float w = ws[t * 128 + s];
#pragma unroll
            for (int i = 0; i < 4; ++i) { const f32x4 v = *(const LAS f32x4*)(F.lds + ((s * 1024 + col + 4 * i) << 2)); y[4 * i] += w * v[0]; y[4 * i + 1] += w * v[1]; y[4 * i + 2] += w * v[2]; y[4 * i + 3] += w * v[3]; } }
#pragma unroll
        for (int i = 0; i < 16; ++i) y[i] *= uu[i];
        *(v4u*)(Y + (m0 + t) * DM + col) = pack8(y); *(v4u*)(Y + (m0 + t) * DM + col + 8) = pack8(y + 8);
    }
    __syncthreads();
}

struct EpiFinal {
    static constexpr bool PERM = true, AFTER_DRAIN = true;
    const bf16* X1; const float* g; float* out; float* PS; unsigned* panel_ctr; bf16* Yo; bool defer;
    __device__ __forceinline__ void operator()(const f32x4 (&)[2][2][4][2], const pg8::Unit&, int, int, int, int) const {}
    __device__ __forceinline__ void fused(f32x4 (&acc)[2][2][4][2], const pg8::Unit& u, int wr, int wc, int fr, int fq, LAS unsigned char* lds, int wid, int lane) const {
        LAS float* red = (LAS float*)lds;
        const int tid = threadIdx.x;
#pragma unroll
        for (int ai = 0; ai < 2; ++ai)
#pragma unroll
            for (int m = 0; m < 4; ++m) { float s = 0.f;
#pragma unroll
                for (int bj = 0; bj < 2; ++bj)
#pragma unroll
                    for (int n = 0; n < 2; ++n)
#pragma unroll
                        for (int i = 0; i < 4; ++i) { const float x = acc[ai][bj][m][n][i]; s += x * x; }
                { auto r = __builtin_amdgcn_permlane16_swap(__float_as_uint(s), __float_as_uint(s), false, false); s = __uint_as_float(r[0]) + __uint_as_float(r[1]); }
                { auto r = __builtin_amdgcn_permlane32_swap(__float_as_uint(s), __float_as_uint(s), false, false); s = __uint_as_float(r[0]) + __uint_as_float(r[1]); }
                if (fq == 0) red[wc * 256 + 128 * ai + 64 * wr + 16 * m + fr] = s; }
        __syncthreads();
        if (tid < 256) __hip_atomic_store(&PS[(size_t)u.pn * SEQ + 256 * u.pm + tid], (red[tid] + red[256 + tid]) + (red[512 + tid] + red[768 + tid]), __ATOMIC_RELAXED, __HIP_MEMORY_SCOPE_AGENT);
        const int col0 = 256 * u.pn + 32 * wc + 8 * fq, rowb = 256 * u.pm + 64 * wr + fr;
        if (defer) {
#pragma unroll
            for (int ai = 0; ai < 2; ++ai)
#pragma unroll
                for (int m = 0; m < 4; ++m) { bf16* rowp = Yo + (size_t)(rowb + 128 * ai + 16 * m) * DM + col0;
#pragma unroll
                    for (int bj = 0; bj < 2; ++bj) { const f32x4 v0 = acc[ai][bj][m][0], v1 = acc[ai][bj][m][1];
                        v4u w; w.x = pk2(v0[0], v0[1]); w.y = pk2(v0[2], v0[3]); w.z = pk2(v1[0], v1[1]); w.w = pk2(v1[2], v1[3]);
                        pg8::st16_wt(rowp + 128 * bj, w); } }
            group_arrive_wt(panel_ctr);
            return;
        }
        group_arrive_wt(panel_ctr);
        f32x4 gg[2][2];
#pragma unroll
        for (int bj = 0; bj < 2; ++bj) { gg[bj][0] = *(const f32x4*)(g + col0 + 128 * bj); gg[bj][1] = *(const f32x4*)(g + col0 + 128 * bj + 4); }
        v4u xr[4][2];
#pragma unroll
        for (int m = 0; m < 4; ++m)
#pragma unroll
            for (int bj = 0; bj < 2; ++bj) xr[m][bj] = *(const v4u*)(X1 + (size_t)(rowb + 16 * m) * DM + col0 + 128 * bj);
        group_wait_na(panel_ctr, 8u);
        if (tid < 256) { float t = 0.f;
#pragma unroll
            for (int q = 0; q < 8; ++q) t += __hip_atomic_load(&PS[(size_t)q * SEQ + 256 * u.pm + tid], __ATOMIC_RELAXED, __HIP_MEMORY_SCOPE_AGENT);
            red[1024 + tid] = rsqrtf(t * (1.f / DM) + EPS); }
        __syncthreads();
#pragma unroll
        for (int ai = 0; ai < 2; ++ai) {
            v4u xc[4][2];
            if (ai == 0) {
#pragma unroll
                for (int m = 0; m < 4; ++m)
#pragma unroll
                    for (int bj = 0; bj < 2; ++bj) xc[m][bj] = xr[m][bj];
            } else {
#pragma unroll
                for (int m = 0; m < 4; ++m)
#pragma unroll
                    for (int bj = 0; bj < 2; ++bj) xc[m][bj] = *(const v4u*)(X1 + (size_t)(rowb + 128 + 16 * m) * DM + col0 + 128 * bj); }
#pragma unroll
            for (int m = 0; m < 4; ++m) { const float rstd = red[1024 + 128 * ai + 64 * wr + 16 * m + fr];
                float* orow = out + (size_t)(rowb + 128 * ai + 16 * m) * DM + col0;
#pragma unroll
                for (int bj = 0; bj < 2; ++bj) { const v4u xb = xc[m][bj];
                    const f32x4 a0 = acc[ai][bj][m][0], a1 = acc[ai][bj][m][1];
                    f32x4 q0, q1;
                    q0[0] = bflo(xb.x) + a0[0] * rstd * gg[bj][0][0]; q0[1] = bfhi(xb.x) + a0[1] * rstd * gg[bj][0][1]; q0[2] = bflo(xb.y) + a0[2] * rstd * gg[bj][0][2]; q0[3] = bfhi(xb.y) + a0[3] * rstd * gg[bj][0][3];
                    q1[0] = bflo(xb.z) + a1[0] * rstd * gg[bj][1][0]; q1[1] = bfhi(xb.z) + a1[1] * rstd * gg[bj][1][1]; q1[2] = bflo(xb.w) + a1[2] * rstd * gg[bj][1][2]; q1[3] = bfhi(xb.w) + a1[3] * rstd * gg[bj][1][3];
                    __builtin_nontemporal_store(q0, (f32x4*)(orow + 128 * bj)); __builtin_nontemporal_store(q1, (f32x4*)(orow + 128 * bj + 4)); } }
        }
        __syncthreads();
    }
};

#ifndef USE_CG_SYNC
#define USE_CG_SYNC 0
#endif
__global__ void __launch_bounds__(NTHR, 2) hybrid_fwd(Args args) {
    extern __shared__ __attribute__((aligned(16))) unsigned char lds[];
    cg::grid_group grid = cg::this_grid();
    Frame F;
    F.lds = (LAS unsigned char*)lds;
    F.tid = threadIdx.x; F.lane = F.tid & 63; F.wave = __builtin_amdgcn_readfirstlane(F.tid >> 6);
    F.G = gridDim.x; F.bid = blockIdx.x;
#pragma unroll
    for (int i = 0; i < 28; ++i) F.in[i] = args.in[i];
    F.out = args.out; F.ws = args.ws;
    for (int u = F.tid; u < (LDS_BYTES - LDS_CTL_OFF) / 4; u += NTHR) ((LAS unsigned*)(F.lds + LDS_CTL_OFF))[u] = 0u;
    __syncthreads();
    XcdBarrier bar = xcd_barrier_post((unsigned*)(F.ws + WS_CTL) + CW_BAR, (volatile LAS unsigned*)(F.lds + LDS_CTL_OFF) + 8);
    const int lo = args.ph_lo, hi = args.ph_hi;
    if (hi > 64) grid.sync();
#ifndef PHASE_MASK
#define PHASE_MASK 0x1fff
#endif
#ifndef REP_MASK
#define REP_MASK 0
#endif
#define REPS(k) _Pragma("unroll") for (int rep_ = 0; rep_ < ((((REP_MASK) >> (k)) & 1) ? 2 : 1); ++rep_)
#define IN(k) (((PHASE_MASK >> (k)) & 1) && lo <= (k) && (k) < hi)
#ifdef DELAY_MASK
#define STAMP(k) do { if (F.bid == 0 && F.tid == 0) ((volatile LAS unsigned long long*)(F.lds + LDS_CTL_OFF + 64))[(k)] = __builtin_amdgcn_s_memrealtime(); } while (0)
#define DELAY(k) do { if (((DELAY_MASK) >> (k)) & 1) { if (F.bid == 0 && F.tid == 0) { volatile LAS unsigned long long* T_ = (volatile LAS unsigned long long*)(F.lds + LDS_CTL_OFF + 64); \
        const unsigned long long t1_ = T_[(k) + 1], d_ = t1_ - T_[(k)]; while (__builtin_amdgcn_s_memrealtime() < t1_ + d_) __builtin_amdgcn_s_sleep(8); } xcd_barrier(bar); } } while (0)
#else
#define STAMP(k) do { } while (0)
#define DELAY(k) do { } while (0)
#endif
#ifdef DOUBLE_BAR
#define SEAM(k) do { if (IN(k) && IN((k) + 1)) { if (USE_CG_SYNC) grid.sync(); else xcd_barrier(bar); xcd_barrier(bar); } STAMP((k) + 1); DELAY(k); } while (0)
#else
#define SEAM(k) do { if (IN(k) && IN((k) + 1)) { if (USE_CG_SYNC) grid.sync(); else xcd_barrier(bar); } STAMP((k) + 1); DELAY(k); } while (0)
#endif

    STAMP(0);
    if (IN(0)) REPS(0) { p0_prologue(F); }
    SEAM(0);
    if (IN(1)) REPS(1) {
        pg8::Gemm g{WSP(bf16, WS_H), WSP(bf16, WS_WT0), MROWS, N0, DM}; pg8::StaticOrder S; S.init(MROWS, N0, F.G, F.bid);
        pg8::EpiL0 E{WSP(bf16, WS_Z), N0, WSP(float, WS_RS0)};
        pg8::gemm_phase<pg8::EpiL0, pg8::StaticOrder, true, true>(F.lds, g, S, E);
        filler_loop(F);
    }
    SEAM(1);
    if (IN(2)) REPS(2) { p2_mixers0(F); }
    SEAM(2);
    if (IN(3)) {
        pg8::StaticOrder S; S.init(SEQ, DM, F.G, F.bid); pg8::Unit u; u.pm = 0; u.pn = 0; (void)S.next(0, u);
        { pg8::Gemm g{WSP(bf16, WS_Y), WSP(bf16, WS_WO0), SEQ, DM, DM}; pg8::EpiStoreWT E{WSP(bf16, WS_Z), DM};
          pg8::gemm_phase<pg8::EpiStoreWT, pg8::StaticOrder, false, true>(F.lds, g, S, E); }
        group_arrive_wt((unsigned*)(F.ws + WS_CTL) + CW_PANEL0 + 64 * u.pm);
        static_assert(TSPLIT == 4 && 16 * TSPLIT == 2 * (SEQ / 256), "two tail items per prompt panel: the panel's pn = 0, 1 workgroups carry them");
        const bool tailwg = (u.pn < 2); const int titem = 2 * u.pm + u.pn;
        if (tailwg) { const int kq = titem >> 4;
            pg8::Gemm g{WSP(bf16, WS_Y) + (size_t)SEQ * DM + kq * (DM / TSPLIT), WSP(bf16, WS_WO0) + kq * (DM / TSPLIT), MROWS - SEQ, DM, DM / TSPLIT, DM}; pg8::StaticOrder S2; S2.init(MROWS - SEQ, DM, F.G, titem & 15);
            pg8::EpiStoreWT E{WSP(bf16, WS_PT) + (size_t)kq * 512 * DM, DM};
            pg8::gemm_phase<pg8::EpiStoreWT, pg8::StaticOrder, false, true>(F.lds, g, S2, E); group_arrive_wt((unsigned*)(F.ws + WS_CTL) + CW_TAIL0); }
        row_pass(F, true, F.in[13], F.in[14], WSP(bf16, WS_H), tailwg ? 256 * u.pm + 240 : 256 * u.pm, tailwg ? 256 * u.pm + 256 : 256 * u.pm + 240, (tailwg ? u.pn : u.pn - 2) * NWAVES + F.wave, (tailwg ? 2 : 6) * NWAVES,
                 (unsigned*)(F.ws + WS_CTL) + CW_PANEL0 + 64 * u.pm, 8u,
                 SEQ, tailwg ? MROWS : SEQ, titem * NWAVES + F.wave, 64 * NWAVES, tailwg ? (unsigned*)(F.ws + WS_CTL) + CW_TAIL0 : nullptr, 16u * TSPLIT);
    }
    SEAM(3); STAMP(5); STAMP(6);
    if (IN(6)) REPS(6) {
        pg8::Gemm g{WSP(bf16, WS_H), WSP(bf16, WS_WT1), MROWS, N1P, DM}; pg8::StaticOrder S; S.init(MROWS, N1P, F.G, F.bid);
        pg8::EpiL1 E{WSP(bf16, WS_Z), N1P, WSP(float, WS_RS1), WSP(float, WS_VSP)};
        pg8::gemm_phase<pg8::EpiL1, pg8::StaticOrder, true, true>(F.lds, g, S, E);
    }
    SEAM(6);
    if (IN(7)) REPS(7) { for (int u = F.bid; u < 256; u += F.G) p6a_unit(F, u >> 2, (u >> 1) & 1, u & 1); }
    SEAM(7);
    if (IN(8)) { p6b_scan(F); }
    SEAM(8);
    if (IN(9)) {
        const int rot = (F.bid >> 3) % 3;
        if (rot == 0) { REPS(15) for (int u = F.bid; u < 256; u += F.G) p6c_sample_unit(F, u >> 1, u & 1); }
        pg8::StaticOrder So; So.init(SEQ, DM, F.G, F.bid); pg8::Unit uo; uo.pm = F.bid >> 3; uo.pn = F.bid & 7; (void)So.next(0, uo);
        REPS(13) p6c_ssd_unit(F, 2 * uo.pm + (uo.pn >> 2), (uo.pn >> 1) & 1, uo.pn & 1);
        if (rot == 1) { REPS(15) for (int u = F.bid; u < 256; u += F.G) p6c_sample_unit(F, u >> 1, u & 1); }
        REPS(14) p6c_mlp_pair(F, 2 * uo.pm + (uo.pn >> 2), 2 * (uo.pn & 3), 2 * uo.pm + (uo.pn >> 2), 2 * (uo.pn & 3) + 1, true);
        if (rot == 2) { REPS(15) for (int u = F.bid; u < 256; u += F.G) p6c_sample_unit(F, u >> 1, u & 1); }
        for (int u = F.bid; u < 128; u += F.G) p6c_sample_mlp(F, u);
        if (F.bid == F.G - 1) { const bf16* Z = WSP(bf16, WS_Z);
            for (int i = F.tid; i < 3 * 1536; i += NTHR) { const int r = i / 1536, ch = i % 1536; F.out[O_PCD + i] = bf1(Z[(size_t)(SEQ - 3 + r) * N1P + C1_X + ch]); } }
    }
    SEAM(9);
    if (IN(10)) {
        pg8::StaticOrder S; S.init(SEQ, DM, F.G, F.bid); pg8::Unit u; u.pm = 0; u.pn = 0; (void)S.next(0, u);
        { pg8::Gemm g{WSP(bf16, WS_Y), WSP(bf16, WS_WO1), SEQ, DM, DM};
          EpiFinal E{WSP(bf16, WS_H), F.in[27], F.out, WSP(float, WS_PS), (unsigned*)(F.ws + WS_CTL) + CW_PANEL1 + 64 * u.pm, WSP(bf16, WS_Z), u.pn < 2};
          pg8::gemm_phase<EpiFinal, pg8::StaticOrder, false, true>(F.lds, g, S, E); }
        if (u.pn >= 2) {
            const LAS float* rsl = (const LAS float*)F.lds + 1024; const bf16* Yo = WSP(bf16, WS_Z); const bf16* X1 = WSP(bf16, WS_H); const float* gp = F.in[27];
            const int c = 8 * F.lane; const f32x4 g0 = *(const f32x4*)(gp + c), g1 = *(const f32x4*)(gp + c + 4);
#pragma unroll 2
            for (int rl = (u.pn - 2) * NWAVES + F.wave; rl < 256; rl += 6 * NWAVES) { const size_t row = (size_t)256 * u.pm + rl;
                const v4u y = ld16_sc1(Yo + row * DM + c), xb = *(const v4u*)(X1 + row * DM + c); const float rstd = rsl[rl];
                f32x4 q0, q1;
                q0[0] = bflo(xb.x) + bflo(y.x) * rstd * g0[0]; q0[1] = bfhi(xb.x) + bfhi(y.x) * rstd * g0[1]; q0[2] = bflo(xb.y) + bflo(y.y) * rstd * g0[2]; q0[3] = bfhi(xb.y) + bfhi(y.y) * rstd * g0[3];
                q1[0] = bflo(xb.z) + bflo(y.z) * rstd * g1[0]; q1[1] = bfhi(xb.z) + bfhi(y.z) * rstd * g1[1]; q1[2] = bflo(xb.w) + bflo(y.w) * rstd * g1[2]; q1[3] = bfhi(xb.w) + bfhi(y.w) * rstd * g1[3];
                __builtin_nontemporal_store(q0, (f32x4*)(F.out + row * DM + c)); __builtin_nontemporal_store(q1, (f32x4*)(F.out + row * DM + c + 4)); }
            __syncthreads();
        }
        static_assert(TSPLIT == 4 && 16 * TSPLIT == 2 * (SEQ / 256), "two tail items per prompt panel: the panel's pn = 0, 1 workgroups carry them");
        const bool tailwg = (u.pn < 2); const int titem = 2 * u.pm + u.pn;
        if (tailwg) { const int kq = titem >> 4;
            pg8::Gemm g{WSP(bf16, WS_Y) + (size_t)SEQ * DM + kq * (DM / TSPLIT), WSP(bf16, WS_WO1) + kq * (DM / TSPLIT), MROWS - SEQ, DM, DM / TSPLIT, DM}; pg8::StaticOrder S2; S2.init(MROWS - SEQ, DM, F.G, titem & 15);
            pg8::EpiStoreWT E{WSP(bf16, WS_PT) + (size_t)kq * 512 * DM, DM};
            pg8::gemm_phase<pg8::EpiStoreWT, pg8::StaticOrder, false, true>(F.lds, g, S2, E); group_arrive_wt((unsigned*)(F.ws + WS_CTL) + CW_TAIL1); }
        if (tailwg) row_pass(F, false, F.in[27], nullptr, nullptr, 0, 0, 0, 1, nullptr, 0u,
                 SEQ, MROWS, titem * NWAVES + F.wave, 64 * NWAVES, (unsigned*)(F.ws + WS_CTL) + CW_TAIL1, 16u * TSPLIT);
    }
#ifdef DELAY_MASK
    xcd_barrier(bar); STAMP(11); DELAY(10);
#endif
#undef IN
#undef SEAM
}

extern "C" void kernel_launch(void* const* d_in, const int* in_sizes, int n_in, void* d_out, int out_size, void* d_ws, size_t ws_size, hipStream_t stream) {
    static int grid = 0;
    if (grid == 0) {
        int dev = 0, cus = 0, per_cu = 0;
        if (n_in != 28 || (size_t)out_size != O_END || ws_size < WS_END) { fprintf(stderr, "kernel_launch: unexpected shapes n_in %d out %d ws %zu\n", n_in, out_size, ws_size); grid = -1; return; }
        (void)hipGetDevice(&dev); (void)hipDeviceGetAttribute(&cus, hipDeviceAttributeMultiprocessorCount, dev);
        (void)hipFuncSetAttribute((const void*)hybrid_fwd, hipFuncAttributeMaxDynamicSharedMemorySize, LDS_BYTES);
        (void)hipOccupancyMaxActiveBlocksPerMultiprocessor(&per_cu, (const void*)hybrid_fwd, NTHR, LDS_BYTES);
        (void)hipGetLastError();
        if (per_cu < 1) { fprintf(stderr, "kernel_launch: occupancy query says %d blocks per CU\n", per_cu); grid = -1; return; }
        if (cus != 256) { fprintf(stderr, "kernel_launch: built for a 256-CU device (the out-projection phases give one tile to each of 256 workgroups); found %d CUs\n", cus); grid = -1; return; }
        grid = cus;
    }
    if (grid < 0) return;
    (void)hipMemsetAsync((char*)d_ws + WS_CTL, 0, CTL_ZERO_BYTES, stream);
    Args a{};
    for (int i = 0; i < 28; ++i) a.in[i] = (const float*)d_in[i];
    a.out = (float*)d_out; a.ws = (unsigned char*)d_ws;
    a.ph_lo = 0; a.ph_hi = 13;
    void* params[] = {&a};
    hipError_t e = hipLaunchCooperativeKernel((const void*)hybrid_fwd, dim3(grid), dim3(NTHR), params, LDS_BYTES, stream);
    if (e != hipSuccess) fprintf(stderr, "cooperative launch failed: %s (grid %d)\n", hipGetErrorString(e), grid);
}
```
